# Optimizing an MI355X kernel written in HIP

```python
import jax, jax.numpy as jnp
from jax import lax
import numpy as np

D_MODEL = 2048
BATCH = 4
SEQ = 2048
DEPTH = 1

NSA_HEADS = 16
NSA_KV_GROUPS = 4
NSA_HEAD_DIM = 128
CMP_BLOCK = 32
CMP_STRIDE = 16
SLC_BLOCK = 64
SLC_TOP_N = 16
WINDOW = 512
WIN_Q_BLOCK = 128
SLC_Q_CHUNK = 32
RET_HEADS = 8
RET_KEY_DIM = 128
RET_VAL_DIM = 256
RET_CHUNK = 128
D_FF = 5632
N_ADA = 9
EPS = 1e-6
SEL_FORCE = 1e4

NSA_WIDTH = NSA_HEADS * NSA_HEAD_DIM
KV_WIDTH = NSA_KV_GROUPS * NSA_HEAD_DIM
RET_QK_WIDTH = RET_HEADS * RET_KEY_DIM
RET_V_WIDTH = RET_HEADS * RET_VAL_DIM
IN_SPLITS = (NSA_WIDTH, 6 * KV_WIDTH, 3 * NSA_HEADS, RET_QK_WIDTH, RET_QK_WIDTH, RET_V_WIDTH, RET_V_WIDTH, D_MODEL, D_MODEL)
N_IN = sum(IN_SPLITS)

kernel_name = 'hybrid_nsa_retention_macaron'


def rms_norm(x, g):
    xf = x.astype(jnp.float32)
    y = xf * lax.rsqrt(jnp.mean(xf * xf, -1, keepdims=True) + EPS)
    return (y * g.astype(jnp.float32)).astype(x.dtype)


def modulate(x, g, shift, scale):
    return rms_norm(x, g) * (1 + scale) + shift


def swiglu(x, w_gate, w_up, w_down):
    return (jax.nn.silu(x @ w_gate) * (x @ w_up)) @ w_down


def masked_softmax(s, mask):
    s = jnp.where(mask, s.astype(jnp.float32), -jnp.inf)
    m = jnp.max(s, -1, keepdims=True)
    m = jnp.where(jnp.isfinite(m), m, 0.0)
    p = jnp.where(mask, jnp.exp(s - m), 0.0)
    return p / jnp.maximum(jnp.sum(p, -1, keepdims=True), jnp.finfo(jnp.float32).tiny)


def alibi_slopes(n):
    return jnp.exp2(-8.0 * jnp.arange(1, n + 1, dtype=jnp.float32) / n)


def nsa_attention(q, kv, gate_logits, g_qk, cmp_pos, cmp_w1, cmp_b1, cmp_w2):
    B, S, _ = q.shape
    G, dh = NSA_KV_GROUPS, NSA_HEAD_DIM
    Hg = NSA_HEADS // G
    scale = dh ** -0.5
    t = jnp.arange(S)
    slopes = alibi_slopes(NSA_HEADS).reshape(G, Hg)
    q = rms_norm(q.reshape(B, S, G, Hg, dh), g_qk[0])
    kv = kv.reshape(B, S, 6, G, dh)
    k_cmp_raw, v_cmp_raw, k_slc, v_slc, k_win, v_win = [kv[:, :, i] for i in range(6)]
    k_slc = rms_norm(k_slc, g_qk[2])
    k_win = rms_norm(k_win, g_qk[3])

    n_cmp = (S - CMP_BLOCK) // CMP_STRIDE + 1
    starts = jnp.arange(n_cmp) * CMP_STRIDE
    cidx = starts[:, None] + jnp.arange(CMP_BLOCK)[None, :]

    def compress(z, i):
        blk = z[:, cidx] + cmp_pos[i][:, None, :]
        blk = blk.transpose(0, 3, 1, 2, 4).reshape(B, G, n_cmp, CMP_BLOCK * dh)
        return jax.nn.gelu(blk @ cmp_w1[i] + cmp_b1[i]) @ cmp_w2[i]

    k_cmp = rms_norm(compress(k_cmp_raw, 0), g_qk[1])
    v_cmp = compress(v_cmp_raw, 1)
    s_c = jnp.einsum('bsghd,bgcd->bghsc', q, k_cmp).astype(jnp.float32) * scale
    centre = (starts + (CMP_BLOCK - 1) / 2).astype(jnp.float32)
    s_c = s_c - slopes[:, :, None, None] * (t[:, None].astype(jnp.float32) - centre[None, :])
    p_c = masked_softmax(s_c, (starts + CMP_BLOCK - 1)[None, :] <= t[:, None])
    o_cmp = jnp.einsum('bghsc,bgcd->bsghd', p_c.astype(v_cmp.dtype), v_cmp)

    n_slc = S // SLC_BLOCK
    top_n = min(SLC_TOP_N, n_slc)
    cs = starts[:, None]
    js = (jnp.arange(n_slc) * SLC_BLOCK)[None, :]
    overlap = jnp.clip(jnp.minimum(cs + CMP_BLOCK, js + SLC_BLOCK) - jnp.maximum(cs, js), 0, None)
    overlap = overlap.astype(jnp.float32) / CMP_BLOCK
    imp = jnp.einsum('bghsc,cj->bgsj', p_c, overlap)
    blk_t = t // SLC_BLOCK
    jj = jnp.arange(n_slc)[None, :]
    forced = (jj == 0) | (jj == blk_t[:, None]) | (jj == blk_t[:, None] - 1)
    imp = jnp.where(forced, SEL_FORCE, jnp.where(jj <= blk_t[:, None], imp, -SEL_FORCE))
    _, sel = lax.top_k(imp, top_n)

    kb = k_slc.reshape(B, n_slc, SLC_BLOCK, G, dh).transpose(0, 3, 1, 2, 4)
    vb = v_slc.reshape(B, n_slc, SLC_BLOCK, G, dh).transpose(0, 3, 1, 2, 4)
    nq = S // SLC_Q_CHUNK
    q_ch = q.reshape(B, nq, SLC_Q_CHUNK, G, Hg, dh).transpose(1, 0, 2, 3, 4, 5)
    sel_ch = sel.reshape(B, G, nq, SLC_Q_CHUNK, top_n).transpose(2, 0, 1, 3, 4)
    t_ch = t.reshape(nq, SLC_Q_CHUNK)
    bi = jnp.arange(B)[:, None, None, None]
    gi = jnp.arange(G)[None, :, None, None]
    n_keys = top_n * SLC_BLOCK

    def slc_chunk(args):
        qc, selc, tc = args
        kg = kb[bi, gi, selc]
        vg = vb[bi, gi, selc]
        s = jnp.einsum('bqghd,bgqnrd->bghqnr', qc, kg).astype(jnp.float32) * scale
        pos = selc[..., None] * SLC_BLOCK + jnp.arange(SLC_BLOCK)
        dist = tc[None, None, :, None, None] - pos
        s = s - slopes[None, :, :, None, None, None] * dist[:, :, None].astype(jnp.float32)
        mask = (dist >= 0)[:, :, None].reshape(B, G, 1, SLC_Q_CHUNK, n_keys)
        p = masked_softmax(s.reshape(B, G, Hg, SLC_Q_CHUNK, n_keys), mask)
        p = p.reshape(B, G, Hg, SLC_Q_CHUNK, top_n, SLC_BLOCK)
        return jnp.einsum('bghqnr,bgqnrd->bqghd', p.astype(vg.dtype), vg)

    o_slc = lax.map(slc_chunk, (q_ch, sel_ch, t_ch))
    o_slc = o_slc.transpose(1, 0, 2, 3, 4, 5).reshape(B, S, G, Hg, dh)

    nb = S // WIN_Q_BLOCK
    span = WIN_Q_BLOCK + WINDOW
    kpad = jnp.pad(k_win, ((0, 0), (WINDOW, 0), (0, 0), (0, 0)))
    vpad = jnp.pad(v_win, ((0, 0), (WINDOW, 0), (0, 0), (0, 0)))
    widx = jnp.arange(nb)[:, None] * WIN_Q_BLOCK + jnp.arange(span)[None, :]
    kw = kpad[:, widx]
    vw = vpad[:, widx]
    qw = q.reshape(B, nb, WIN_Q_BLOCK, G, Hg, dh)
    s_w = jnp.einsum('bnqghd,bnkgd->bghnqk', qw, kw).astype(jnp.float32) * scale
    sk = widx - WINDOW
    dist_w = t.reshape(nb, WIN_Q_BLOCK)[:, :, None] - sk[:, None, :]
    mask_w = (dist_w >= 0) & (dist_w < WINDOW) & (sk[:, None, :] >= 0)
    s_w = s_w - slopes[:, :, None, None, None] * dist_w.astype(jnp.float32)
    p_w = masked_softmax(s_w, mask_w)
    o_win = jnp.einsum('bghnqk,bnkgd->bnqghd', p_w.astype(vw.dtype), vw).reshape(B, S, G, Hg, dh)

    gates = jax.nn.sigmoid(gate_logits.reshape(B, S, 3, G, Hg, 1))
    o = gates[:, :, 0] * o_cmp + gates[:, :, 1] * o_slc + gates[:, :, 2] * o_win
    return o.reshape(B, S, NSA_WIDTH)


def retention(q, k, v, g, gn_gain):
    B, S, _ = q.shape
    H, dk, dv, C = RET_HEADS, RET_KEY_DIM, RET_VAL_DIM, RET_CHUNK
    nc = S // C
    f32 = jnp.float32
    qc = q.astype(f32).reshape(B, nc, C, H, dk)
    kc = k.astype(f32).reshape(B, nc, C, H, dk) * (dk ** -0.5)
    vc = v.astype(f32).reshape(B, nc, C, H, dv)
    log_gamma = jnp.log1p(-jnp.exp2(-5.0 - jnp.arange(H, dtype=f32)))
    n = jnp.arange(C, dtype=f32)
    diff = n[:, None] - n[None, :]
    decay = jnp.where(diff >= 0, jnp.exp(log_gamma[:, None, None] * jnp.maximum(diff, 0.0)), 0.0)
    scores = jnp.einsum('bcnhd,bcmhd->bchnm', qc, kc) * decay
    inner = jnp.einsum('bchnm,bcmhe->bcnhe', scores, vc)
    zeta = jnp.exp(log_gamma[:, None] * (C - 1 - n)[None, :])
    kv = jnp.einsum('bcmhd,hm,bcmhe->cbhde', kc, zeta, vc)
    chunk_decay = jnp.exp(log_gamma * C)[None, :, None, None]

    def step(state, kv_i):
        return state * chunk_decay + kv_i, state

    _, prev = lax.scan(step, jnp.zeros((B, H, dk, dv), f32), kv)
    xi = jnp.exp(log_gamma[:, None] * (n + 1.0)[None, :])
    cross = jnp.einsum('bcnhd,cbhde,hn->bcnhe', qc, prev, xi)
    y = (inner + cross).reshape(B, S, H, dv)
    yc = y - jnp.mean(y, -1, keepdims=True)
    y = yc * lax.rsqrt(jnp.mean(yc * yc, -1, keepdims=True) + EPS) * gn_gain.astype(f32)
    out = jax.nn.silu(g.astype(f32).reshape(B, S, H, dv)) * y
    return out.reshape(B, S, RET_V_WIDTH).astype(q.dtype)


def setup_inputs(seed: int = 0) -> dict:
    key = jax.random.key(seed)
    ks = jax.random.split(key, 20)
    f32 = jnp.float32
    dh = NSA_HEAD_DIM

    def nrm(k, shape, fan_in):
        return jax.random.normal(k, shape, f32) * (fan_in ** -0.5)

    return {
        'x': jax.random.normal(ks[0], (BATCH, SEQ, D_MODEL), f32),
        'c': jax.random.normal(ks[1], (BATCH, D_MODEL), f32),
        'w_ada': 0.5 * nrm(ks[2], (DEPTH, D_MODEL, N_ADA * D_MODEL), D_MODEL),
        'b_ada': 0.01 * jax.random.normal(ks[3], (DEPTH, N_ADA * D_MODEL), f32),
        'g_norm': 1.0 + 0.02 * jax.random.normal(ks[4], (DEPTH, 3, D_MODEL), f32),
        'w_ffn_gate': nrm(ks[5], (DEPTH, 2, D_MODEL, D_FF), D_MODEL),
        'w_ffn_up': nrm(ks[6], (DEPTH, 2, D_MODEL, D_FF), D_MODEL),
        'w_ffn_down': nrm(ks[7], (DEPTH, 2, D_FF, D_MODEL), D_FF),
        'w_in': nrm(ks[8], (DEPTH, D_MODEL, N_IN), D_MODEL),
        'g_qk': 1.0 + 0.02 * jax.random.normal(ks[9], (DEPTH, 4, dh), f32),
        'cmp_pos': 0.02 * jax.random.normal(ks[10], (DEPTH, 2, CMP_BLOCK, dh), f32),
        'cmp_w1': nrm(ks[11], (DEPTH, 2, CMP_BLOCK * dh, dh), CMP_BLOCK * dh),
        'cmp_b1': 0.01 * jax.random.normal(ks[12], (DEPTH, 2, dh), f32),
        'cmp_w2': nrm(ks[13], (DEPTH, 2, dh, dh), dh),
        'ret_gn_gain': 1.0 + 0.02 * jax.random.normal(ks[14], (DEPTH, RET_HEADS, RET_VAL_DIM), f32),
        'w_proj_nsa': nrm(ks[15], (DEPTH, NSA_WIDTH, D_MODEL), NSA_WIDTH),
        'w_proj_ret': nrm(ks[16], (DEPTH, RET_V_WIDTH, D_MODEL), RET_V_WIDTH),
        'w_out': nrm(ks[17], (DEPTH, D_MODEL, D_MODEL), D_MODEL),
    }


def reference(x, c, w_ada, b_ada, g_norm, w_ffn_gate, w_ffn_up, w_ffn_down, w_in, g_qk, cmp_pos, cmp_w1, cmp_b1, cmp_w2, ret_gn_gain, w_proj_nsa, w_proj_ret, w_out):
    B, S, D = x.shape
    cond = jax.nn.silu(c)
    split_at = tuple(np.cumsum(IN_SPLITS)[:-1].tolist())
    for l in range(DEPTH):
        ada = (cond @ w_ada[l] + b_ada[l]).reshape(B, N_ADA, 1, D)
        sh1, sc1, gt1, sh2, sc2, gt2, sh3, sc3, gt3 = [ada[:, i] for i in range(N_ADA)]
        h = modulate(x, g_norm[l, 0], sh1, sc1)
        x = x + 0.5 * gt1 * swiglu(h, w_ffn_gate[l, 0], w_ffn_up[l, 0], w_ffn_down[l, 0])
        u = modulate(x, g_norm[l, 1], sh2, sc2)
        q_nsa, kv_nsa, gl_nsa, q_r, k_r, v_r, g_r, ga, gb = jnp.split(u @ w_in[l], split_at, axis=-1)
        o_nsa = nsa_attention(q_nsa, kv_nsa, gl_nsa, g_qk[l], cmp_pos[l], cmp_w1[l], cmp_b1[l], cmp_w2[l])
        o_ret = retention(q_r, k_r, v_r, g_r, ret_gn_gain[l])
        merged = jax.nn.sigmoid(ga) * (o_nsa @ w_proj_nsa[l]) + jax.nn.sigmoid(gb) * (o_ret @ w_proj_ret[l])
        x = x + gt2 * (merged @ w_out[l])
        h = modulate(x, g_norm[l, 2], sh3, sc3)
        x = x + 0.5 * gt3 * swiglu(h, w_ffn_gate[l, 1], w_ffn_up[l, 1], w_ffn_down[l, 1])
    return x
```

```cpp
#include <hip/hip_runtime.h>
#include <hip/hip_cooperative_groups.h>
#include <cstdio>
#include <cstdint>
namespace cg = cooperative_groups;
namespace pg8 {
#define PG8_LAS __attribute__((address_space(3)))
typedef unsigned short bf16_t;
typedef short bf16x8 __attribute__((ext_vector_type(8)));
typedef float f32x4 __attribute__((ext_vector_type(4)));
typedef unsigned u32x4 __attribute__((ext_vector_type(4)));
constexpr int BM = 256, BK = 64, HALF = 128, HTB = HALF * BK * 2  , STAGE_BYTES = 8 * HTB, NXCD = 8, WGM = 8;

__host__ __device__ __forceinline__ int lds_byte(int r, int c) { const int st = (r >> 4) * 2 + (c >> 5), rr = r & 15, cc = c & 31, ob = rr * 64 + cc * 2; return st * 1024 + (ob ^ (((ob >> 9) & 1) << 5)); }
__host__ __device__ __forceinline__ void stage_rc(int b, int& R, int& C) { const int st = b / 1024, sb = b % 1024, swz = sb ^ (((sb >> 9) & 1) << 5); R = (st >> 1) * 16 + swz / 64; C = (st & 1) * 32 + (swz % 64) / 2; }
__host__ __device__ __forceinline__ int perm32(int rho) { const int n = rho >> 4, i = rho & 15; return 8 * (i >> 2) + 4 * n + (i & 3); }

struct Unit { int pm, pn; };
struct Gemm { const bf16_t* A; const bf16_t* Bt; int M, N, K; };

struct StaticOrder {
    int nM, nN, nwg, G, c;
    __host__ __device__ void init(int M, int N, int G_, int c_) { nM = M / BM; nN = N / BM; nwg = nM * nN; G = G_; c = c_; }
    __host__ __device__ bool next(int i, Unit& u) const {
        const long L = (long)i * G + c; if (L >= nwg) return false;
        int wgid = (int)L; { const int q = nwg / NXCD, r = nwg % NXCD, xcd = wgid % NXCD, off = wgid / NXCD; wgid = (xcd < r ? xcd * (q + 1) : r * (q + 1) + (xcd - r) * q) + off; }
        const int nig = WGM * nN, gid = wgid / nig, fm = gid * WGM, gsz = (nM - fm) < WGM ? (nM - fm) : WGM;
        u.pm = fm + ((wgid % nig) % gsz); u.pn = (wgid % nig) / gsz; return true;
    }
    __device__ __forceinline__ void a_ready(const Unit&) const {}
    __device__ __forceinline__ void done(const Unit&) const {}
};

__device__ __forceinline__ unsigned cvt_pk_bf16(float lo, float hi) { unsigned r; asm volatile("v_cvt_pk_bf16_f32 %0, %1, %2" : "=v"(r) : "v"(lo), "v"(hi)); return r; }
typedef float f32x2 __attribute__((ext_vector_type(2)));
template <class Epi, class Sched, bool ALIGN_EPI = false, bool SP2 = false>
__device__ __forceinline__ void gemm_phase(PG8_LAS unsigned char* lds, const Gemm g, const Sched& S, const Epi& E) {
    const int tid = threadIdx.x, wid = __builtin_amdgcn_readfirstlane(tid >> 6), lane = tid & 63, wr = wid >> 2, wc = wid & 3, fr = lane & 15, fq = lane >> 4;
    const int K = g.K, nt = K / BK;
    unsigned voffA[2], voffB[2];
#pragma unroll
    for (int i = 0; i < 2; ++i) { int R, C; stage_rc(tid * 16 + i * 8192, R, C); const int Rb = Epi::PERM ? ((R & ~31) + perm32(R & 31)) : R;
        voffA[i] = (unsigned)(R * K + C) * 2u; voffB[i] = (unsigned)(Rb * K + C) * 2u; }
    const size_t kstep = (size_t)(BK * 2);
    const size_t hstep = (size_t)HALF * K * 2;
    const size_t tstep = 2 * hstep;
    const unsigned ldsw = (unsigned)wid * 1024u;
    const int aoff = lds_byte(wr * 64 + fr, fq * 8), boff = lds_byte(wc * 32 + fr, fq * 8);
#define PG8_SA(b, h) (((b) * 2 + (h)) * HTB)
#define PG8_SB(b, h) ((4 + (b) * 2 + (h)) * HTB)
#define PG8_STAGE(bufoff, gbase, voff) do { _Pragma("unroll") for (int _i = 0; _i < 2; ++_i) \
        __builtin_amdgcn_global_load_lds((const unsigned*)((const char*)(gbase) + (voff)[_i]), (PG8_LAS unsigned*)(lds + (bufoff) + ldsw + _i * 8192), 16, 0, 0); } while (0)
#define PG8_LDA(dst, b, h) do { _Pragma("unroll") for (int m = 0; m < 4; ++m) _Pragma("unroll") for (int k = 0; k < 2; ++k) dst[m][k] = *(const PG8_LAS bf16x8*)(lds + PG8_SA(b, h) + aoff + m * 2048 + k * 1024); } while (0)
#define PG8_LDB(dst, b, h) do { _Pragma("unroll") for (int n = 0; n < 2; ++n) _Pragma("unroll") for (int k = 0; k < 2; ++k) dst[n][k] = *(const PG8_LAS bf16x8*)(lds + PG8_SB(b, h) + boff + n * 2048 + k * 1024); } while (0)
#define PG8_MMA(ai, bj, At, Bt) do { __builtin_amdgcn_s_setprio(1); _Pragma("unroll") for (int m = 0; m < 4; ++m) _Pragma("unroll") for (int n = 0; n < 2; ++n) _Pragma("unroll") for (int k = 0; k < 2; ++k) \
        acc[ai][bj][m][n] = __builtin_amdgcn_mfma_f32_16x16x32_bf16(Bt[n][k], At[m][k], acc[ai][bj][m][n], 0, 0, 0); __builtin_amdgcn_s_setprio(0); } while (0)
#define PG8_WAIT_V(n) asm volatile("s_waitcnt vmcnt(" #n ")" ::: "memory")
#define PG8_WAIT_L(n) asm volatile("s_waitcnt lgkmcnt(" #n ")" ::: "memory")
#define PG8_BAR __builtin_amdgcn_s_barrier()
#define PG8_SCHED __builtin_amdgcn_sched_barrier(0)
    Unit cur, nxt; int ui = 0;
    if (!S.next(0, cur)) return;
    f32x4 acc[2][2][4][2];
#pragma unroll
    for (int a = 0; a < 2; ++a)
#pragma unroll
        for (int b = 0; b < 2; ++b)
#pragma unroll
            for (int m = 0; m < 4; ++m)
#pragma unroll
                for (int n = 0; n < 2; ++n) acc[a][b][m][n] = (f32x4){0.f, 0.f, 0.f, 0.f};
    bf16x8 At[4][2], B0[2][2], B1[2][2];
    const char* cA = (const char*)g.A + (size_t)cur.pm * tstep; const char* cB = (const char*)g.Bt + (size_t)cur.pn * tstep;
    S.a_ready(cur);
    if constexpr (SP2) {
        PG8_STAGE(PG8_SB(0, 0), cB, voffB); PG8_STAGE(PG8_SB(0, 1), cB + hstep, voffB); PG8_STAGE(PG8_SA(0, 0), cA, voffA); PG8_STAGE(PG8_SA(0, 1), cA + hstep, voffA);
        if (wr == 1) PG8_BAR;
        PG8_WAIT_V(2); PG8_BAR;
        PG8_STAGE(PG8_SB(1, 0), cB + kstep, voffB); PG8_STAGE(PG8_SA(1, 0), cA + kstep, voffA); PG8_STAGE(PG8_SB(1, 1), cB + hstep + kstep, voffB);
        PG8_WAIT_V(6); PG8_BAR;
    } else {
        PG8_STAGE(PG8_SB(0, 0), cB, voffB); PG8_STAGE(PG8_SA(0, 0), cA, voffA); PG8_STAGE(PG8_SB(0, 1), cB + hstep, voffB); PG8_STAGE(PG8_SA(0, 1), cA + hstep, voffA);
        if (wr == 1) PG8_BAR;
        PG8_WAIT_V(4); PG8_BAR;
        PG8_STAGE(PG8_SB(1, 0), cB + kstep, voffB); PG8_STAGE(PG8_SA(1, 0), cA + kstep, voffA); PG8_STAGE(PG8_SB(1, 1), cB + hstep + kstep, voffB);
        PG8_WAIT_V(6); PG8_BAR;
    }
    for (;;) {
        const bool has_next = S.next(ui + 1, nxt);
        const char* nA = has_next ? (const char*)g.A + (size_t)nxt.pm * tstep : cA; const char* nB = has_next ? (const char*)g.Bt + (size_t)nxt.pn * tstep : cB;
        for (int t = 0; t < nt; t += 2) {
            const bool last = (t == nt - 2);
            const char* a1 = cA + (size_t)(t + 1) * kstep;
            const char* a2 = last ? nA : cA + (size_t)(t + 2) * kstep; const char* b2 = last ? nB : cB + (size_t)(t + 2) * kstep;
            const char* a3 = a2 + kstep; const char* b3 = b2 + kstep;
            if (last && has_next) S.a_ready(nxt);
            if constexpr (SP2) {
            PG8_LDB(B0, 0, 0); PG8_LDB(B1, 0, 1); PG8_SCHED; PG8_LDA(At, 0, 0); PG8_STAGE(PG8_SA(1, 1), a1 + hstep, voffA);
            PG8_WAIT_V(8); PG8_WAIT_L(0); PG8_BAR; PG8_MMA(0, 0, At, B0); PG8_MMA(0, 1, At, B1); PG8_BAR; PG8_SCHED;
            PG8_LDA(At, 0, 1); PG8_STAGE(PG8_SB(0, 0), b2, voffB); PG8_STAGE(PG8_SB(0, 1), b2 + hstep, voffB); PG8_STAGE(PG8_SA(0, 0), a2, voffA);
            PG8_WAIT_V(8); PG8_WAIT_L(0); PG8_BAR; PG8_MMA(1, 0, At, B0); PG8_MMA(1, 1, At, B1); PG8_BAR; PG8_SCHED;
            PG8_LDB(B0, 1, 0); PG8_LDB(B1, 1, 1); PG8_SCHED; PG8_LDA(At, 1, 0); PG8_STAGE(PG8_SA(0, 1), a2 + hstep, voffA);
            PG8_WAIT_V(8); PG8_WAIT_L(0); PG8_BAR; PG8_MMA(0, 0, At, B0); PG8_MMA(0, 1, At, B1); PG8_BAR; PG8_SCHED;
            PG8_LDA(At, 1, 1); PG8_STAGE(PG8_SB(1, 0), b3, voffB); PG8_STAGE(PG8_SB(1, 1), b3 + hstep, voffB); PG8_STAGE(PG8_SA(1, 0), a3, voffA);
            PG8_WAIT_V(8); PG8_WAIT_L(0); PG8_BAR; PG8_MMA(1, 0, At, B0); PG8_MMA(1, 1, At, B1); PG8_BAR; PG8_SCHED;
            } else {
            PG8_LDB(B0, 0, 0); PG8_SCHED; PG8_LDA(At, 0, 0); PG8_STAGE(PG8_SA(1, 1), a1 + hstep, voffA);
            PG8_WAIT_L(8); PG8_BAR; PG8_WAIT_L(0); PG8_MMA(0, 0, At, B0); PG8_BAR; PG8_SCHED;
            PG8_LDB(B1, 0, 1); PG8_STAGE(PG8_SB(0, 0), b2, voffB);
            PG8_BAR; PG8_WAIT_L(0); PG8_MMA(0, 1, At, B1); PG8_BAR;
            PG8_LDA(At, 0, 1); PG8_STAGE(PG8_SA(0, 0), a2, voffA);
            PG8_BAR; PG8_WAIT_L(0); PG8_MMA(1, 0, At, B0); PG8_BAR; PG8_SCHED;
            PG8_STAGE(PG8_SB(0, 1), b2 + hstep, voffB);
            PG8_WAIT_V(6); PG8_BAR; PG8_MMA(1, 1, At, B1); PG8_BAR;
            PG8_LDB(B0, 1, 0); PG8_SCHED; PG8_LDA(At, 1, 0); PG8_STAGE(PG8_SA(0, 1), a2 + hstep, voffA);
            PG8_WAIT_L(8); PG8_BAR; PG8_WAIT_L(0); PG8_MMA(0, 0, At, B0); PG8_BAR; PG8_SCHED;
            PG8_LDB(B1, 1, 1); PG8_STAGE(PG8_SB(1, 0), b3, voffB);
            PG8_BAR; PG8_WAIT_L(0); PG8_MMA(0, 1, At, B1); PG8_BAR;
            PG8_LDA(At, 1, 1); PG8_STAGE(PG8_SA(1, 0), a3, voffA);
            PG8_BAR; PG8_WAIT_L(0); PG8_MMA(1, 0, At, B0); PG8_BAR; PG8_SCHED;
            PG8_STAGE(PG8_SB(1, 1), b3 + hstep, voffB);
            PG8_WAIT_V(6); PG8_BAR; PG8_MMA(1, 1, At, B1); PG8_BAR;
            }
        }
        if constexpr (ALIGN_EPI) { if (wr == 0) PG8_BAR; }
        if constexpr (!Epi::AFTER_DRAIN) { E(acc, cur, wr, wc, fr, fq); S.done(cur); }
        if (!has_next) break;
#pragma unroll
        for (int a = 0; a < 2; ++a)
#pragma unroll
            for (int b = 0; b < 2; ++b)
#pragma unroll
                for (int m = 0; m < 4; ++m)
#pragma unroll
                    for (int n = 0; n < 2; ++n) acc[a][b][m][n] = (f32x4){0.f, 0.f, 0.f, 0.f};
        cur = nxt; cA = nA; cB = nB; ++ui;
        if constexpr (ALIGN_EPI) { if (wr == 1) PG8_BAR; }
    }
    PG8_WAIT_V(0);
    if constexpr (!ALIGN_EPI) { if (wr == 0) PG8_BAR; }
    PG8_BAR;
    if constexpr (Epi::AFTER_DRAIN) { E.fused(acc, cur, wr, wc, fr, fq, lds, wid, lane); S.done(cur); }
#undef PG8_SA
#undef PG8_SB
#undef PG8_STAGE
#undef PG8_LDA
#undef PG8_LDB
#undef PG8_MMA
#undef PG8_WAIT_V
#undef PG8_WAIT_L
#undef PG8_BAR
#undef PG8_SCHED
}
}

#define LAS __attribute__((address_space(3)))
typedef unsigned short bf16_t;
typedef short bf16x8 __attribute__((ext_vector_type(8)));
typedef short s16x4 __attribute__((ext_vector_type(4)));
typedef float f32x4 __attribute__((ext_vector_type(4)));
typedef unsigned u32x4 __attribute__((ext_vector_type(4)));
typedef unsigned u32x2 __attribute__((ext_vector_type(2)));

constexpr int T_ = 8192, D_ = 2048, FF_ = 5632, NIN_ = 15408, LDY = 15616, NADA = 18432;
constexpr int OFF_Q = 0, OFF_KV = 2048, OFF_QR = 5120, OFF_KR = 6144, OFF_VR = 7168, OFF_GR = 9216, OFF_GA = 11264, OFF_GB = 13312, OFF_GL = 15360;
constexpr float LOG2E = 1.4426950408889634f;
constexpr float EPS_ = 1e-6f;

constexpr size_t al256(size_t x) { return (x + 255) & ~(size_t)255; }
constexpr size_t WS_CTL = 0;
constexpr size_t WS_ADA = 4096;
constexpr size_t WS_WGU = al256(WS_ADA + (size_t)4 * NADA * 4);
constexpr size_t WS_WD  = WS_WGU + (size_t)2 * FF_ * D_ * 2;
constexpr size_t WS_WIN = WS_WD + (size_t)D_ * FF_ * 2;
constexpr size_t WS_WPN = WS_WIN + (size_t)LDY * D_ * 2;
constexpr size_t WS_WPR = WS_WPN + (size_t)D_ * D_ * 2;
constexpr size_t WS_WO  = WS_WPR + (size_t)D_ * D_ * 2;
constexpr size_t WS_WC1 = WS_WO + (size_t)D_ * D_ * 2;
constexpr size_t WS_WC2 = WS_WC1 + (size_t)2 * 128 * 4096 * 2;
constexpr size_t WS_H   = WS_WC2 + (size_t)2 * 128 * 128 * 2;
constexpr size_t WS_Y   = WS_H + (size_t)T_ * D_ * 2;
constexpr size_t WS_MG  = WS_Y + (size_t)T_ * LDY * 2;
constexpr size_t WS_ORET = WS_MG + (size_t)T_ * D_ * 2;
constexpr size_t WS_VTS = WS_ORET + (size_t)T_ * D_ * 2;
constexpr size_t WS_VTW = WS_VTS + (size_t)16 * 128 * 2048 * 2;
constexpr size_t WS_VTR = WS_VTW + (size_t)16 * 128 * 2048 * 2;
constexpr size_t WS_KC  = WS_VTR + (size_t)32 * 256 * 2048 * 2;
constexpr size_t WS_VCT = WS_KC + (size_t)16 * 128 * 128 * 2;
constexpr size_t WS_END = WS_VCT + (size_t)16 * 128 * 128 * 2;

constexpr int LDS_BYTES = 131072 + 2048;

using pg8::cvt_pk_bf16;
__device__ __forceinline__ float bf_lo(unsigned w) { return __uint_as_float(w << 16); }
__device__ __forceinline__ float bf_hi(unsigned w) { return __uint_as_float(w & 0xffff0000u); }
__device__ __forceinline__ float bf2f(bf16_t h) { return __uint_as_float((unsigned)h << 16); }
__device__ __forceinline__ float ex2(float x) { return __builtin_amdgcn_exp2f(x); }
__device__ __forceinline__ float sigmoid_f(float x) { return __builtin_amdgcn_rcpf(1.0f + ex2(-x * LOG2E)); }
__device__ __forceinline__ float silu_f(float x) { return x * sigmoid_f(x); }
__device__ __forceinline__ float wave_sum(float v) {
#pragma unroll
    for (int o = 1; o < 64; o <<= 1) v += __shfl_xor(v, o);
    return v;
}
#define MFMA16(a, b, c) __builtin_amdgcn_mfma_f32_16x16x32_bf16((a), (b), (c), 0, 0, 0)

struct EpiSwiglu {
    static constexpr bool PERM = true, AFTER_DRAIN = false;
    bf16_t* O;
    __device__ __forceinline__ void operator()(const f32x4 (&acc)[2][2][4][2], const pg8::Unit& u, int wr, int wc, int fr, int fq) const {
        const int row0 = u.pm * 256 + wr * 64 + fr, col0 = u.pn * 128 + wc * 32 + 8 * fq;
#pragma unroll
        for (int ai = 0; ai < 2; ++ai)
#pragma unroll
            for (int m = 0; m < 4; ++m) {
                bf16_t* rowp = O + (size_t)(row0 + ai * 128 + m * 16) * FF_ + col0;
                const f32x4 g0 = acc[ai][0][m][0], g1 = acc[ai][0][m][1], u0 = acc[ai][1][m][0], u1 = acc[ai][1][m][1];
                u32x4 w;
                w.x = cvt_pk_bf16(silu_f(g0[0]) * u0[0], silu_f(g0[1]) * u0[1]);
                w.y = cvt_pk_bf16(silu_f(g0[2]) * u0[2], silu_f(g0[3]) * u0[3]);
                w.z = cvt_pk_bf16(silu_f(g1[0]) * u1[0], silu_f(g1[1]) * u1[1]);
                w.w = cvt_pk_bf16(silu_f(g1[2]) * u1[2], silu_f(g1[3]) * u1[3]);
                *(u32x4*)rowp = w;
            }
    }
};
struct EpiResid {
    static constexpr bool PERM = false, AFTER_DRAIN = false;
    const float* base; float* out; const float* gate; float coef;
    __device__ __forceinline__ void operator()(const f32x4 (&acc)[2][2][4][2], const pg8::Unit& u, int wr, int wc, int fr, int fq) const {
        const int row0 = u.pm * 256 + wr * 64 + fr, col0 = u.pn * 256 + wc * 32 + 4 * fq, b = u.pm >> 3;
        f32x4 gv[2][2];
#pragma unroll
        for (int bj = 0; bj < 2; ++bj)
#pragma unroll
            for (int n = 0; n < 2; ++n) gv[bj][n] = *(const f32x4*)(gate + (size_t)b * NADA + col0 + bj * 128 + n * 16) * coef;
#pragma unroll
        for (int ai = 0; ai < 2; ++ai)
#pragma unroll
            for (int m = 0; m < 4; ++m) {
                const size_t off = (size_t)(row0 + ai * 128 + m * 16) * D_ + col0;
#pragma unroll
                for (int bj = 0; bj < 2; ++bj)
#pragma unroll
                    for (int n = 0; n < 2; ++n) {
                        const size_t o = off + bj * 128 + n * 16;
                        *(f32x4*)(out + o) = *(const f32x4*)(base + o) + gv[bj][n] * acc[ai][bj][m][n];
                    }
            }
    }
};
struct EpiY {
    static constexpr bool PERM = true, AFTER_DRAIN = false;
    bf16_t* O;
    __device__ __forceinline__ void operator()(const f32x4 (&acc)[2][2][4][2], const pg8::Unit& u, int wr, int wc, int fr, int fq) const {
        const int row0 = u.pm * 256 + wr * 64 + fr, col0 = u.pn * 256 + wc * 32 + 8 * fq;
#pragma unroll
        for (int ai = 0; ai < 2; ++ai)
#pragma unroll
            for (int m = 0; m < 4; ++m) {
                bf16_t* rowp = O + (size_t)(row0 + ai * 128 + m * 16) * LDY + col0;
#pragma unroll
                for (int bj = 0; bj < 2; ++bj) {
                    const f32x4 v0 = acc[ai][bj][m][0], v1 = acc[ai][bj][m][1];
                    u32x4 w; w.x = cvt_pk_bf16(v0[0], v0[1]); w.y = cvt_pk_bf16(v0[2], v0[3]); w.z = cvt_pk_bf16(v1[0], v1[1]); w.w = cvt_pk_bf16(v1[2], v1[3]);
                    *(u32x4*)(rowp + bj * 128) = w;
                }
            }
    }
};
template <bool ADD> struct EpiMerge {
    static constexpr bool PERM = true, AFTER_DRAIN = false;
    bf16_t* O; const bf16_t* Yg; int goff;
    __device__ __forceinline__ void operator()(const f32x4 (&acc)[2][2][4][2], const pg8::Unit& u, int wr, int wc, int fr, int fq) const {
        const int row0 = u.pm * 256 + wr * 64 + fr, col0 = u.pn * 256 + wc * 32 + 8 * fq;
#pragma unroll
        for (int ai = 0; ai < 2; ++ai)
#pragma unroll
            for (int m = 0; m < 4; ++m) {
                const int row = row0 + ai * 128 + m * 16;
#pragma unroll
                for (int bj = 0; bj < 2; ++bj) {
                    const int col = col0 + bj * 128;
                    const u32x4 gw = *(const u32x4*)(Yg + (size_t)row * LDY + goff + col);
                    const f32x4 v0 = acc[ai][bj][m][0], v1 = acc[ai][bj][m][1];
                    float r[8];
                    r[0] = sigmoid_f(bf_lo(gw.x)) * v0[0]; r[1] = sigmoid_f(bf_hi(gw.x)) * v0[1];
                    r[2] = sigmoid_f(bf_lo(gw.y)) * v0[2]; r[3] = sigmoid_f(bf_hi(gw.y)) * v0[3];
                    r[4] = sigmoid_f(bf_lo(gw.z)) * v1[0]; r[5] = sigmoid_f(bf_hi(gw.z)) * v1[1];
                    r[6] = sigmoid_f(bf_lo(gw.w)) * v1[2]; r[7] = sigmoid_f(bf_hi(gw.w)) * v1[3];
                    bf16_t* op = O + (size_t)row * D_ + col;
                    if (ADD) {
                        const u32x4 pw = *(const u32x4*)op;
                        r[0] += bf_lo(pw.x); r[1] += bf_hi(pw.x); r[2] += bf_lo(pw.y); r[3] += bf_hi(pw.y);
                        r[4] += bf_lo(pw.z); r[5] += bf_hi(pw.z); r[6] += bf_lo(pw.w); r[7] += bf_hi(pw.w);
                    }
                    u32x4 w; w.x = cvt_pk_bf16(r[0], r[1]); w.y = cvt_pk_bf16(r[2], r[3]); w.z = cvt_pk_bf16(r[4], r[5]); w.w = cvt_pk_bf16(r[6], r[7]);
                    *(u32x4*)op = w;
                }
            }
    }
};

__device__ __forceinline__ int rowmap(int mode, int n) {
    if (mode == 0) return n;
    if (mode == 1) return ((n >> 7) << 8) + (n & 127);
    if (mode == 2) return ((n >> 7) << 8) + 128 + (n & 127);
    return n < 5120 ? n : (n < 5168 ? OFF_GL + (n - 5120) : n - 48);
}
__device__ __forceinline__ void transpose_item(const float* __restrict__ W, int K, int N, bf16_t* __restrict__ WT, int mode, LAS float* scr, int item, int lane) {
    const int nblk = (N + 31) >> 5, kb = item / nblk, nb = item - kb * nblk, k0 = 64 * kb, n0 = 32 * nb;
    const bool cok = (n0 + (lane & 31)) < N;
#pragma unroll 8
    for (int i = 0; i < 32; ++i) { const int kk = 2 * i + (lane >> 5); scr[kk * 33 + (lane & 31)] = cok ? W[(size_t)(k0 + kk) * N + n0 + (lane & 31)] : 0.f; }
    asm volatile("s_waitcnt lgkmcnt(0)" ::: "memory");
    const int c = lane & 7;
#pragma unroll
    for (int j = 0; j < 4; ++j) {
        const int n = (lane >> 3) + 8 * j; const LAS float* s = scr + (8 * c) * 33 + n;
        u32x4 o; o.x = cvt_pk_bf16(s[0 * 33], s[1 * 33]); o.y = cvt_pk_bf16(s[2 * 33], s[3 * 33]); o.z = cvt_pk_bf16(s[4 * 33], s[5 * 33]); o.w = cvt_pk_bf16(s[6 * 33], s[7 * 33]);
        if (n0 + n < N) *(u32x4*)(WT + (size_t)rowmap(mode, n0 + n) * K + k0 + 8 * c) = o;
    }
    asm volatile("s_waitcnt lgkmcnt(0)" ::: "memory");
}

__device__ __forceinline__ void norm_rows(const float* __restrict__ X, const float* __restrict__ g, const float* __restrict__ ada, int ish, int isc, bf16_t* __restrict__ H, int gw, int NGW, int lane) {
    for (int m = gw; m < T_; m += NGW) {
        const int b = m >> 11;
        const f32x4* xr = (const f32x4*)(X + (size_t)m * D_) + lane;
        f32x4 v[8]; float ss = 0.f;
#pragma unroll
        for (int j = 0; j < 8; ++j) { v[j] = xr[64 * j]; ss += (v[j].x * v[j].x + v[j].y * v[j].y) + (v[j].z * v[j].z + v[j].w * v[j].w); }
        const float r = 1.0f / sqrtf(wave_sum(ss) * (1.0f / D_) + EPS_);
        const f32x4* gp = (const f32x4*)g + lane;
        const f32x4* sh = (const f32x4*)(ada + (size_t)b * NADA + ish * D_) + lane;
        const f32x4* sc = (const f32x4*)(ada + (size_t)b * NADA + isc * D_) + lane;
        u32x2* o = (u32x2*)(H + (size_t)m * D_) + lane;
#pragma unroll
        for (int j = 0; j < 8; ++j) {
            const f32x4 y = v[j] * r * gp[64 * j] * (sc[64 * j] + 1.0f) + sh[64 * j];
            u32x2 w; w.x = cvt_pk_bf16(y.x, y.y); w.y = cvt_pk_bf16(y.z, y.w); o[64 * j] = w;
        }
    }
}

template <int NR, int NDT, int MODE>
__device__ __forceinline__ void att_step(const bf16_t* __restrict__ Kp, const bf16_t* __restrict__ Vt, int k0, int tq  , int koff  , int voff  ,
                                         const LAS bf16x8* qs, f32x4 (&O)[NR][NDT], float (&m)[NR], float (&l)[NR], const float (&coef)[NR], bool vblk) {
    constexpr float SC = 0.08838834764831845f;
    const bf16_t* kb = Kp + (size_t)k0 * LDY + koff;
    const bf16_t* vb = Vt + k0 + voff;
    const int dq = tq - k0;
    f32x4 sa[NR][2];
#pragma unroll
    for (int kt = 0; kt < 2; ++kt) {
        bf16x8 kf[4];
#pragma unroll
        for (int dc = 0; dc < 4; ++dc) kf[dc] = *(const bf16x8*)(kb + 16 * kt * LDY + 32 * dc);
#pragma unroll
        for (int r = 0; r < NR; ++r) { sa[r][kt] = (f32x4){0.f, 0.f, 0.f, 0.f};
#pragma unroll
            for (int dc = 0; dc < 4; ++dc) sa[r][kt] = MFMA16(kf[dc], qs[(r * 4 + dc) * 64], sa[r][kt]); }
        __builtin_amdgcn_sched_barrier(0);
    }
    bf16x8 Pb[NR];
    const float dqf = (float)dq;
#pragma unroll
    for (int r = 0; r < NR; ++r) {
        f32x4 s[2]; s[0] = sa[r][0]; s[1] = sa[r][1];
        float p[2][4];
        if (MODE == 2) {
#pragma unroll
            for (int kt = 0; kt < 2; ++kt)
#pragma unroll
                for (int j = 0; j < 4; ++j) { const bool valid = dq >= (16 * kt + j); p[kt][j] = valid ? s[kt][j] * SC * ex2(coef[r] * (dqf - (float)(16 * kt + j))) : 0.f; }
        } else {
            float mx = -INFINITY;
#pragma unroll
            for (int kt = 0; kt < 2; ++kt)
#pragma unroll
                for (int j = 0; j < 4; ++j) {
                    const bool valid = (MODE == 0) ? (vblk && dq >= (16 * kt + j)) : (dq >= (16 * kt + j) && dq < 512 + (16 * kt + j));
                    const float v = valid ? s[kt][j] * (SC * LOG2E) - coef[r] * (dqf - (float)(16 * kt + j)) : -INFINITY;
                    p[kt][j] = v; mx = fmaxf(mx, v);
                }
            mx = fmaxf(mx, __shfl_xor(mx, 16)); mx = fmaxf(mx, __shfl_xor(mx, 32));
            const float mnew = fmaxf(m[r], mx), muse = (mnew == -INFINITY) ? 0.f : mnew;
            const float alpha = ex2(m[r] - muse);
            float ps = 0.f;
#pragma unroll
            for (int kt = 0; kt < 2; ++kt)
#pragma unroll
                for (int j = 0; j < 4; ++j) { p[kt][j] = ex2(p[kt][j] - muse); ps += p[kt][j]; }
            l[r] = l[r] * alpha + ps; m[r] = mnew;
#pragma unroll
            for (int dt = 0; dt < NDT; ++dt) O[r][dt] *= alpha;
        }
        u32x4 pw; pw.x = cvt_pk_bf16(p[0][0], p[0][1]); pw.y = cvt_pk_bf16(p[0][2], p[0][3]); pw.z = cvt_pk_bf16(p[1][0], p[1][1]); pw.w = cvt_pk_bf16(p[1][2], p[1][3]);
        Pb[r] = __builtin_bit_cast(bf16x8, pw);
    }
#pragma unroll
    for (int dt = 0; dt < NDT; ++dt) {
        const bf16_t* vp = vb + 16 * dt * 2048;
        const s16x4 lo = *(const s16x4*)vp, hi = *(const s16x4*)(vp + 16);
        const bf16x8 vf = __builtin_shufflevector(lo, hi, 0, 1, 2, 3, 4, 5, 6, 7);
#pragma unroll
        for (int r = 0; r < NR; ++r) O[r][dt] = MFMA16(vf, Pb[r], O[r][dt]);
        if ((dt & 3) == 3) __builtin_amdgcn_sched_barrier(0);
    }
}

struct MixPtrs { const bf16_t* Y; bf16_t* ONSA; bf16_t* ORET; const bf16_t* VTS; const bf16_t* VTW; const bf16_t* VTR; const bf16_t* KC; const bf16_t* VCT; const float* gn; };

__device__ __forceinline__ void nsa_unit(const MixPtrs& P, int b, int g, int tile, int lane, LAS bf16x8* qs  ) {
    const int l15 = lane & 15, fq = lane >> 4, t0 = tile * 16, t = t0 + l15, bg = b * 4 + g;
    const bf16_t* Yb = P.Y + (size_t)(b * 2048) * LDY;
    const bf16_t* Yt = Yb + (size_t)t * LDY;
    bf16_t* orow = P.ONSA + (size_t)(b * 2048 + t) * D_;
    constexpr float SC2 = 0.08838834764831845f * LOG2E;
    const int tq64 = t - 64 * fq; const float tq64f = (float)tq64 - 15.5f;
    const int tq = t - 4 * fq, koff = l15 * LDY + 8 * fq, voff = l15 * 2048 + 4 * fq;
    float psum[8][4];
#pragma unroll
    for (int kt = 0; kt < 8; ++kt)
#pragma unroll
        for (int j = 0; j < 4; ++j) psum[kt][j] = 0.f;
#pragma unroll
    for (int hd = 0; hd < 4; ++hd)
#pragma unroll
        for (int dc = 0; dc < 4; ++dc) qs[(hd * 4 + dc) * 64] = *(const bf16x8*)(Yt + OFF_Q + (4 * g + hd) * 128 + 32 * dc + 8 * fq);
#ifndef NO_CMP
#pragma unroll 1
    for (int hd = 0; hd < 4; ++hd) {
        const int hh = 4 * g + hd;
        const bf16_t* kcb = P.KC + (size_t)(bg * 128 + l15) * 128 + 8 * fq;
        const bf16_t* vcb = P.VCT + (size_t)(bg * 128 + l15) * 128 + 4 * fq;
        asm volatile("" : "+v"(kcb), "+v"(vcb));
        bf16x8 Qf[4];
#pragma unroll
        for (int dc = 0; dc < 4; ++dc) Qf[dc] = qs[(hd * 4 + dc) * 64];
        f32x4 s[8];
#pragma unroll
        for (int kt = 0; kt < 8; ++kt) { s[kt] = (f32x4){0.f, 0.f, 0.f, 0.f};
#pragma unroll
            for (int dc = 0; dc < 4; ++dc) { const bf16x8 kf = *(const bf16x8*)(kcb + 16 * kt * 128 + 32 * dc); s[kt] = MFMA16(kf, Qf[dc], s[kt]); }
            if (kt & 1) __builtin_amdgcn_sched_barrier(0); }
        const float slope2 = ex2(-0.5f * (float)(hh + 1)) * LOG2E;
        float mx = -INFINITY;
#pragma unroll
        for (int kt = 0; kt < 8; ++kt)
#pragma unroll
            for (int j = 0; j < 4; ++j) {
                const bool valid = (256 * kt + 16 * j + 31) <= tq64;
                const float v = valid ? s[kt][j] * SC2 - slope2 * (tq64f - (float)(256 * kt + 16 * j)) : -INFINITY;
                s[kt][j] = v; mx = fmaxf(mx, v);
            }
        mx = fmaxf(mx, __shfl_xor(mx, 16)); mx = fmaxf(mx, __shfl_xor(mx, 32));
        const float muse = (mx == -INFINITY) ? 0.f : mx;
        float ls = 0.f;
#pragma unroll
        for (int kt = 0; kt < 8; ++kt)
#pragma unroll
            for (int j = 0; j < 4; ++j) { const float pv = ex2(s[kt][j] - muse); s[kt][j] = pv; ls += pv; }
        ls += __shfl_xor(ls, 16); ls += __shfl_xor(ls, 32);
        const float inv = 1.0f / fmaxf(ls, 1.17549435e-38f);
#pragma unroll
        for (int kt = 0; kt < 8; ++kt)
#pragma unroll
            for (int j = 0; j < 4; ++j) { s[kt][j] *= inv; psum[kt][j] += s[kt][j]; }
        f32x4 O[8];
#pragma unroll
        for (int dt = 0; dt < 8; ++dt) O[dt] = (f32x4){0.f, 0.f, 0.f, 0.f};
#pragma unroll
        for (int ks = 0; ks < 4; ++ks) {
            u32x4 pw; pw.x = cvt_pk_bf16(s[2 * ks][0], s[2 * ks][1]); pw.y = cvt_pk_bf16(s[2 * ks][2], s[2 * ks][3]);
            pw.z = cvt_pk_bf16(s[2 * ks + 1][0], s[2 * ks + 1][1]); pw.w = cvt_pk_bf16(s[2 * ks + 1][2], s[2 * ks + 1][3]);
            const bf16x8 Pb = __builtin_bit_cast(bf16x8, pw);
#pragma unroll
            for (int dt = 0; dt < 8; ++dt) {
                const bf16_t* vp = vcb + 16 * dt * 128 + 32 * ks;
                const s16x4 lo = *(const s16x4*)vp, hi = *(const s16x4*)(vp + 16);
                O[dt] = MFMA16(__builtin_shufflevector(lo, hi, 0, 1, 2, 3, 4, 5, 6, 7), Pb, O[dt]);
            }
            __builtin_amdgcn_sched_barrier(0);
        }
        const float gate = sigmoid_f(bf2f(Yt[OFF_GL + hh]));
#pragma unroll
        for (int dt = 0; dt < 8; ++dt) {
            u32x2 w; w.x = cvt_pk_bf16(O[dt][0] * gate, O[dt][1] * gate); w.y = cvt_pk_bf16(O[dt][2] * gate, O[dt][3] * gate);
            *(u32x2*)(orow + hh * 128 + 16 * dt + 4 * fq) = w;
        }
    }
#endif
    unsigned sm = 0;
#ifdef NO_SEL
    sm = (unsigned)Yt[0];
#endif
#ifndef NO_SEL
    {
        float val[8], tail[8], sh[8];
        const int bq = (t >> 6) - fq;
#pragma unroll
        for (int kt = 0; kt < 8; ++kt) { tail[kt] = 0.5f * psum[kt][3]; sh[kt] = __shfl(tail[kt], (lane + 48) & 63); }
#pragma unroll
        for (int kt = 0; kt < 8; ++kt) {
            const float prev = fq > 0 ? sh[kt] : (kt > 0 ? sh[kt > 0 ? kt - 1 : 0] : 0.f);
            const float imp = ((psum[kt][0] + psum[kt][1]) + psum[kt][2]) + tail[kt] + prev;
            const bool forced = (kt == 0 && fq == 0) || (4 * kt == bq) || (4 * kt == bq - 1);
            val[kt] = forced ? 1e4f : (4 * kt <= bq ? imp : -1e4f);
        }
        int cnt[8];
#pragma unroll
        for (int kt = 0; kt < 8; ++kt) cnt[kt] = 0;
#pragma unroll 1
        for (int f2 = 0; f2 < 4; ++f2) {
            const int df = fq - f2;
#pragma unroll
            for (int k2 = 0; k2 < 8; ++k2) {
                const float o = __shfl(val[k2], l15 + 16 * f2);
#pragma unroll
                for (int kt = 0; kt < 8; ++kt) cnt[kt] += ((o > val[kt]) || (o == val[kt] && (4 * (k2 - kt)) < df)) ? 1 : 0;
            }
        }
        unsigned smq = 0;
#pragma unroll
        for (int kt = 0; kt < 8; ++kt) if (cnt[kt] < 16) smq |= 1u << (4 * kt);
        sm = smq << fq;
        sm |= __shfl_xor(sm, 16); sm |= __shfl_xor(sm, 32);
    }
#endif
#ifndef NO_SW
#pragma unroll 1
    for (int hp = 0; hp < 2; ++hp) {
        float coef[2], m[2], l[2]; f32x4 O[2][8];
        const LAS bf16x8* Qf = qs + hp * 8 * 64;
#pragma unroll
        for (int r = 0; r < 2; ++r) coef[r] = ex2(-0.5f * (float)(4 * g + 2 * hp + r + 1)) * LOG2E;
#pragma unroll 1
        for (int br = 1; br < 3; ++br) {
#pragma unroll
            for (int r = 0; r < 2; ++r) { m[r] = -INFINITY; l[r] = 0.f;
#pragma unroll
                for (int dt = 0; dt < 8; ++dt) O[r][dt] = (f32x4){0.f, 0.f, 0.f, 0.f}; }
            if (br == 1) {
                const bf16_t* Kp = Yb + OFF_KV + 2 * 512 + g * 128; const bf16_t* Vt = P.VTS + (size_t)(bg * 128) * 2048;
                const int blkmax = (t0 + 15) >> 6;
#pragma unroll 1
                for (int jb = 0; jb <= blkmax; ++jb) {
                    const bool vb = (sm >> jb) & 1u;
                    if (__ballot(vb) == 0ull) continue;
                    att_step<2, 8, 0>(Kp, Vt, 64 * jb, tq, koff, voff, Qf, O, m, l, coef, vb);
                    att_step<2, 8, 0>(Kp, Vt, 64 * jb + 32, tq, koff, voff, Qf, O, m, l, coef, vb);
                }
            } else {
                const bf16_t* Kp = Yb + OFF_KV + 4 * 512 + g * 128; const bf16_t* Vt = P.VTW + (size_t)(bg * 128) * 2048;
                int kstart = t0 - 511; kstart = kstart < 0 ? 0 : (kstart & ~31);
#pragma unroll 1
                for (int k0 = kstart; k0 <= t0; k0 += 32) att_step<2, 8, 1>(Kp, Vt, k0, tq, koff, voff, Qf, O, m, l, coef, true);
            }
#pragma unroll
            for (int r = 0; r < 2; ++r) {
                const int hh = 4 * g + 2 * hp + r;
                float lt = l[r]; lt += __shfl_xor(lt, 16); lt += __shfl_xor(lt, 32);
                const float sc = sigmoid_f(bf2f(Yt[OFF_GL + br * 16 + hh])) / fmaxf(lt, 1.17549435e-38f);
#pragma unroll
                for (int dt = 0; dt < 8; ++dt) {
                    u32x2* op = (u32x2*)(orow + hh * 128 + 16 * dt + 4 * fq);
                    const u32x2 pw = *op;
                    u32x2 w; w.x = cvt_pk_bf16(bf_lo(pw.x) + O[r][dt][0] * sc, bf_hi(pw.x) + O[r][dt][1] * sc);
                    w.y = cvt_pk_bf16(bf_lo(pw.y) + O[r][dt][2] * sc, bf_hi(pw.y) + O[r][dt][3] * sc);
                    *op = w;
                }
            }
        }
    }
#endif
}

__device__ __forceinline__ void ret_unit(const MixPtrs& P, int b, int h, int tile, int lane, LAS bf16x8* qs) {
    const int l15 = lane & 15, fq = lane >> 4, t0 = tile * 16, t = t0 + l15;
    const bf16_t* Yb = P.Y + (size_t)(b * 2048) * LDY;
    const bf16_t* Yt = Yb + (size_t)t * LDY;
    float coef[1], m[1], l[1]; f32x4 O[1][16];
    const LAS bf16x8* Qf = qs;
#pragma unroll
    for (int dc = 0; dc < 4; ++dc) qs[dc * 64] = *(const bf16x8*)(Yt + OFF_QR + h * 128 + 32 * dc + 8 * fq);
    coef[0] = log1pf(-exp2f(-5.0f - (float)h)) * LOG2E; m[0] = 0.f; l[0] = 0.f;
#pragma unroll
    for (int dt = 0; dt < 16; ++dt) O[0][dt] = (f32x4){0.f, 0.f, 0.f, 0.f};
    const bf16_t* Kp = Yb + OFF_KR + h * 128; const bf16_t* Vt = P.VTR + (size_t)((b * 8 + h) * 256) * 2048;
#pragma unroll 1
    for (int k0 = 0; k0 <= t0; k0 += 32) att_step<1, 16, 2>(Kp, Vt, k0, t - 4 * fq, l15 * LDY + 8 * fq, l15 * 2048 + 4 * fq, Qf, O, m, l, coef, true);
    float sum = 0.f;
#pragma unroll
    for (int dt = 0; dt < 16; ++dt) sum += (O[0][dt][0] + O[0][dt][1]) + (O[0][dt][2] + O[0][dt][3]);
    sum += __shfl_xor(sum, 16); sum += __shfl_xor(sum, 32);
    const float mean = sum * (1.0f / 256.0f);
    float var = 0.f;
#pragma unroll
    for (int dt = 0; dt < 16; ++dt) { const f32x4 d = O[0][dt] - mean; var += (d[0] * d[0] + d[1] * d[1]) + (d[2] * d[2] + d[3] * d[3]); }
    var += __shfl_xor(var, 16); var += __shfl_xor(var, 32);
    const float rstd = 1.0f / sqrtf(var * (1.0f / 256.0f) + EPS_);
    bf16_t* orow = P.ORET + (size_t)(b * 2048 + t) * D_ + h * 256;
#pragma unroll
    for (int dt = 0; dt < 16; ++dt) {
        const int e = 16 * dt + 4 * fq;
        const f32x4 gain = *(const f32x4*)(P.gn + h * 256 + e);
        const u32x2 gw = *(const u32x2*)(Yt + OFF_GR + h * 256 + e);
        const f32x4 y = (O[0][dt] - mean) * rstd * gain;
        u32x2 w; w.x = cvt_pk_bf16(silu_f(bf_lo(gw.x)) * y[0], silu_f(bf_hi(gw.x)) * y[1]); w.y = cvt_pk_bf16(silu_f(bf_lo(gw.y)) * y[2], silu_f(bf_hi(gw.y)) * y[3]);
        *(u32x2*)(orow + e) = w;
    }
}

__device__ __forceinline__ void compress_unit(int unit, const bf16_t* __restrict__ Y, const float* __restrict__ cmp_pos, const float* __restrict__ cmp_b1, const float* __restrict__ g_qk,
                                              const bf16_t* __restrict__ WC1, const bf16_t* __restrict__ WC2, bf16_t* __restrict__ KC, bf16_t* __restrict__ VCT, LAS unsigned char* lds, int tid) {
    const int lane = tid & 63, wave = tid >> 6, l15 = lane & 15, fq = lane >> 4;
    const int i = unit >> 7, bg = (unit >> 3) & 15, ct = unit & 7, b = bg >> 2, g = bg & 3;
    const int c = 16 * ct + l15; const bool cvalid = c < 127;
    const bf16_t* Yc = Y + (size_t)(b * 2048 + 16 * (cvalid ? c : 0)) * LDY + OFF_KV + i * 512 + g * 128;
    LAS float* red = (LAS float*)lds;
    LAS bf16_t* hid = (LAS bf16_t*)(lds + 65536);
    f32x4 acc[8];
#pragma unroll
    for (int nt = 0; nt < 8; ++nt) acc[nt] = (f32x4){0.f, 0.f, 0.f, 0.f};
#pragma unroll 1
    for (int ls = 0; ls < 4; ++ls) {
        const int l = 4 * wave + ls;
#pragma unroll
        for (int dc = 0; dc < 4; ++dc) {
            const int d = 32 * dc + 8 * fq;
            u32x4 aw = (u32x4){0u, 0u, 0u, 0u};
            if (cvalid) {
                const u32x4 zw = *(const u32x4*)(Yc + (size_t)l * LDY + d);
                const f32x4 p0 = *(const f32x4*)(cmp_pos + (size_t)(i * 32 + l) * 128 + d), p1 = *(const f32x4*)(cmp_pos + (size_t)(i * 32 + l) * 128 + d + 4);
                aw.x = cvt_pk_bf16(bf_lo(zw.x) + p0[0], bf_hi(zw.x) + p0[1]); aw.y = cvt_pk_bf16(bf_lo(zw.y) + p0[2], bf_hi(zw.y) + p0[3]);
                aw.z = cvt_pk_bf16(bf_lo(zw.z) + p1[0], bf_hi(zw.z) + p1[1]); aw.w = cvt_pk_bf16(bf_lo(zw.w) + p1[2], bf_hi(zw.w) + p1[3]);
            }
            const bf16x8 a = __builtin_bit_cast(bf16x8, aw);
            const int kidx = l * 128 + 32 * dc + 8 * fq;
#pragma unroll
            for (int nt = 0; nt < 8; ++nt) { const bf16x8 bf = *(const bf16x8*)(WC1 + (size_t)(i * 128 + 16 * nt + l15) * 4096 + kidx); acc[nt] = MFMA16(a, bf, acc[nt]); }
        }
    }
#pragma unroll
    for (int nt = 0; nt < 8; ++nt)
#pragma unroll
        for (int j = 0; j < 4; ++j) red[(wave * 16 + 4 * fq + j) * 128 + 16 * nt + l15] = acc[nt][j];
    __syncthreads();
    {
        const int e = tid * 4, cc = e >> 7, n = e & 127;
        f32x4 s = *(const f32x4*)(cmp_b1 + i * 128 + n);
#pragma unroll
        for (int w = 0; w < 8; ++w) s += *(const LAS f32x4*)(red + (w * 16 + cc) * 128 + n);
        float o[4];
#pragma unroll
        for (int j = 0; j < 4; ++j) { const float x = s[j]; o[j] = 0.5f * x * (1.0f + tanhf(0.7978845608028654f * (x + 0.044715f * x * x * x))); }
        u32x2 w; w.x = cvt_pk_bf16(o[0], o[1]); w.y = cvt_pk_bf16(o[2], o[3]);
        *(LAS u32x2*)(hid + cc * 136 + n) = w;
    }
    __syncthreads();
    f32x4 o2 = (f32x4){0.f, 0.f, 0.f, 0.f};
#pragma unroll
    for (int kc = 0; kc < 4; ++kc) {
        const bf16x8 a = *(const LAS bf16x8*)(hid + l15 * 136 + 32 * kc + 8 * fq);
        const bf16x8 bf = *(const bf16x8*)(WC2 + (size_t)(i * 128 + 16 * wave + l15) * 128 + 32 * kc + 8 * fq);
        o2 = MFMA16(a, bf, o2);
    }
    if (i == 1) {
        const int cbase = 16 * ct + 4 * fq;
        u32x2 w; w.x = cvt_pk_bf16(cbase + 0 < 127 ? o2[0] : 0.f, cbase + 1 < 127 ? o2[1] : 0.f); w.y = cvt_pk_bf16(cbase + 2 < 127 ? o2[2] : 0.f, cbase + 3 < 127 ? o2[3] : 0.f);
        *(u32x2*)(VCT + (size_t)(bg * 128 + 16 * wave + l15) * 128 + cbase) = w;
    } else {
#pragma unroll
        for (int j = 0; j < 4; ++j) red[(4 * fq + j) * 128 + 16 * wave + l15] = o2[j];
        __syncthreads();
        const int cc = tid >> 5, part = tid & 31;
        const f32x4 v = *(const LAS f32x4*)(red + cc * 128 + 4 * part);
        float ss = (v[0] * v[0] + v[1] * v[1]) + (v[2] * v[2] + v[3] * v[3]);
#pragma unroll
        for (int o = 1; o < 32; o <<= 1) ss += __shfl_xor(ss, o);
        const float r = 1.0f / sqrtf(ss * (1.0f / 128.0f) + EPS_);
        const f32x4 gq = *(const f32x4*)(g_qk + 128 + 4 * part);
        f32x4 y = v * r * gq;
        if (16 * ct + cc >= 127) y = (f32x4){0.f, 0.f, 0.f, 0.f};
        u32x2 w; w.x = cvt_pk_bf16(y[0], y[1]); w.y = cvt_pk_bf16(y[2], y[3]);
        *(u32x2*)(KC + (size_t)(bg * 128 + 16 * ct + cc) * 128 + 4 * part) = w;
    }
    __syncthreads();
}

struct Params {
    const float *x, *c, *w_ada, *b_ada, *g_norm, *w_gate, *w_up, *w_down, *w_in, *g_qk, *cmp_pos, *cmp_w1, *cmp_b1, *cmp_w2, *gn_gain, *w_pn, *w_pr, *w_out;
    float* out; unsigned char* ws; int mask; int pad;
};

__device__ __forceinline__ void conv_ffn(const Params& p, int layer, bf16_t* WGU, bf16_t* WD, LAS float* scr, int gw, int NGW, int lane) {
    constexpr int I_G = (D_ / 64) * (FF_ / 32), I_D = (FF_ / 64) * (D_ / 32);
    const float* wg = p.w_gate + (size_t)layer * D_ * FF_; const float* wu = p.w_up + (size_t)layer * D_ * FF_; const float* wd = p.w_down + (size_t)layer * D_ * FF_;
    for (int it = gw; it < 2 * I_G + I_D; it += NGW) {
        int r = it;
        if (r < I_G) { transpose_item(wg, D_, FF_, WGU, 1, scr, r, lane); continue; } r -= I_G;
        if (r < I_G) { transpose_item(wu, D_, FF_, WGU, 2, scr, r, lane); continue; } r -= I_G;
        transpose_item(wd, FF_, D_, WD, 0, scr, r, lane);
    }
}

__global__ void __launch_bounds__(512, 2) fwd_kernel(Params p) {
    extern __shared__ __attribute__((aligned(16))) unsigned char lds_raw[];
    cg::grid_group grid = cg::this_grid();
    LAS unsigned char* lds = (LAS unsigned char*)lds_raw;
    const int tid = threadIdx.x, lane = tid & 63, wave = __builtin_amdgcn_readfirstlane(tid >> 6);
    const int G = gridDim.x, gw = blockIdx.x * 8 + wave, NGW = G * 8;
    unsigned char* ws = p.ws;
    unsigned* ctl = (unsigned*)(ws + WS_CTL);
    float* ada = (float*)(ws + WS_ADA);
    bf16_t* WGU = (bf16_t*)(ws + WS_WGU); bf16_t* WD = (bf16_t*)(ws + WS_WD); bf16_t* WIN = (bf16_t*)(ws + WS_WIN);
    bf16_t* WPN = (bf16_t*)(ws + WS_WPN); bf16_t* WPR = (bf16_t*)(ws + WS_WPR); bf16_t* WO = (bf16_t*)(ws + WS_WO);
    bf16_t* WC1 = (bf16_t*)(ws + WS_WC1); bf16_t* WC2 = (bf16_t*)(ws + WS_WC2);
    bf16_t* H = (bf16_t*)(ws + WS_H); bf16_t* ONSA = H; bf16_t* Y = (bf16_t*)(ws + WS_Y); bf16_t* ACT = Y;
    bf16_t* MG = (bf16_t*)(ws + WS_MG); bf16_t* ORET = (bf16_t*)(ws + WS_ORET);
    bf16_t* VTS = (bf16_t*)(ws + WS_VTS); bf16_t* VTW = (bf16_t*)(ws + WS_VTW); bf16_t* VTR = (bf16_t*)(ws + WS_VTR);
    bf16_t* KC = (bf16_t*)(ws + WS_KC); bf16_t* VCT = (bf16_t*)(ws + WS_VCT);
    const int mask = p.mask;
#ifdef CT_MASK
#define ON(k) ((CT_MASK >> (k)) & 1)
#else
#define ON(k) ((mask >> (k)) & 1)
#endif

    if (ON(0)) {
        LAS float* cond = (LAS float*)lds;
        LAS float* red = (LAS float*)(lds + 32768);
        for (int i = tid; i < 4 * D_; i += 512) cond[i] = silu_f(p.c[i]);
        __syncthreads();
        for (int it = blockIdx.x; it < NADA / 64; it += G) {
            const int n = it * 64 + lane; float a0 = 0.f, a1 = 0.f, a2 = 0.f, a3 = 0.f;
            const int kb = wave * 256;
#pragma unroll 8
            for (int kk = 0; kk < 256; ++kk) { const int k = kb + kk; const float w = p.w_ada[(size_t)k * NADA + n];
                a0 += cond[k] * w; a1 += cond[D_ + k] * w; a2 += cond[2 * D_ + k] * w; a3 += cond[3 * D_ + k] * w; }
            red[(wave * 4 + 0) * 64 + lane] = a0; red[(wave * 4 + 1) * 64 + lane] = a1; red[(wave * 4 + 2) * 64 + lane] = a2; red[(wave * 4 + 3) * 64 + lane] = a3;
            __syncthreads();
            if (tid < 256) { const int bb = tid >> 6, l = tid & 63; float s = p.b_ada[it * 64 + l];
#pragma unroll
                for (int w = 0; w < 8; ++w) s += red[(w * 4 + bb) * 64 + l];
                ada[(size_t)bb * NADA + it * 64 + l] = s; }
            __syncthreads();
        }
        __syncthreads();
        LAS float* scr = (LAS float*)(lds + wave * 16384);
        conv_ffn(p, 0, WGU, WD, scr, gw, NGW, lane);
        constexpr int I_IN = (D_ / 64) * ((NIN_ + 31) / 32), I_P = (D_ / 64) * (D_ / 32), I_C1 = (4096 / 64) * (128 / 32), I_C2 = (128 / 64) * (128 / 32);
        for (int it = gw; it < I_IN + 3 * I_P + 2 * I_C1 + 2 * I_C2; it += NGW) {
            int r = it;
            if (r < I_IN) { transpose_item(p.w_in, D_, NIN_, WIN, 3, scr, r, lane); continue; } r -= I_IN;
            if (r < I_P) { transpose_item(p.w_pn, D_, D_, WPN, 0, scr, r, lane); continue; } r -= I_P;
            if (r < I_P) { transpose_item(p.w_pr, D_, D_, WPR, 0, scr, r, lane); continue; } r -= I_P;
            if (r < I_P) { transpose_item(p.w_out, D_, D_, WO, 0, scr, r, lane); continue; } r -= I_P;
            if (r < 2 * I_C1) { const int i = r / I_C1; transpose_item(p.cmp_w1 + (size_t)i * 4096 * 128, 4096, 128, WC1 + (size_t)i * 128 * 4096, 0, scr, r - i * I_C1, lane); continue; } r -= 2 * I_C1;
            { const int i = r / I_C2; transpose_item(p.cmp_w2 + (size_t)i * 128 * 128, 128, 128, WC2 + (size_t)i * 128 * 128, 0, scr, r - i * I_C2, lane); }
        }
        { u32x4* z = (u32x4*)(WIN + (size_t)NIN_ * D_); const int nz = (LDY - NIN_) * D_ * 2 / 16;
          for (int i = blockIdx.x * 512 + tid; i < nz; i += G * 512) z[i] = (u32x4){0u, 0u, 0u, 0u}; }
    }
    grid.sync();
    if (ON(1)) norm_rows(p.x, p.g_norm, ada, 0, 1, H, gw, NGW, lane);
    grid.sync();
    if (ON(2)) {
        pg8::Gemm g{H, WGU, T_, 2 * FF_, D_}; pg8::StaticOrder S; S.init(T_, 2 * FF_, G, (int)blockIdx.x);
        EpiSwiglu E{ACT};
        pg8::gemm_phase<EpiSwiglu, pg8::StaticOrder, true, true>(lds, g, S, E);
    }
    grid.sync();
    if (ON(3)) {
        pg8::Gemm g{ACT, WD, T_, D_, FF_}; pg8::StaticOrder S; S.init(T_, D_, G, (int)blockIdx.x);
        EpiResid E{p.x, p.out, ada + 2 * D_, 0.5f};
        pg8::gemm_phase<EpiResid, pg8::StaticOrder, true, true>(lds, g, S, E);
    } else {
        for (size_t i = (size_t)blockIdx.x * 512 + tid; i < (size_t)T_ * D_ / 4; i += (size_t)G * 512) ((f32x4*)p.out)[i] = ((const f32x4*)p.x)[i];
    }
    grid.sync();
    if (ON(4)) {
        norm_rows(p.out, p.g_norm + D_, ada, 3, 4, H, gw, NGW, lane);
        LAS float* scr = (LAS float*)(lds + wave * 16384);
        conv_ffn(p, 1, WGU, WD, scr, gw, NGW, lane);
    }
    grid.sync();
    if (ON(5)) {
        pg8::Gemm g{H, WIN, T_, LDY, D_}; pg8::StaticOrder S; S.init(T_, LDY, G, (int)blockIdx.x);
        EpiY E{Y};
        pg8::gemm_phase<EpiY, pg8::StaticOrder, true, true>(lds, g, S, E);
    }
    grid.sync();
    if (ON(6)) {
        for (int unit = blockIdx.x; unit < 256; unit += G) compress_unit(unit, Y, p.cmp_pos, p.cmp_b1, p.g_qk, WC1, WC2, KC, VCT, lds, tid);
        __syncthreads();
        for (int tok = gw; tok < T_; tok += NGW) {
            bf16_t* row = Y + (size_t)tok * LDY;
#pragma unroll 1
            for (int seg = 0; seg < 6; ++seg) {
                const int colbase = seg < 4 ? seg * 512 : (seg == 4 ? OFF_KV + 1024 : OFF_KV + 2048), gi = seg < 4 ? 0 : (seg == 4 ? 2 : 3);
                u32x4* ptr = (u32x4*)(row + colbase + lane * 8);
                const u32x4 w = *ptr;
                float f[8] = {bf_lo(w.x), bf_hi(w.x), bf_lo(w.y), bf_hi(w.y), bf_lo(w.z), bf_hi(w.z), bf_lo(w.w), bf_hi(w.w)};
                float ss = 0.f;
#pragma unroll
                for (int j = 0; j < 8; ++j) ss += f[j] * f[j];
                ss += __shfl_xor(ss, 1); ss += __shfl_xor(ss, 2); ss += __shfl_xor(ss, 4); ss += __shfl_xor(ss, 8);
                const float r = 1.0f / sqrtf(ss * (1.0f / 128.0f) + EPS_);
                const float* gq = p.g_qk + gi * 128 + (lane & 15) * 8;
                const f32x4 g0 = *(const f32x4*)gq, g1 = *(const f32x4*)(gq + 4);
                u32x4 o; o.x = cvt_pk_bf16(f[0] * r * g0[0], f[1] * r * g0[1]); o.y = cvt_pk_bf16(f[2] * r * g0[2], f[3] * r * g0[3]);
                o.z = cvt_pk_bf16(f[4] * r * g1[0], f[5] * r * g1[1]); o.w = cvt_pk_bf16(f[6] * r * g1[2], f[7] * r * g1[3]);
                *ptr = o;
            }
        }
        LAS bf16_t* tl = (LAS bf16_t*)(lds + wave * 16384);
        for (int it = gw; it < 48 * 128; it += NGW) {
            const int tt = it / 48, ct = it - tt * 48;
            int srccol, W, cc; bf16_t* dst;
            if (ct < 8) { srccol = OFF_KV + 3 * 512 + ct * 64; W = 512; cc = ct * 64; dst = VTS; }
            else if (ct < 16) { srccol = OFF_KV + 5 * 512 + (ct - 8) * 64; W = 512; cc = (ct - 8) * 64; dst = VTW; }
            else { srccol = OFF_VR + (ct - 16) * 64; W = 2048; cc = (ct - 16) * 64; dst = VTR; }
            const int b = tt >> 5, s0 = (tt & 31) * 64;
#pragma unroll
            for (int i = 0; i < 8; ++i) {
                const int tok = 8 * i + (lane >> 3), ch = lane & 7;
                const u32x4 w = *(const u32x4*)(Y + (size_t)(b * 2048 + s0 + tok) * LDY + srccol + ch * 8);
                LAS bf16_t* d = tl + (ch * 8) * 72 + tok;
                d[0 * 72] = (bf16_t)(w.x & 0xffffu); d[1 * 72] = (bf16_t)(w.x >> 16); d[2 * 72] = (bf16_t)(w.y & 0xffffu); d[3 * 72] = (bf16_t)(w.y >> 16);
                d[4 * 72] = (bf16_t)(w.z & 0xffffu); d[5 * 72] = (bf16_t)(w.z >> 16); d[6 * 72] = (bf16_t)(w.w & 0xffffu); d[7 * 72] = (bf16_t)(w.w >> 16);
            }
            asm volatile("s_waitcnt lgkmcnt(0)" ::: "memory");
#pragma unroll
            for (int i = 0; i < 8; ++i) {
                const int col = 8 * i + (lane >> 3), ch = lane & 7;
                const u32x4 w = *(const LAS u32x4*)(tl + col * 72 + ch * 8);
                *(u32x4*)(dst + (size_t)(b * W + cc + col) * 2048 + s0 + ch * 8) = w;
            }
            asm volatile("s_waitcnt lgkmcnt(0)" ::: "memory");
        }
    }
    grid.sync();
    if (ON(7)) {
        MixPtrs MP{Y, ONSA, ORET, VTS, VTW, VTR, KC, VCT, p.gn_gain};
        LAS bf16x8* qs = (LAS bf16x8*)(lds + wave * 16384) + lane;
        for (;;) {
            unsigned id = 0;
            if (lane == 0) id = atomicAdd(ctl, 1u);
            id = (unsigned)__builtin_amdgcn_readfirstlane((int)id);
            if (id >= 128u * 48u) break;
            const int tile = 127 - (int)(id / 48u), sub = (int)(id % 48u);
#ifndef NO_NSA
            if (sub < 16) nsa_unit(MP, sub >> 2, sub & 3, tile, lane, qs);
#endif
#ifndef NO_RET
            if (sub >= 16) ret_unit(MP, (sub - 16) >> 3, (sub - 16) & 7, tile, lane, qs);
#endif
        }
    }
    grid.sync();
    if (ON(8)) {
        { pg8::Gemm g{ONSA, WPN, T_, D_, D_}; pg8::StaticOrder S; S.init(T_, D_, G, (int)blockIdx.x);
          EpiMerge<false> E{MG, Y, OFF_GA};
          pg8::gemm_phase<EpiMerge<false>, pg8::StaticOrder, true, true>(lds, g, S, E); }
        __syncthreads();
        { pg8::Gemm g{ORET, WPR, T_, D_, D_}; pg8::StaticOrder S; S.init(T_, D_, G, (int)blockIdx.x);
          EpiMerge<true> E{MG, Y, OFF_GB};
          pg8::gemm_phase<EpiMerge<true>, pg8::StaticOrder, true, true>(lds, g, S, E); }
    }
    grid.sync();
    if (ON(9)) {
        pg8::Gemm g{MG, WO, T_, D_, D_}; pg8::StaticOrder S; S.init(T_, D_, G, (int)blockIdx.x);
        EpiResid E{p.out, p.out, ada + 5 * D_, 1.0f};
        pg8::gemm_phase<EpiResid, pg8::StaticOrder, true, true>(lds, g, S, E);
    }
    grid.sync();
    if (ON(10)) norm_rows(p.out, p.g_norm + 2 * D_, ada, 6, 7, H, gw, NGW, lane);
    grid.sync();
    if (ON(11)) {
        pg8::Gemm g{H, WGU, T_, 2 * FF_, D_}; pg8::StaticOrder S; S.init(T_, 2 * FF_, G, (int)blockIdx.x);
        EpiSwiglu E{ACT};
        pg8::gemm_phase<EpiSwiglu, pg8::StaticOrder, true, true>(lds, g, S, E);
    }
    grid.sync();
    if (ON(12)) {
        pg8::Gemm g{ACT, WD, T_, D_, FF_}; pg8::StaticOrder S; S.init(T_, D_, G, (int)blockIdx.x);
        EpiResid E{p.out, p.out, ada + 8 * D_, 0.5f};
        pg8::gemm_phase<EpiResid, pg8::StaticOrder, true, true>(lds, g, S, E);
    }
#undef ON
}

#ifndef PHASE_MASK
#define PHASE_MASK 0x1fff
#endif
extern "C" void kernel_launch(void* const* d_in, const int* in_sizes, int n_in, void* d_out, int out_size, void* d_ws, size_t ws_size, hipStream_t stream) {
    static int grid_blocks = 0;
    if (grid_blocks == 0) {
        if (n_in != 18 || ws_size < WS_END) { fprintf(stderr, "kernel_launch: unexpected n_in %d or workspace %zu < %zu\n", n_in, ws_size, (size_t)WS_END); grid_blocks = -1; return; }
        int dev = 0, cus = 0, per_cu = 0;
        hipGetDevice(&dev);
        hipDeviceGetAttribute(&cus, hipDeviceAttributeMultiprocessorCount, dev);
        if (hipFuncSetAttribute((const void*)fwd_kernel, hipFuncAttributeMaxDynamicSharedMemorySize, LDS_BYTES) != hipSuccess) { fprintf(stderr, "kernel_launch: hipFuncSetAttribute failed\n"); grid_blocks = -1; return; }
        if (hipOccupancyMaxActiveBlocksPerMultiprocessor(&per_cu, (const void*)fwd_kernel, 512, LDS_BYTES) != hipSuccess || per_cu < 1) { fprintf(stderr, "kernel_launch: occupancy query gave %d\n", per_cu); per_cu = 1; }
        (void)hipGetLastError();
        grid_blocks = cus * 1;
    }
    if (grid_blocks < 0) return;
    (void)hipMemsetAsync((char*)d_ws + WS_CTL, 0, 4096, stream);
    Params p{};
    p.x = (const float*)d_in[0]; p.c = (const float*)d_in[1]; p.w_ada = (const float*)d_in[2]; p.b_ada = (const float*)d_in[3]; p.g_norm = (const float*)d_in[4];
    p.w_gate = (const float*)d_in[5]; p.w_up = (const float*)d_in[6]; p.w_down = (const float*)d_in[7]; p.w_in = (const float*)d_in[8]; p.g_qk = (const float*)d_in[9];
    p.cmp_pos = (const float*)d_in[10]; p.cmp_w1 = (const float*)d_in[11]; p.cmp_b1 = (const float*)d_in[12]; p.cmp_w2 = (const float*)d_in[13]; p.gn_gain = (const float*)d_in[14];
    p.w_pn = (const float*)d_in[15]; p.w_pr = (const float*)d_in[16]; p.w_out = (const float*)d_in[17];
    p.out = (float*)d_out; p.ws = (unsigned char*)d_ws; p.mask = PHASE_MASK; p.pad = 0;
    void* args[] = {&p};
    hipError_t e = hipLaunchCooperativeKernel((const void*)fwd_kernel, dim3(grid_blocks), dim3(512), args, LDS_BYTES, stream);
    if (e != hipSuccess) fprintf(stderr, "kernel_launch: cooperative launch failed: %s (grid %d)\n", hipGetErrorString(e), grid_blocks);
}
```

```cpp
#include <hip/hip_runtime.h>
#include <hip/hip_cooperative_groups.h>
#include <cstdio>
#include <cstdint>
namespace cg = cooperative_groups;
namespace pg8 {
#define PG8_LAS __attribute__((address_space(3)))
typedef unsigned short bf16_t;
typedef short bf16x8 __attribute__((ext_vector_type(8)));
typedef float f32x4 __attribute__((ext_vector_type(4)));
typedef unsigned u32x4 __attribute__((ext_vector_type(4)));
constexpr int BM = 256, BK = 64, HALF = 128, HTB = HALF * BK * 2  , STAGE_BYTES = 8 * HTB, NXCD = 8, WGM = 8;

__host__ __device__ __forceinline__ int lds_byte(int r, int c) { const int st = (r >> 4) * 2 + (c >> 5), rr = r & 15, cc = c & 31, ob = rr * 64 + cc * 2; return st * 1024 + (ob ^ (((ob >> 9) & 1) << 5)); }
__host__ __device__ __forceinline__ void stage_rc(int b, int& R, int& C) { const int st = b / 1024, sb = b % 1024, swz = sb ^ (((sb >> 9) & 1) << 5); R = (st >> 1) * 16 + swz / 64; C = (st & 1) * 32 + (swz % 64) / 2; }
__host__ __device__ __forceinline__ int perm32(int rho) { const int n = rho >> 4, i = rho & 15; return 8 * (i >> 2) + 4 * n + (i & 3); }

struct Unit { int pm, pn; };
struct Gemm { const bf16_t* A; const bf16_t* Bt; int M, N, K; };

struct StaticOrder {
    int nM, nN, nwg, G, c;
    __host__ __device__ void init(int M, int N, int G_, int c_) { nM = M / BM; nN = N / BM; nwg = nM * nN; G = G_; c = c_; }
    __host__ __device__ bool next(int i, Unit& u) const {
        const long L = (long)i * G + c; if (L >= nwg) return false;
        int wgid = (int)L; { const int q = nwg / NXCD, r = nwg % NXCD, xcd = wgid % NXCD, off = wgid / NXCD; wgid = (xcd < r ? xcd * (q + 1) : r * (q + 1) + (xcd - r) * q) + off; }
        const int nig = WGM * nN, gid = wgid / nig, fm = gid * WGM, gsz = (nM - fm) < WGM ? (nM - fm) : WGM;
        u.pm = fm + ((wgid % nig) % gsz); u.pn = (wgid % nig) / gsz; return true;
    }
    __device__ __forceinline__ void a_ready(const Unit&) const {}
    __device__ __forceinline__ void done(const Unit&) const {}
};

__device__ __forceinline__ unsigned cvt_pk_bf16(float lo, float hi) { unsigned r; asm volatile("v_cvt_pk_bf16_f32 %0, %1, %2" : "=v"(r) : "v"(lo), "v"(hi)); return r; }
typedef float f32x2 __attribute__((ext_vector_type(2)));
template <class Epi, class Sched, bool ALIGN_EPI = false, bool SP2 = false>
__device__ __forceinline__ void gemm_phase(PG8_LAS unsigned char* lds, const Gemm g, const Sched& S, const Epi& E) {
    int tid_o = threadIdx.x; asm volatile("" : "+v"(tid_o));
    const int tid = tid_o, wid = __builtin_amdgcn_readfirstlane(tid >> 6), lane = tid & 63, wr = wid >> 2, wc = wid & 3, fr = lane & 15, fq = lane >> 4;
    const int K = g.K, nt = K / BK;
    unsigned voffA[2], voffB[2];
#pragma unroll
    for (int i = 0; i < 2; ++i) { int R, C; stage_rc(tid * 16 + i * 8192, R, C); const int Rb = Epi::PERM ? ((R & ~31) + perm32(R & 31)) : R;
        voffA[i] = (unsigned)(R * K + C) * 2u; voffB[i] = (unsigned)(Rb * K + C) * 2u; }
    const size_t kstep = (size_t)(BK * 2);
    const size_t hstep = (size_t)HALF * K * 2;
    const size_t tstep = 2 * hstep;
    const unsigned ldsw = (unsigned)wid * 1024u;
    const int aoff = lds_byte(wr * 64 + fr, fq * 8), boff = lds_byte(wc * 32 + fr, fq * 8);
#define PG8_SA(b, h) (((b) * 2 + (h)) * HTB)
#define PG8_SB(b, h) ((4 + (b) * 2 + (h)) * HTB)
#define PG8_STAGE(bufoff, gbase, voff) do { _Pragma("unroll") for (int _i = 0; _i < 2; ++_i) \
        __builtin_amdgcn_global_load_lds((const unsigned*)((const char*)(gbase) + (voff)[_i]), (PG8_LAS unsigned*)(lds + (bufoff) + ldsw + _i * 8192), 16, 0, 0); } while (0)
#define PG8_LDA(dst, b, h) do { _Pragma("unroll") for (int m = 0; m < 4; ++m) _Pragma("unroll") for (int k = 0; k < 2; ++k) dst[m][k] = *(const PG8_LAS bf16x8*)(lds + PG8_SA(b, h) + aoff + m * 2048 + k * 1024); } while (0)
#define PG8_LDB(dst, b, h) do { _Pragma("unroll") for (int n = 0; n < 2; ++n) _Pragma("unroll") for (int k = 0; k < 2; ++k) dst[n][k] = *(const PG8_LAS bf16x8*)(lds + PG8_SB(b, h) + boff + n * 2048 + k * 1024); } while (0)
#define PG8_MMA(ai, bj, At, Bt) do { __builtin_amdgcn_s_setprio(1); _Pragma("unroll") for (int m = 0; m < 4; ++m) _Pragma("unroll") for (int n = 0; n < 2; ++n) _Pragma("unroll") for (int k = 0; k < 2; ++k) \
        acc[ai][bj][m][n] = __builtin_amdgcn_mfma_f32_16x16x32_bf16(Bt[n][k], At[m][k], acc[ai][bj][m][n], 0, 0, 0); __builtin_amdgcn_s_setprio(0); } while (0)
#define PG8_WAIT_V(n) asm volatile("s_waitcnt vmcnt(" #n ")" ::: "memory")
#define PG8_WAIT_L(n) asm volatile("s_waitcnt lgkmcnt(" #n ")" ::: "memory")
#define PG8_BAR __builtin_amdgcn_s_barrier()
#define PG8_SCHED __builtin_amdgcn_sched_barrier(0)
    Unit cur, nxt; int ui = 0;
    if (!S.next(0, cur)) return;
    f32x4 acc[2][2][4][2];
#pragma unroll
    for (int a = 0; a < 2; ++a)
#pragma unroll
        for (int b = 0; b < 2; ++b)
#pragma unroll
            for (int m = 0; m < 4; ++m)
#pragma unroll
                for (int n = 0; n < 2; ++n) acc[a][b][m][n] = (f32x4){0.f, 0.f, 0.f, 0.f};
    bf16x8 At[4][2], B0[2][2], B1[2][2];
    const char* cA = (const char*)g.A + (size_t)cur.pm * tstep; const char* cB = (const char*)g.Bt + (size_t)cur.pn * tstep;
    S.a_ready(cur);
    if constexpr (SP2) {
        PG8_STAGE(PG8_SB(0, 0), cB, voffB); PG8_STAGE(PG8_SB(0, 1), cB + hstep, voffB); PG8_STAGE(PG8_SA(0, 0), cA, voffA); PG8_STAGE(PG8_SA(0, 1), cA + hstep, voffA);
        if (wr == 1) PG8_BAR;
        PG8_WAIT_V(2); PG8_BAR;
        PG8_STAGE(PG8_SB(1, 0), cB + kstep, voffB); PG8_STAGE(PG8_SA(1, 0), cA + kstep, voffA); PG8_STAGE(PG8_SB(1, 1), cB + hstep + kstep, voffB);
        PG8_WAIT_V(6); PG8_BAR;
    } else {
        PG8_STAGE(PG8_SB(0, 0), cB, voffB); PG8_STAGE(PG8_SA(0, 0), cA, voffA); PG8_STAGE(PG8_SB(0, 1), cB + hstep, voffB); PG8_STAGE(PG8_SA(0, 1), cA + hstep, voffA);
        if (wr == 1) PG8_BAR;
        PG8_WAIT_V(4); PG8_BAR;
        PG8_STAGE(PG8_SB(1, 0), cB + kstep, voffB); PG8_STAGE(PG8_SA(1, 0), cA + kstep, voffA); PG8_STAGE(PG8_SB(1, 1), cB + hstep + kstep, voffB);
        PG8_WAIT_V(6); PG8_BAR;
    }
    for (;;) {
        const bool has_next = S.next(ui + 1, nxt);
        const char* nA = has_next ? (const char*)g.A + (size_t)nxt.pm * tstep : cA; const char* nB = has_next ? (const char*)g.Bt + (size_t)nxt.pn * tstep : cB;
        for (int t = 0; t < nt; t += 2) {
            const bool last = (t == nt - 2);
            const char* a1 = cA + (size_t)(t + 1) * kstep;
            const char* a2 = last ? nA : cA + (size_t)(t + 2) * kstep; const char* b2 = last ? nB : cB + (size_t)(t + 2) * kstep;
            const char* a3 = a2 + kstep; const char* b3 = b2 + kstep;
            if (last && has_next) S.a_ready(nxt);
            if constexpr (SP2) {
            PG8_LDB(B0, 0, 0); PG8_LDB(B1, 0, 1); PG8_SCHED; PG8_LDA(At, 0, 0); PG8_STAGE(PG8_SA(1, 1), a1 + hstep, voffA);
            PG8_WAIT_V(8); PG8_WAIT_L(0); PG8_BAR; PG8_MMA(0, 0, At, B0); PG8_MMA(0, 1, At, B1); PG8_BAR; PG8_SCHED;
            PG8_LDA(At, 0, 1); PG8_STAGE(PG8_SB(0, 0), b2, voffB); PG8_STAGE(PG8_SB(0, 1), b2 + hstep, voffB); PG8_STAGE(PG8_SA(0, 0), a2, voffA);
            PG8_WAIT_V(8); PG8_WAIT_L(0); PG8_BAR; PG8_MMA(1, 0, At, B0); PG8_MMA(1, 1, At, B1); PG8_BAR; PG8_SCHED;
            PG8_LDB(B0, 1, 0); PG8_LDB(B1, 1, 1); PG8_SCHED; PG8_LDA(At, 1, 0); PG8_STAGE(PG8_SA(0, 1), a2 + hstep, voffA);
            PG8_WAIT_V(8); PG8_WAIT_L(0); PG8_BAR; PG8_MMA(0, 0, At, B0); PG8_MMA(0, 1, At, B1); PG8_BAR; PG8_SCHED;
            PG8_LDA(At, 1, 1); PG8_STAGE(PG8_SB(1, 0), b3, voffB); PG8_STAGE(PG8_SB(1, 1), b3 + hstep, voffB); PG8_STAGE(PG8_SA(1, 0), a3, voffA);
            PG8_WAIT_V(8); PG8_WAIT_L(0); PG8_BAR; PG8_MMA(1, 0, At, B0); PG8_MMA(1, 1, At, B1); PG8_BAR; PG8_SCHED;
            } else {
            PG8_LDB(B0, 0, 0); PG8_SCHED; PG8_LDA(At, 0, 0); PG8_STAGE(PG8_SA(1, 1), a1 + hstep, voffA);
            PG8_WAIT_L(8); PG8_BAR; PG8_WAIT_L(0); PG8_MMA(0, 0, At, B0); PG8_BAR; PG8_SCHED;
            PG8_LDB(B1, 0, 1); PG8_STAGE(PG8_SB(0, 0), b2, voffB);
            PG8_BAR; PG8_WAIT_L(0); PG8_MMA(0, 1, At, B1); PG8_BAR;
            PG8_LDA(At, 0, 1); PG8_STAGE(PG8_SA(0, 0), a2, voffA);
            PG8_BAR; PG8_WAIT_L(0); PG8_MMA(1, 0, At, B0); PG8_BAR; PG8_SCHED;
            PG8_STAGE(PG8_SB(0, 1), b2 + hstep, voffB);
            PG8_WAIT_V(6); PG8_BAR; PG8_MMA(1, 1, At, B1); PG8_BAR;
            PG8_LDB(B0, 1, 0); PG8_SCHED; PG8_LDA(At, 1, 0); PG8_STAGE(PG8_SA(0, 1), a2 + hstep, voffA);
            PG8_WAIT_L(8); PG8_BAR; PG8_WAIT_L(0); PG8_MMA(0, 0, At, B0); PG8_BAR; PG8_SCHED;
            PG8_LDB(B1, 1, 1); PG8_STAGE(PG8_SB(1, 0), b3, voffB);
            PG8_BAR; PG8_WAIT_L(0); PG8_MMA(0, 1, At, B1); PG8_BAR;
            PG8_LDA(At, 1, 1); PG8_STAGE(PG8_SA(1, 0), a3, voffA);
            PG8_BAR; PG8_WAIT_L(0); PG8_MMA(1, 0, At, B0); PG8_BAR; PG8_SCHED;
            PG8_STAGE(PG8_SB(1, 1), b3 + hstep, voffB);
            PG8_WAIT_V(6); PG8_BAR; PG8_MMA(1, 1, At, B1); PG8_BAR;
            }
        }
        if constexpr (ALIGN_EPI) { if (wr == 0) PG8_BAR; }
        if constexpr (!Epi::AFTER_DRAIN) { E(acc, cur, wr, wc, fr, fq); S.done(cur); }
        if (!has_next) break;
#pragma unroll
        for (int a = 0; a < 2; ++a)
#pragma unroll
            for (int b = 0; b < 2; ++b)
#pragma unroll
                for (int m = 0; m < 4; ++m)
#pragma unroll
                    for (int n = 0; n < 2; ++n) acc[a][b][m][n] = (f32x4){0.f, 0.f, 0.f, 0.f};
        cur = nxt; cA = nA; cB = nB; ++ui;
        if constexpr (ALIGN_EPI) { if (wr == 1) PG8_BAR; }
    }
    PG8_WAIT_V(0);
    if constexpr (!ALIGN_EPI) { if (wr == 0) PG8_BAR; }
    PG8_BAR;
    if constexpr (Epi::AFTER_DRAIN) { E.fused(acc, cur, wr, wc, fr, fq, lds, wid, lane); S.done(cur); }
#undef PG8_SA
#undef PG8_SB
#undef PG8_STAGE
#undef PG8_LDA
#undef PG8_LDB
#undef PG8_MMA
#undef PG8_WAIT_V
#undef PG8_WAIT_L
#undef PG8_BAR
#undef PG8_SCHED
}
}

#define LAS __attribute__((address_space(3)))
typedef unsigned short bf16_t;
typedef short bf16x8 __attribute__((ext_vector_type(8)));
typedef short s16x4 __attribute__((ext_vector_type(4)));
typedef float f32x4 __attribute__((ext_vector_type(4)));
typedef unsigned u32x4 __attribute__((ext_vector_type(4)));
typedef unsigned u32x2 __attribute__((ext_vector_type(2)));

constexpr int T_ = 8192, D_ = 2048, FF_ = 5632, NIN_ = 15408, LDY = 15616, NADA = 18432;
constexpr int OFF_Q = 0, OFF_KV = 2048, OFF_QR = 5120, OFF_KR = 6144, OFF_VR = 7168, OFF_GR = 9216, OFF_GA = 11264, OFF_GB = 13312, OFF_GL = 15360;
constexpr float LOG2E = 1.4426950408889634f;
constexpr float EPS_ = 1e-6f;

constexpr size_t al256(size_t x) { return (x + 255) & ~(size_t)255; }
constexpr size_t WS_CTL = 0;
constexpr size_t WS_ADA = 4096;
constexpr size_t WS_WGU = al256(WS_ADA + (size_t)4 * NADA * 4);
constexpr size_t WS_WD  = WS_WGU + (size_t)2 * FF_ * D_ * 2;
constexpr size_t WS_WIN = WS_WD + (size_t)D_ * FF_ * 2;
constexpr size_t WS_WPN = WS_WIN + (size_t)LDY * D_ * 2;
constexpr size_t WS_WPR = WS_WPN + (size_t)D_ * D_ * 2;
constexpr size_t WS_WO  = WS_WPR + (size_t)D_ * D_ * 2;
constexpr size_t WS_WC1 = WS_WO + (size_t)D_ * D_ * 2;
constexpr size_t WS_WC2 = WS_WC1 + (size_t)2 * 128 * 4096 * 2;
constexpr size_t WS_H   = WS_WC2 + (size_t)2 * 128 * 128 * 2;
constexpr size_t WS_Y   = WS_H + (size_t)T_ * D_ * 2;
constexpr size_t WS_MG  = WS_Y + (size_t)T_ * LDY * 2;
constexpr size_t WS_ORET = WS_MG + (size_t)T_ * D_ * 2;
constexpr size_t WS_VTS = WS_ORET + (size_t)T_ * D_ * 2;
constexpr size_t WS_VTW = WS_VTS + (size_t)16 * 128 * 2048 * 2;
constexpr size_t WS_VTR = WS_VTW + (size_t)16 * 128 * 2048 * 2;
constexpr size_t WS_KC  = WS_VTR + (size_t)32 * 256 * 2048 * 2;
constexpr size_t WS_VCT = WS_KC + (size_t)16 * 128 * 128 * 2;
constexpr size_t WS_KS  = WS_VCT + (size_t)16 * 128 * 128 * 2;
constexpr size_t WS_KW  = WS_KS + (size_t)16 * 2048 * 128 * 2;
constexpr size_t WS_KR  = WS_KW + (size_t)16 * 2048 * 128 * 2;
constexpr size_t WS_END = WS_KR + (size_t)32 * 2048 * 128 * 2;

constexpr int LDS_BYTES = 131072 + 2048;

using pg8::cvt_pk_bf16;
__device__ __forceinline__ float bf_lo(unsigned w) { return __uint_as_float(w << 16); }
__device__ __forceinline__ float bf_hi(unsigned w) { return __uint_as_float(w & 0xffff0000u); }
__device__ __forceinline__ float bf2f(bf16_t h) { return __uint_as_float((unsigned)h << 16); }
__device__ __forceinline__ float ex2(float x) { return __builtin_amdgcn_exp2f(x); }
__device__ __forceinline__ float sigmoid_f(float x) { return __builtin_amdgcn_rcpf(1.0f + ex2(-x * LOG2E)); }
__device__ __forceinline__ float silu_f(float x) { return x * sigmoid_f(x); }
__device__ __forceinline__ float wave_sum(float v) {
#pragma unroll
    for (int o = 1; o < 64; o <<= 1) v += __shfl_xor(v, o);
    return v;
}
#define MFMA16(a, b, c) __builtin_amdgcn_mfma_f32_16x16x32_bf16((a), (b), (c), 0, 0, 0)

struct EpiSwiglu {
    static constexpr bool PERM = true, AFTER_DRAIN = false;
    bf16_t* O;
    __device__ __forceinline__ void operator()(const f32x4 (&acc)[2][2][4][2], const pg8::Unit& u, int wr, int wc, int fr, int fq) const {
        const int row0 = u.pm * 256 + wr * 64 + fr, col0 = u.pn * 128 + wc * 32 + 8 * fq;
#pragma unroll
        for (int ai = 0; ai < 2; ++ai)
#pragma unroll
            for (int m = 0; m < 4; ++m) {
                bf16_t* rowp = O + (size_t)(row0 + ai * 128 + m * 16) * FF_ + col0;
                const f32x4 g0 = acc[ai][0][m][0], g1 = acc[ai][0][m][1], u0 = acc[ai][1][m][0], u1 = acc[ai][1][m][1];
                u32x4 w;
                w.x = cvt_pk_bf16(silu_f(g0[0]) * u0[0], silu_f(g0[1]) * u0[1]);
                w.y = cvt_pk_bf16(silu_f(g0[2]) * u0[2], silu_f(g0[3]) * u0[3]);
                w.z = cvt_pk_bf16(silu_f(g1[0]) * u1[0], silu_f(g1[1]) * u1[1]);
                w.w = cvt_pk_bf16(silu_f(g1[2]) * u1[2], silu_f(g1[3]) * u1[3]);
                *(u32x4*)rowp = w;
            }
    }
};
struct EpiResid {
    static constexpr bool PERM = false, AFTER_DRAIN = false;
    const float* base; float* out; const float* gate; float coef;
    __device__ __forceinline__ void operator()(const f32x4 (&acc)[2][2][4][2], const pg8::Unit& u, int wr, int wc, int fr, int fq) const {
        const int row0 = u.pm * 256 + wr * 64 + fr, col0 = u.pn * 256 + wc * 32 + 4 * fq, b = u.pm >> 3;
        f32x4 gv[2][2];
#pragma unroll
        for (int bj = 0; bj < 2; ++bj)
#pragma unroll
            for (int n = 0; n < 2; ++n) gv[bj][n] = *(const f32x4*)(gate + (size_t)b * NADA + col0 + bj * 128 + n * 16) * coef;
#pragma unroll
        for (int ai = 0; ai < 2; ++ai)
#pragma unroll
            for (int m = 0; m < 4; ++m) {
                const size_t off = (size_t)(row0 + ai * 128 + m * 16) * D_ + col0;
#pragma unroll
                for (int bj = 0; bj < 2; ++bj)
#pragma unroll
                    for (int n = 0; n < 2; ++n) {
                        const size_t o = off + bj * 128 + n * 16;
                        *(f32x4*)(out + o) = *(const f32x4*)(base + o) + gv[bj][n] * acc[ai][bj][m][n];
                    }
            }
    }
};
struct EpiY {
    static constexpr bool PERM = true, AFTER_DRAIN = false;
    bf16_t* O;
    __device__ __forceinline__ void operator()(const f32x4 (&acc)[2][2][4][2], const pg8::Unit& u, int wr, int wc, int fr, int fq) const {
        const int row0 = u.pm * 256 + wr * 64 + fr, col0 = u.pn * 256 + wc * 32 + 8 * fq;
#pragma unroll
        for (int ai = 0; ai < 2; ++ai)
#pragma unroll
            for (int m = 0; m < 4; ++m) {
                bf16_t* rowp = O + (size_t)(row0 + ai * 128 + m * 16) * LDY + col0;
#pragma unroll
                for (int bj = 0; bj < 2; ++bj) {
                    const f32x4 v0 = acc[ai][bj][m][0], v1 = acc[ai][bj][m][1];
                    u32x4 w; w.x = cvt_pk_bf16(v0[0], v0[1]); w.y = cvt_pk_bf16(v0[2], v0[3]); w.z = cvt_pk_bf16(v1[0], v1[1]); w.w = cvt_pk_bf16(v1[2], v1[3]);
                    *(u32x4*)(rowp + bj * 128) = w;
                }
            }
    }
};
template <bool ADD> struct EpiMerge {
    static constexpr bool PERM = true, AFTER_DRAIN = false;
    bf16_t* O; const bf16_t* Yg; int goff;
    __device__ __forceinline__ void operator()(const f32x4 (&acc)[2][2][4][2], const pg8::Unit& u, int wr, int wc, int fr, int fq) const {
        const int row0 = u.pm * 256 + wr * 64 + fr, col0 = u.pn * 256 + wc * 32 + 8 * fq;
#pragma unroll
        for (int ai = 0; ai < 2; ++ai)
#pragma unroll
            for (int m = 0; m < 4; ++m) {
                const int row = row0 + ai * 128 + m * 16;
#pragma unroll
                for (int bj = 0; bj < 2; ++bj) {
                    const int col = col0 + bj * 128;
                    const u32x4 gw = *(const u32x4*)(Yg + (size_t)row * LDY + goff + col);
                    const f32x4 v0 = acc[ai][bj][m][0], v1 = acc[ai][bj][m][1];
                    float r[8];
                    r[0] = sigmoid_f(bf_lo(gw.x)) * v0[0]; r[1] = sigmoid_f(bf_hi(gw.x)) * v0[1];
                    r[2] = sigmoid_f(bf_lo(gw.y)) * v0[2]; r[3] = sigmoid_f(bf_hi(gw.y)) * v0[3];
                    r[4] = sigmoid_f(bf_lo(gw.z)) * v1[0]; r[5] = sigmoid_f(bf_hi(gw.z)) * v1[1];
                    r[6] = sigmoid_f(bf_lo(gw.w)) * v1[2]; r[7] = sigmoid_f(bf_hi(gw.w)) * v1[3];
                    bf16_t* op = O + (size_t)row * D_ + col;
                    if (ADD) {
                        const u32x4 pw = *(const u32x4*)op;
                        r[0] += bf_lo(pw.x); r[1] += bf_hi(pw.x); r[2] += bf_lo(pw.y); r[3] += bf_hi(pw.y);
                        r[4] += bf_lo(pw.z); r[5] += bf_hi(pw.z); r[6] += bf_lo(pw.w); r[7] += bf_hi(pw.w);
                    }
                    u32x4 w; w.x = cvt_pk_bf16(r[0], r[1]); w.y = cvt_pk_bf16(r[2], r[3]); w.z = cvt_pk_bf16(r[4], r[5]); w.w = cvt_pk_bf16(r[6], r[7]);
                    *(u32x4*)op = w;
                }
            }
    }
};

__device__ __forceinline__ int rowmap(int mode, int n) {
    if (mode == 0) return n;
    if (mode == 1) return ((n >> 7) << 8) + (n & 127);
    if (mode == 2) return ((n >> 7) << 8) + 128 + (n & 127);
    return n < 5120 ? n : (n < 5168 ? OFF_GL + (n - 5120) : n - 48);
}
__device__ __forceinline__ void transpose_item(const float* __restrict__ W, int K, int N, bf16_t* __restrict__ WT, int mode, LAS float* scr, int item, int lane) {
    const int nblk = (N + 31) >> 5, kb = item / nblk, nb = item - kb * nblk, k0 = 64 * kb, n0 = 32 * nb;
    const bool cok = (n0 + (lane & 31)) < N;
#pragma unroll 8
    for (int i = 0; i < 32; ++i) { const int kk = 2 * i + (lane >> 5); scr[kk * 33 + (lane & 31)] = cok ? W[(size_t)(k0 + kk) * N + n0 + (lane & 31)] : 0.f; }
    asm volatile("s_waitcnt lgkmcnt(0)" ::: "memory");
    const int c = lane & 7;
#pragma unroll
    for (int j = 0; j < 4; ++j) {
        const int n = (lane >> 3) + 8 * j; const LAS float* s = scr + (8 * c) * 33 + n;
        u32x4 o; o.x = cvt_pk_bf16(s[0 * 33], s[1 * 33]); o.y = cvt_pk_bf16(s[2 * 33], s[3 * 33]); o.z = cvt_pk_bf16(s[4 * 33], s[5 * 33]); o.w = cvt_pk_bf16(s[6 * 33], s[7 * 33]);
        if (n0 + n < N) *(u32x4*)(WT + (size_t)rowmap(mode, n0 + n) * K + k0 + 8 * c) = o;
    }
    asm volatile("s_waitcnt lgkmcnt(0)" ::: "memory");
}

__device__ __forceinline__ void norm_rows(const float* __restrict__ X, const float* __restrict__ g, const float* __restrict__ ada, int ish, int isc, bf16_t* __restrict__ H, int gw, int NGW, int lane) {
    for (int m = gw; m < T_; m += NGW) {
        const int b = m >> 11;
        const f32x4* xr = (const f32x4*)(X + (size_t)m * D_) + lane;
        f32x4 v[8]; float ss = 0.f;
#pragma unroll
        for (int j = 0; j < 8; ++j) { v[j] = xr[64 * j]; ss += (v[j].x * v[j].x + v[j].y * v[j].y) + (v[j].z * v[j].z + v[j].w * v[j].w); }
        const float r = 1.0f / sqrtf(wave_sum(ss) * (1.0f / D_) + EPS_);
        const f32x4* gp = (const f32x4*)g + lane;
        const f32x4* sh = (const f32x4*)(ada + (size_t)b * NADA + ish * D_) + lane;
        const f32x4* sc = (const f32x4*)(ada + (size_t)b * NADA + isc * D_) + lane;
        u32x2* o = (u32x2*)(H + (size_t)m * D_) + lane;
#pragma unroll
        for (int j = 0; j < 8; ++j) {
            const f32x4 y = v[j] * r * gp[64 * j] * (sc[64 * j] + 1.0f) + sh[64 * j];
            u32x2 w; w.x = cvt_pk_bf16(y.x, y.y); w.y = cvt_pk_bf16(y.z, y.w); o[64 * j] = w;
        }
    }
}

template <int NR, int NDT, int MODE>
__device__ __forceinline__ void att_step(const bf16_t* __restrict__ Kf, const bf16_t* __restrict__ Vf, int k0, int tq  , int lane8  ,
                                         const LAS bf16x8* qs, f32x4 (&O)[NR][NDT], float (&m)[NR], float (&l)[NR], const float (&coef)[NR], bool vblk) {
    constexpr float SC = 0.08838834764831845f;
    const bf16_t* kb = Kf + (size_t)(k0 >> 4) * 2048 + lane8;
    const bf16_t* vb = Vf + (size_t)(k0 >> 5) * (NDT * 512) + lane8;
    const int dq = tq - k0;
    f32x4 sa[NR][2];
#pragma unroll
    for (int kt = 0; kt < 2; ++kt) {
        bf16x8 kf[4];
#pragma unroll
        for (int dc = 0; dc < 4; ++dc) kf[dc] = *(const bf16x8*)(kb + kt * 2048 + dc * 512);
#pragma unroll
        for (int r = 0; r < NR; ++r) { sa[r][kt] = (f32x4){0.f, 0.f, 0.f, 0.f};
#pragma unroll
            for (int dc = 0; dc < 4; ++dc) sa[r][kt] = MFMA16(kf[dc], qs[(r * 4 + dc) * 64], sa[r][kt]); }
        __builtin_amdgcn_sched_barrier(0);
    }
    bf16x8 Pb[NR];
    const float dqf = (float)dq;
#pragma unroll
    for (int r = 0; r < NR; ++r) {
        f32x4 s[2]; s[0] = sa[r][0]; s[1] = sa[r][1];
        float p[2][4];
        if (MODE == 2) {
#pragma unroll
            for (int kt = 0; kt < 2; ++kt)
#pragma unroll
                for (int j = 0; j < 4; ++j) { const bool valid = dq >= (16 * kt + j); p[kt][j] = valid ? s[kt][j] * SC * ex2(coef[r] * (dqf - (float)(16 * kt + j))) : 0.f; }
        } else {
            float mx = -INFINITY;
#pragma unroll
            for (int kt = 0; kt < 2; ++kt)
#pragma unroll
                for (int j = 0; j < 4; ++j) {
                    const bool valid = (MODE == 0) ? (vblk && dq >= (16 * kt + j)) : (dq >= (16 * kt + j) && dq < 512 + (16 * kt + j));
                    const float v = valid ? s[kt][j] * (SC * LOG2E) - coef[r] * (dqf - (float)(16 * kt + j)) : -INFINITY;
                    p[kt][j] = v; mx = fmaxf(mx, v);
                }
            mx = fmaxf(mx, __shfl_xor(mx, 16)); mx = fmaxf(mx, __shfl_xor(mx, 32));
            const float mnew = fmaxf(m[r], mx), muse = (mnew == -INFINITY) ? 0.f : mnew;
            const float alpha = ex2(m[r] - muse);
            float ps = 0.f;
#pragma unroll
            for (int kt = 0; kt < 2; ++kt)
#pragma unroll
                for (int j = 0; j < 4; ++j) { p[kt][j] = ex2(p[kt][j] - muse); ps += p[kt][j]; }
            l[r] = l[r] * alpha + ps; m[r] = mnew;
#pragma unroll
            for (int dt = 0; dt < NDT; ++dt) O[r][dt] *= alpha;
        }
        u32x4 pw; pw.x = cvt_pk_bf16(p[0][0], p[0][1]); pw.y = cvt_pk_bf16(p[0][2], p[0][3]); pw.z = cvt_pk_bf16(p[1][0], p[1][1]); pw.w = cvt_pk_bf16(p[1][2], p[1][3]);
        Pb[r] = __builtin_bit_cast(bf16x8, pw);
    }
#pragma unroll
    for (int dt = 0; dt < NDT; ++dt) {
        const bf16x8 vf = *(const bf16x8*)(vb + dt * 512);
#pragma unroll
        for (int r = 0; r < NR; ++r) O[r][dt] = MFMA16(vf, Pb[r], O[r][dt]);
        if ((dt & 3) == 3) __builtin_amdgcn_sched_barrier(0);
    }
}

struct MixPtrs { const bf16_t* Y; bf16_t* ONSA; bf16_t* ORET; const bf16_t* VTS; const bf16_t* VTW; const bf16_t* VTR; const bf16_t* KC; const bf16_t* VCT; const float* gn; const bf16_t* KS; const bf16_t* KW; const bf16_t* KR; };

__device__ __forceinline__ void nsa_unit(const MixPtrs& P, int b, int g, int tile, int lane, LAS bf16x8* qs  ) {
    const int l15 = lane & 15, fq = lane >> 4, t0 = tile * 16, t = t0 + l15, bg = b * 4 + g;
    const bf16_t* Yb = P.Y + (size_t)(b * 2048) * LDY;
    const bf16_t* Yt = Yb + (size_t)t * LDY;
    bf16_t* orow = P.ONSA + (size_t)(b * 2048 + t) * D_;
    constexpr float SC2 = 0.08838834764831845f * LOG2E;
    const int tq64 = t - 64 * fq; const float tq64f = (float)tq64 - 15.5f;
    const int tq = t - 4 * fq, lane8 = lane * 8;
    float pown[8], ptail[8];
#pragma unroll
    for (int kt = 0; kt < 8; ++kt) { pown[kt] = 0.f; ptail[kt] = 0.f; }
#pragma unroll
    for (int hd = 0; hd < 4; ++hd)
#pragma unroll
        for (int dc = 0; dc < 4; ++dc) qs[(hd * 4 + dc) * 64] = *(const bf16x8*)(Yt + OFF_Q + (4 * g + hd) * 128 + 32 * dc + 8 * fq);
#ifndef NO_CMP
#pragma unroll 1
    for (int hd = 0; hd < 4; ++hd) {
        const int hh = 4 * g + hd;
        const bf16_t* kcb = P.KC + (size_t)bg * 16384 + lane * 8;
        const bf16_t* vcb = P.VCT + (size_t)bg * 16384 + lane * 8;
        asm volatile("" : "+v"(kcb), "+v"(vcb));
        const LAS bf16x8* Qf = qs + hd * 4 * 64;
        f32x4 s[8];
#pragma unroll
        for (int kt = 0; kt < 8; ++kt) { s[kt] = (f32x4){0.f, 0.f, 0.f, 0.f};
#pragma unroll
            for (int dc = 0; dc < 4; ++dc) { const bf16x8 kf = *(const bf16x8*)(kcb + kt * 2048 + dc * 512); s[kt] = MFMA16(kf, Qf[dc * 64], s[kt]); }
            if (kt & 1) __builtin_amdgcn_sched_barrier(0); }
        const float slope2 = ex2(-0.5f * (float)(hh + 1)) * LOG2E;
        float mx = -INFINITY;
#pragma unroll
        for (int kt = 0; kt < 8; ++kt)
#pragma unroll
            for (int j = 0; j < 4; ++j) {
                const bool valid = (256 * kt + 16 * j + 31) <= tq64;
                const float v = valid ? s[kt][j] * SC2 - slope2 * (tq64f - (float)(256 * kt + 16 * j)) : -INFINITY;
                s[kt][j] = v; mx = fmaxf(mx, v);
            }
        mx = fmaxf(mx, __shfl_xor(mx, 16)); mx = fmaxf(mx, __shfl_xor(mx, 32));
        const float muse = (mx == -INFINITY) ? 0.f : mx;
        float ls = 0.f;
#pragma unroll
        for (int kt = 0; kt < 8; ++kt)
#pragma unroll
            for (int j = 0; j < 4; ++j) { const float pv = ex2(s[kt][j] - muse); s[kt][j] = pv; ls += pv; }
        ls += __shfl_xor(ls, 16); ls += __shfl_xor(ls, 32);
        const float inv = 1.0f / fmaxf(ls, 1.17549435e-38f);
#pragma unroll
        for (int kt = 0; kt < 8; ++kt)
#pragma unroll
            for (int j = 0; j < 4; ++j) s[kt][j] *= inv;
#pragma unroll
        for (int kt = 0; kt < 8; ++kt) { const float h3 = 0.5f * s[kt][3]; ptail[kt] += h3; pown[kt] += ((s[kt][0] + s[kt][1]) + s[kt][2]) + h3; }
        f32x4 O[8];
#pragma unroll
        for (int dt = 0; dt < 8; ++dt) O[dt] = (f32x4){0.f, 0.f, 0.f, 0.f};
#pragma unroll
        for (int ks = 0; ks < 4; ++ks) {
            u32x4 pw; pw.x = cvt_pk_bf16(s[2 * ks][0], s[2 * ks][1]); pw.y = cvt_pk_bf16(s[2 * ks][2], s[2 * ks][3]);
            pw.z = cvt_pk_bf16(s[2 * ks + 1][0], s[2 * ks + 1][1]); pw.w = cvt_pk_bf16(s[2 * ks + 1][2], s[2 * ks + 1][3]);
            const bf16x8 Pb = __builtin_bit_cast(bf16x8, pw);
#pragma unroll
            for (int dt = 0; dt < 8; ++dt) {
                O[dt] = MFMA16(*(const bf16x8*)(vcb + (ks * 8 + dt) * 512), Pb, O[dt]);
            }
            __builtin_amdgcn_sched_barrier(0);
        }
        const float gate = sigmoid_f(bf2f(Yt[OFF_GL + hh]));
#pragma unroll
        for (int dt = 0; dt < 8; ++dt) {
            u32x2 w; w.x = cvt_pk_bf16(O[dt][0] * gate, O[dt][1] * gate); w.y = cvt_pk_bf16(O[dt][2] * gate, O[dt][3] * gate);
            *(u32x2*)(orow + hh * 128 + 16 * dt + 4 * fq) = w;
        }
    }
#endif
    unsigned sm = 0;
#ifdef NO_SEL
    sm = (unsigned)Yt[0];
#endif
#ifndef NO_SEL
    {
        float val[8], tail[8], sh[8];
        const int bq = (t >> 6) - fq;
#pragma unroll
        for (int kt = 0; kt < 8; ++kt) { tail[kt] = ptail[kt]; sh[kt] = __shfl(tail[kt], (lane + 48) & 63); }
#pragma unroll
        for (int kt = 0; kt < 8; ++kt) {
            const float prev = fq > 0 ? sh[kt] : (kt > 0 ? sh[kt > 0 ? kt - 1 : 0] : 0.f);
            const float imp = pown[kt] + prev;
            const bool forced = (kt == 0 && fq == 0) || (4 * kt == bq) || (4 * kt == bq - 1);
            val[kt] = forced ? 1e4f : (4 * kt <= bq ? imp : -1e4f);
        }
        int cnt[8];
#pragma unroll
        for (int kt = 0; kt < 8; ++kt) cnt[kt] = 0;
#pragma unroll 1
        for (int f2 = 0; f2 < 4; ++f2) {
            const int df = fq - f2;
#pragma unroll
            for (int k2 = 0; k2 < 8; ++k2) {
                const float o = __shfl(val[k2], l15 + 16 * f2);
#pragma unroll
                for (int kt = 0; kt < 8; ++kt) cnt[kt] += ((o > val[kt]) || (o == val[kt] && (4 * (k2 - kt)) < df)) ? 1 : 0;
            }
        }
        unsigned smq = 0;
#pragma unroll
        for (int kt = 0; kt < 8; ++kt) if (cnt[kt] < 16) smq |= 1u << (4 * kt);
        sm = smq << fq;
        sm |= __shfl_xor(sm, 16); sm |= __shfl_xor(sm, 32);
    }
#endif
#ifndef NO_SW
#pragma unroll 1
    for (int hp = 0; hp < 2; ++hp) {
        float coef[2], m[2], l[2]; f32x4 O[2][8];
        const LAS bf16x8* Qf = qs + hp * 8 * 64;
#pragma unroll
        for (int r = 0; r < 2; ++r) coef[r] = ex2(-0.5f * (float)(4 * g + 2 * hp + r + 1)) * LOG2E;
#pragma unroll 1
        for (int br = 1; br < 3; ++br) {
#pragma unroll
            for (int r = 0; r < 2; ++r) { m[r] = -INFINITY; l[r] = 0.f;
#pragma unroll
                for (int dt = 0; dt < 8; ++dt) O[r][dt] = (f32x4){0.f, 0.f, 0.f, 0.f}; }
            if (br == 1) {
                const bf16_t* Kp = P.KS + (size_t)bg * 262144; const bf16_t* Vt = P.VTS + (size_t)bg * 262144;
                const int blkmax = (t0 + 15) >> 6;
#pragma unroll 1
                for (int jb = 0; jb <= blkmax; ++jb) {
                    const bool vb = (sm >> jb) & 1u;
                    if (__ballot(vb) == 0ull) continue;
                    att_step<2, 8, 0>(Kp, Vt, 64 * jb, tq, lane8, Qf, O, m, l, coef, vb);
                    att_step<2, 8, 0>(Kp, Vt, 64 * jb + 32, tq, lane8, Qf, O, m, l, coef, vb);
                }
            } else {
                const bf16_t* Kp = P.KW + (size_t)bg * 262144; const bf16_t* Vt = P.VTW + (size_t)bg * 262144;
                int kstart = t0 - 511; kstart = kstart < 0 ? 0 : (kstart & ~31);
#pragma unroll 1
                for (int k0 = kstart; k0 <= t0; k0 += 32) att_step<2, 8, 1>(Kp, Vt, k0, tq, lane8, Qf, O, m, l, coef, true);
            }
#pragma unroll
            for (int r = 0; r < 2; ++r) {
                const int hh = 4 * g + 2 * hp + r;
                float lt = l[r]; lt += __shfl_xor(lt, 16); lt += __shfl_xor(lt, 32);
                const float sc = sigmoid_f(bf2f(Yt[OFF_GL + br * 16 + hh])) / fmaxf(lt, 1.17549435e-38f);
#pragma unroll
                for (int dt = 0; dt < 8; ++dt) {
                    u32x2* op = (u32x2*)(orow + hh * 128 + 16 * dt + 4 * fq);
                    const u32x2 pw = *op;
                    u32x2 w; w.x = cvt_pk_bf16(bf_lo(pw.x) + O[r][dt][0] * sc, bf_hi(pw.x) + O[r][dt][1] * sc);
                    w.y = cvt_pk_bf16(bf_lo(pw.y) + O[r][dt][2] * sc, bf_hi(pw.y) + O[r][dt][3] * sc);
                    *op = w;
                }
            }
        }
    }
#endif
}

__device__ __forceinline__ void ret_unit(const MixPtrs& P, int b, int h, int tile, int lane, LAS bf16x8* qs) {
    const int l15 = lane & 15, fq = lane >> 4, t0 = tile * 16, t = t0 + l15;
    const bf16_t* Yb = P.Y + (size_t)(b * 2048) * LDY;
    const bf16_t* Yt = Yb + (size_t)t * LDY;
    float coef[1], m[1], l[1]; f32x4 O[1][16];
    const LAS bf16x8* Qf = qs;
#pragma unroll
    for (int dc = 0; dc < 4; ++dc) qs[dc * 64] = *(const bf16x8*)(Yt + OFF_QR + h * 128 + 32 * dc + 8 * fq);
    coef[0] = log1pf(-exp2f(-5.0f - (float)h)) * LOG2E; m[0] = 0.f; l[0] = 0.f;
#pragma unroll
    for (int dt = 0; dt < 16; ++dt) O[0][dt] = (f32x4){0.f, 0.f, 0.f, 0.f};
    const bf16_t* Kp = P.KR + (size_t)(b * 8 + h) * 262144; const bf16_t* Vt = P.VTR + (size_t)(b * 8 + h) * 524288;
#pragma unroll 1
    for (int k0 = 0; k0 <= t0; k0 += 32) att_step<1, 16, 2>(Kp, Vt, k0, t - 4 * fq, lane * 8, Qf, O, m, l, coef, true);
    float sum = 0.f;
#pragma unroll
    for (int dt = 0; dt < 16; ++dt) sum += (O[0][dt][0] + O[0][dt][1]) + (O[0][dt][2] + O[0][dt][3]);
    sum += __shfl_xor(sum, 16); sum += __shfl_xor(sum, 32);
    const float mean = sum * (1.0f / 256.0f);
    float var = 0.f;
#pragma unroll
    for (int dt = 0; dt < 16; ++dt) { const f32x4 d = O[0][dt] - mean; var += (d[0] * d[0] + d[1] * d[1]) + (d[2] * d[2] + d[3] * d[3]); }
    var += __shfl_xor(var, 16); var += __shfl_xor(var, 32);
    const float rstd = 1.0f / sqrtf(var * (1.0f / 256.0f) + EPS_);
    bf16_t* orow = P.ORET + (size_t)(b * 2048 + t) * D_ + h * 256;
#pragma unroll
    for (int dt = 0; dt < 16; ++dt) {
        const int e = 16 * dt + 4 * fq;
        const f32x4 gain = *(const f32x4*)(P.gn + h * 256 + e);
        const u32x2 gw = *(const u32x2*)(Yt + OFF_GR + h * 256 + e);
        const f32x4 y = (O[0][dt] - mean) * rstd * gain;
        u32x2 w; w.x = cvt_pk_bf16(silu_f(bf_lo(gw.x)) * y[0], silu_f(bf_hi(gw.x)) * y[1]); w.y = cvt_pk_bf16(silu_f(bf_lo(gw.y)) * y[2], silu_f(bf_hi(gw.y)) * y[3]);
        *(u32x2*)(orow + e) = w;
    }
}

__device__ __forceinline__ void compress_unit(int unit, const bf16_t* __restrict__ Y, const float* __restrict__ cmp_pos, const float* __restrict__ cmp_b1, const float* __restrict__ g_qk,
                                              const bf16_t* __restrict__ WC1, const bf16_t* __restrict__ WC2, bf16_t* __restrict__ KC, bf16_t* __restrict__ VCT, LAS unsigned char* lds, int tid) {
    const int lane = tid & 63, wave = tid >> 6, l15 = lane & 15, fq = lane >> 4;
    const int i = unit >> 7, bg = (unit >> 3) & 15, ct = unit & 7, b = bg >> 2, g = bg & 3;
    const int c = 16 * ct + l15; const bool cvalid = c < 127;
    const bf16_t* Yc = Y + (size_t)(b * 2048 + 16 * (cvalid ? c : 0)) * LDY + OFF_KV + i * 512 + g * 128;
    LAS float* red = (LAS float*)lds;
    LAS bf16_t* hid = (LAS bf16_t*)(lds + 65536);
    f32x4 acc[8];
#pragma unroll
    for (int nt = 0; nt < 8; ++nt) acc[nt] = (f32x4){0.f, 0.f, 0.f, 0.f};
#pragma unroll 1
    for (int ls = 0; ls < 4; ++ls) {
        const int l = 4 * wave + ls;
#pragma unroll
        for (int dc = 0; dc < 4; ++dc) {
            const int d = 32 * dc + 8 * fq;
            u32x4 aw = (u32x4){0u, 0u, 0u, 0u};
            if (cvalid) {
                const u32x4 zw = *(const u32x4*)(Yc + (size_t)l * LDY + d);
                const f32x4 p0 = *(const f32x4*)(cmp_pos + (size_t)(i * 32 + l) * 128 + d), p1 = *(const f32x4*)(cmp_pos + (size_t)(i * 32 + l) * 128 + d + 4);
                aw.x = cvt_pk_bf16(bf_lo(zw.x) + p0[0], bf_hi(zw.x) + p0[1]); aw.y = cvt_pk_bf16(bf_lo(zw.y) + p0[2], bf_hi(zw.y) + p0[3]);
                aw.z = cvt_pk_bf16(bf_lo(zw.z) + p1[0], bf_hi(zw.z) + p1[1]); aw.w = cvt_pk_bf16(bf_lo(zw.w) + p1[2], bf_hi(zw.w) + p1[3]);
            }
            const bf16x8 a = __builtin_bit_cast(bf16x8, aw);
            const int kidx = l * 128 + 32 * dc + 8 * fq;
#pragma unroll
            for (int nt = 0; nt < 8; ++nt) { const bf16x8 bf = *(const bf16x8*)(WC1 + (size_t)(i * 128 + 16 * nt + l15) * 4096 + kidx); acc[nt] = MFMA16(a, bf, acc[nt]); }
        }
    }
#pragma unroll
    for (int nt = 0; nt < 8; ++nt)
#pragma unroll
        for (int j = 0; j < 4; ++j) red[(wave * 16 + 4 * fq + j) * 128 + 16 * nt + l15] = acc[nt][j];
    __syncthreads();
    {
        const int e = tid * 4, cc = e >> 7, n = e & 127;
        f32x4 s = *(const f32x4*)(cmp_b1 + i * 128 + n);
#pragma unroll
        for (int w = 0; w < 8; ++w) s += *(const LAS f32x4*)(red + (w * 16 + cc) * 128 + n);
        float o[4];
#pragma unroll
        for (int j = 0; j < 4; ++j) { const float x = s[j]; o[j] = 0.5f * x * (1.0f + tanhf(0.7978845608028654f * (x + 0.044715f * x * x * x))); }
        u32x2 w; w.x = cvt_pk_bf16(o[0], o[1]); w.y = cvt_pk_bf16(o[2], o[3]);
        *(LAS u32x2*)(hid + cc * 136 + n) = w;
    }
    __syncthreads();
    f32x4 o2 = (f32x4){0.f, 0.f, 0.f, 0.f};
#pragma unroll
    for (int kc = 0; kc < 4; ++kc) {
        const bf16x8 a = *(const LAS bf16x8*)(hid + l15 * 136 + 32 * kc + 8 * fq);
        const bf16x8 bf = *(const bf16x8*)(WC2 + (size_t)(i * 128 + 16 * wave + l15) * 128 + 32 * kc + 8 * fq);
        o2 = MFMA16(a, bf, o2);
    }
    if (i == 1) {
        const int cbase = 16 * ct + 4 * fq;
        u32x2 w; w.x = cvt_pk_bf16(cbase + 0 < 127 ? o2[0] : 0.f, cbase + 1 < 127 ? o2[1] : 0.f); w.y = cvt_pk_bf16(cbase + 2 < 127 ? o2[2] : 0.f, cbase + 3 < 127 ? o2[3] : 0.f);
        *(u32x2*)(VCT + (size_t)bg * 16384 + (((ct >> 1) * 8 + wave) * 64 + lane) * 8 + 4 * (ct & 1)) = w;
    } else {
#pragma unroll
        for (int j = 0; j < 4; ++j) red[(4 * fq + j) * 128 + 16 * wave + l15] = o2[j];
        __syncthreads();
        const int cc = tid >> 5, part = tid & 31;
        const f32x4 v = *(const LAS f32x4*)(red + cc * 128 + 4 * part);
        float ss = (v[0] * v[0] + v[1] * v[1]) + (v[2] * v[2] + v[3] * v[3]);
#pragma unroll
        for (int o = 1; o < 32; o <<= 1) ss += __shfl_xor(ss, o);
        const float r = 1.0f / sqrtf(ss * (1.0f / 128.0f) + EPS_);
        const f32x4 gq = *(const f32x4*)(g_qk + 128 + 4 * part);
        f32x4 y = v * r * gq;
        if (16 * ct + cc >= 127) y = (f32x4){0.f, 0.f, 0.f, 0.f};
        u32x2 w; w.x = cvt_pk_bf16(y[0], y[1]); w.y = cvt_pk_bf16(y[2], y[3]);
        *(u32x2*)(KC + (size_t)bg * 16384 + (ct * 4 + (part >> 3)) * 512 + ((part >> 1) & 3) * 128 + cc * 8 + 4 * (part & 1)) = w;
    }
    __syncthreads();
}

struct Params {
    const float *x, *c, *w_ada, *b_ada, *g_norm, *w_gate, *w_up, *w_down, *w_in, *g_qk, *cmp_pos, *cmp_w1, *cmp_b1, *cmp_w2, *gn_gain, *w_pn, *w_pr, *w_out;
    float* out; unsigned char* ws; int mask; int pad;
};

__device__ __forceinline__ void conv_ffn(const Params& p, int layer, bf16_t* WGU, bf16_t* WD, LAS float* scr, int gw, int NGW, int lane) {
    constexpr int I_G = (D_ / 64) * (FF_ / 32), I_D = (FF_ / 64) * (D_ / 32);
    const float* wg = p.w_gate + (size_t)layer * D_ * FF_; const float* wu = p.w_up + (size_t)layer * D_ * FF_; const float* wd = p.w_down + (size_t)layer * D_ * FF_;
    for (int it = gw; it < 2 * I_G + I_D; it += NGW) {
        int r = it;
        if (r < I_G) { transpose_item(wg, D_, FF_, WGU, 1, scr, r, lane); continue; } r -= I_G;
        if (r < I_G) { transpose_item(wu, D_, FF_, WGU, 2, scr, r, lane); continue; } r -= I_G;
        transpose_item(wd, FF_, D_, WD, 0, scr, r, lane);
    }
}

__global__ void __launch_bounds__(512, 2) fwd_kernel(Params p) {
    extern __shared__ __attribute__((aligned(16))) unsigned char lds_raw[];
    cg::grid_group grid = cg::this_grid();
    LAS unsigned char* lds = (LAS unsigned char*)lds_raw;
    const int tid = threadIdx.x, lane = tid & 63, wave = __builtin_amdgcn_readfirstlane(tid >> 6);
    const int G = gridDim.x, gw = blockIdx.x * 8 + wave, NGW = G * 8;
#define ctl ((unsigned*)(p.ws + WS_CTL))
#define ada ((float*)(p.ws + WS_ADA))
#define WGU ((bf16_t*)(p.ws + WS_WGU))
#define WD ((bf16_t*)(p.ws + WS_WD))
#define WIN ((bf16_t*)(p.ws + WS_WIN))
#define WPN ((bf16_t*)(p.ws + WS_WPN))
#define WPR ((bf16_t*)(p.ws + WS_WPR))
#define WO ((bf16_t*)(p.ws + WS_WO))
#define WC1 ((bf16_t*)(p.ws + WS_WC1))
#define WC2 ((bf16_t*)(p.ws + WS_WC2))
#define H ((bf16_t*)(p.ws + WS_H))
#define ONSA ((bf16_t*)(p.ws + WS_H))
#define Y ((bf16_t*)(p.ws + WS_Y))
#define ACT ((bf16_t*)(p.ws + WS_Y))
#define MG ((bf16_t*)(p.ws + WS_MG))
#define ORET ((bf16_t*)(p.ws + WS_ORET))
#define VTS ((bf16_t*)(p.ws + WS_VTS))
#define VTW ((bf16_t*)(p.ws + WS_VTW))
#define VTR ((bf16_t*)(p.ws + WS_VTR))
#define KC ((bf16_t*)(p.ws + WS_KC))
#define VCT ((bf16_t*)(p.ws + WS_VCT))
#define KS ((bf16_t*)(p.ws + WS_KS))
#define KW ((bf16_t*)(p.ws + WS_KW))
#define KR ((bf16_t*)(p.ws + WS_KR))
    const int mask = p.mask;
#ifndef DBL_MASK
#define DBL_MASK 0
#endif
#define REPS(k) (1 + ((DBL_MASK >> (k)) & 1))
#ifdef CT_MASK
#define ON(k) ((CT_MASK >> (k)) & 1)
#else
#define ON(k) ((mask >> (k)) & 1)
#endif

    for (int rep = 0; rep < REPS(0); ++rep) { if (rep) grid.sync();
    if (ON(0)) {
        LAS float* cond = (LAS float*)lds;
        LAS float* red = (LAS float*)(lds + 32768);
        for (int i = tid; i < 4 * D_; i += 512) cond[i] = silu_f(p.c[i]);
        __syncthreads();
        for (int it = blockIdx.x; it < NADA / 64; it += G) {
            const int n = it * 64 + lane; float a0 = 0.f, a1 = 0.f, a2 = 0.f, a3 = 0.f;
            const int kb = wave * 256;
#pragma unroll 8
            for (int kk = 0; kk < 256; ++kk) { const int k = kb + kk; const float w = p.w_ada[(size_t)k * NADA + n];
                a0 += cond[k] * w; a1 += cond[D_ + k] * w; a2 += cond[2 * D_ + k] * w; a3 += cond[3 * D_ + k] * w; }
            red[(wave * 4 + 0) * 64 + lane] = a0; red[(wave * 4 + 1) * 64 + lane] = a1; red[(wave * 4 + 2) * 64 + lane] = a2; red[(wave * 4 + 3) * 64 + lane] = a3;
            __syncthreads();
            if (tid < 256) { const int bb = tid >> 6, l = tid & 63; float s = p.b_ada[it * 64 + l];
#pragma unroll
                for (int w = 0; w < 8; ++w) s += red[(w * 4 + bb) * 64 + l];
                ada[(size_t)bb * NADA + it * 64 + l] = s; }
            __syncthreads();
        }
        __syncthreads();
        LAS float* scr = (LAS float*)(lds + wave * 16384);
        conv_ffn(p, 0, WGU, WD, scr, gw, NGW, lane);
        constexpr int I_IN = (D_ / 64) * ((NIN_ + 31) / 32), I_P = (D_ / 64) * (D_ / 32), I_C1 = (4096 / 64) * (128 / 32), I_C2 = (128 / 64) * (128 / 32);
        for (int it = gw; it < I_IN + 3 * I_P + 2 * I_C1 + 2 * I_C2; it += NGW) {
            int r = it;
            if (r < I_IN) { transpose_item(p.w_in, D_, NIN_, WIN, 3, scr, r, lane); continue; } r -= I_IN;
            if (r < I_P) { transpose_item(p.w_pn, D_, D_, WPN, 0, scr, r, lane); continue; } r -= I_P;
            if (r < I_P) { transpose_item(p.w_pr, D_, D_, WPR, 0, scr, r, lane); continue; } r -= I_P;
            if (r < I_P) { transpose_item(p.w_out, D_, D_, WO, 0, scr, r, lane); continue; } r -= I_P;
            if (r < 2 * I_C1) { const int i = r / I_C1; transpose_item(p.cmp_w1 + (size_t)i * 4096 * 128, 4096, 128, WC1 + (size_t)i * 128 * 4096, 0, scr, r - i * I_C1, lane); continue; } r -= 2 * I_C1;
            { const int i = r / I_C2; transpose_item(p.cmp_w2 + (size_t)i * 128 * 128, 128, 128, WC2 + (size_t)i * 128 * 128, 0, scr, r - i * I_C2, lane); }
        }
        { u32x4* z = (u32x4*)(WIN + (size_t)NIN_ * D_); const int nz = (LDY - NIN_) * D_ * 2 / 16;
          for (int i = blockIdx.x * 512 + tid; i < nz; i += G * 512) z[i] = (u32x4){0u, 0u, 0u, 0u}; }
    }
    }
    grid.sync();
    for (int rep = 0; rep < REPS(1); ++rep) { if (rep) grid.sync();
    if (ON(1)) norm_rows(p.x, p.g_norm, ada, 0, 1, H, gw, NGW, lane);
    }
    grid.sync();
    for (int rep = 0; rep < REPS(2); ++rep) { if (rep) grid.sync();
    if (ON(2)) {
        pg8::Gemm g{H, WGU, T_, 2 * FF_, D_}; pg8::StaticOrder S; S.init(T_, 2 * FF_, G, (int)blockIdx.x);
        EpiSwiglu E{ACT};
        pg8::gemm_phase<EpiSwiglu, pg8::StaticOrder, true, true>(lds, g, S, E);
    }
    }
    grid.sync();
    if (ON(3)) {
        pg8::Gemm g{ACT, WD, T_, D_, FF_}; pg8::StaticOrder S; S.init(T_, D_, G, (int)blockIdx.x);
        EpiResid E{p.x, p.out, ada + 2 * D_, 0.5f};
        pg8::gemm_phase<EpiResid, pg8::StaticOrder, true, true>(lds, g, S, E);
    } else {
        for (size_t i = (size_t)blockIdx.x * 512 + tid; i < (size_t)T_ * D_ / 4; i += (size_t)G * 512) ((f32x4*)p.out)[i] = ((const f32x4*)p.x)[i];
    }
    grid.sync();
    for (int rep = 0; rep < REPS(4); ++rep) { if (rep) grid.sync();
    if (ON(4)) {
        norm_rows(p.out, p.g_norm + D_, ada, 3, 4, H, gw, NGW, lane);
        LAS float* scr = (LAS float*)(lds + wave * 16384);
        conv_ffn(p, 1, WGU, WD, scr, gw, NGW, lane);
    }
    }
    grid.sync();
    for (int rep = 0; rep < REPS(5); ++rep) { if (rep) grid.sync();
    if (ON(5)) {
        pg8::Gemm g{H, WIN, T_, LDY, D_}; pg8::StaticOrder S; S.init(T_, LDY, G, (int)blockIdx.x);
        EpiY E{Y};
        pg8::gemm_phase<EpiY, pg8::StaticOrder, true, true>(lds, g, S, E);
    }
    }
    grid.sync();
    for (int rep = 0; rep < REPS(6); ++rep) { if (rep) grid.sync();
    if (ON(6)) {
        for (int unit = blockIdx.x; unit < 256; unit += G) compress_unit(unit, Y, p.cmp_pos, p.cmp_b1, p.g_qk, WC1, WC2, KC, VCT, lds, tid);
        __syncthreads();
        if (rep == 0) for (int tok = gw; tok < T_; tok += NGW) {
            bf16_t* row = Y + (size_t)tok * LDY;
            const int b = tok >> 11, sidx = tok & 2047, c16 = lane & 15, hsub = lane >> 4;
            const size_t fro = (size_t)((sidx >> 4) * 4 + (c16 >> 2)) * 512 + (c16 & 3) * 128 + (sidx & 15) * 8;
#pragma unroll 1
            for (int seg = 0; seg < 8; ++seg) {
                const int colbase = seg < 4 ? seg * 512 : (seg == 4 ? OFF_KV + 1024 : (seg == 5 ? OFF_KV + 2048 : OFF_KR + (seg - 6) * 512)), gi = seg < 4 ? 0 : (seg == 4 ? 2 : 3);
                const u32x4 w = *(const u32x4*)(row + colbase + lane * 8);
                u32x4 o = w;
                if (seg < 6) {
                    float f[8] = {bf_lo(w.x), bf_hi(w.x), bf_lo(w.y), bf_hi(w.y), bf_lo(w.z), bf_hi(w.z), bf_lo(w.w), bf_hi(w.w)};
                    float ss = 0.f;
#pragma unroll
                    for (int j = 0; j < 8; ++j) ss += f[j] * f[j];
                    ss += __shfl_xor(ss, 1); ss += __shfl_xor(ss, 2); ss += __shfl_xor(ss, 4); ss += __shfl_xor(ss, 8);
                    const float r = 1.0f / sqrtf(ss * (1.0f / 128.0f) + EPS_);
                    const float* gq = p.g_qk + gi * 128 + c16 * 8;
                    const f32x4 g0 = *(const f32x4*)gq, g1 = *(const f32x4*)(gq + 4);
                    o.x = cvt_pk_bf16(f[0] * r * g0[0], f[1] * r * g0[1]); o.y = cvt_pk_bf16(f[2] * r * g0[2], f[3] * r * g0[3]);
                    o.z = cvt_pk_bf16(f[4] * r * g1[0], f[5] * r * g1[1]); o.w = cvt_pk_bf16(f[6] * r * g1[2], f[7] * r * g1[3]);
                }
                bf16_t* dstp;
                if (seg < 4) dstp = row + colbase + lane * 8;
                else if (seg == 4) dstp = KS + (size_t)(b * 4 + hsub) * 262144 + fro;
                else if (seg == 5) dstp = KW + (size_t)(b * 4 + hsub) * 262144 + fro;
                else dstp = KR + (size_t)(b * 8 + (seg - 6) * 4 + hsub) * 262144 + fro;
                *(u32x4*)dstp = o;
            }
        }
        LAS bf16_t* tl = (LAS bf16_t*)(lds + wave * 16384);
        for (int it = gw; it < 48 * 128; it += NGW) {
            const int tt = it / 48, ct = it - tt * 48;
            int srccol, cc, HD; bf16_t* dst;
            if (ct < 8) { srccol = OFF_KV + 3 * 512 + ct * 64; cc = ct * 64; dst = VTS; HD = 128; }
            else if (ct < 16) { srccol = OFF_KV + 5 * 512 + (ct - 8) * 64; cc = (ct - 8) * 64; dst = VTW; HD = 128; }
            else { srccol = OFF_VR + (ct - 16) * 64; cc = (ct - 16) * 64; dst = VTR; HD = 256; }
            const int b = tt >> 5, s0 = (tt & 31) * 64;
            const int head = cc / HD, dt0 = (cc - head * HD) >> 4, NDTh = HD >> 4, nheads = (HD == 128) ? 4 : 8;
#pragma unroll
            for (int i = 0; i < 8; ++i) {
                const int tok = 8 * i + (lane >> 3), ch = lane & 7;
                const u32x4 w = *(const u32x4*)(Y + (size_t)(b * 2048 + s0 + tok) * LDY + srccol + ch * 8);
                LAS bf16_t* d = tl + (ch * 8) * 72 + tok;
                d[0 * 72] = (bf16_t)(w.x & 0xffffu); d[1 * 72] = (bf16_t)(w.x >> 16); d[2 * 72] = (bf16_t)(w.y & 0xffffu); d[3 * 72] = (bf16_t)(w.y >> 16);
                d[4 * 72] = (bf16_t)(w.z & 0xffffu); d[5 * 72] = (bf16_t)(w.z >> 16); d[6 * 72] = (bf16_t)(w.w & 0xffffu); d[7 * 72] = (bf16_t)(w.w >> 16);
            }
            asm volatile("s_waitcnt lgkmcnt(0)" ::: "memory");
            bf16_t* hb = dst + (size_t)(b * nheads + head) * (2048 * HD) + lane * 8;
#pragma unroll
            for (int i = 0; i < 8; ++i) {
                const int ks = i >> 2, dt = i & 3, col = 16 * dt + (lane & 15), fq4 = 4 * (lane >> 4);
                const u32x2 lo = *(const LAS u32x2*)(tl + col * 72 + 32 * ks + fq4), hi = *(const LAS u32x2*)(tl + col * 72 + 32 * ks + 16 + fq4);
                u32x4 w; w.x = lo.x; w.y = lo.y; w.z = hi.x; w.w = hi.y;
                *(u32x4*)(hb + (size_t)(((s0 >> 5) + ks) * NDTh + dt0 + dt) * 512) = w;
            }
            asm volatile("s_waitcnt lgkmcnt(0)" ::: "memory");
        }
    }
    }
    grid.sync();
    for (int rep = 0; rep < REPS(7); ++rep) { if (rep) grid.sync();
    if (ON(7)) {
        MixPtrs MP{Y, ONSA, ORET, VTS, VTW, VTR, KC, VCT, p.gn_gain, KS, KW, KR};
        LAS bf16x8* qs = (LAS bf16x8*)(lds + wave * 16384) + lane;
        for (;;) {
            unsigned id = 0;
            if (lane == 0) id = atomicAdd(ctl + 64 * rep, 1u);
            id = (unsigned)__builtin_amdgcn_readfirstlane((int)id);
            if (id >= 128u * 48u) break;
            const int tile = 127 - (int)(id / 48u), sub = (int)(id % 48u);
#ifndef NO_NSA
            if (sub < 16) nsa_unit(MP, sub >> 2, sub & 3, tile, lane, qs);
#endif
#ifndef NO_RET
            if (sub >= 16) ret_unit(MP, (sub - 16) >> 3, (sub - 16) & 7, tile, lane, qs);
#endif
        }
    }
    }
    grid.sync();
    for (int rep = 0; rep < REPS(8); ++rep) { if (rep) grid.sync();
    if (ON(8)) {
        { pg8::Gemm g{ONSA, WPN, T_, D_, D_}; pg8::StaticOrder S; S.init(T_, D_, G, (int)blockIdx.x);
          EpiMerge<false> E{MG, Y, OFF_GA};
          pg8::gemm_phase<EpiMerge<false>, pg8::StaticOrder, true, true>(lds, g, S, E); }
        __syncthreads();
        { pg8::Gemm g{ORET, WPR, T_, D_, D_}; pg8::StaticOrder S; S.init(T_, D_, G, (int)blockIdx.x);
          EpiMerge<true> E{MG, Y, OFF_GB};
          pg8::gemm_phase<EpiMerge<true>, pg8::StaticOrder, true, true>(lds, g, S, E); }
    }
    }
    grid.sync();
    if (ON(9)) {
        pg8::Gemm g{MG, WO, T_, D_, D_}; pg8::StaticOrder S; S.init(T_, D_, G, (int)blockIdx.x);
        EpiResid E{p.out, p.out, ada + 5 * D_, 1.0f};
        pg8::gemm_phase<EpiResid, pg8::StaticOrder, true, true>(lds, g, S, E);
    }
    grid.sync();
    for (int rep = 0; rep < REPS(10); ++rep) { if (rep) grid.sync();
    if (ON(10)) norm_rows(p.out, p.g_norm + 2 * D_, ada, 6, 7, H, gw, NGW, lane);
    }
    grid.sync();
    for (int rep = 0; rep < REPS(11); ++rep) { if (rep) grid.sync();
    if (ON(11)) {
        pg8::Gemm g{H, WGU, T_, 2 * FF_, D_}; pg8::StaticOrder S; S.init(T_, 2 * FF_, G, (int)blockIdx.x);
        EpiSwiglu E{ACT};
        pg8::gemm_phase<EpiSwiglu, pg8::StaticOrder, true, true>(lds, g, S, E);
    }
    }
    grid.sync();
    if (ON(12)) {
        pg8::Gemm g{ACT, WD, T_, D_, FF_}; pg8::StaticOrder S; S.init(T_, D_, G, (int)blockIdx.x);
        EpiResid E{p.out, p.out, ada + 8 * D_, 0.5f};
        pg8::gemm_phase<EpiResid, pg8::StaticOrder, true, true>(lds, g, S, E);
    }
#undef ON
#undef ctl
#undef ada
#undef WGU
#undef WD
#undef WIN
#undef WPN
#undef WPR
#undef WO
#undef WC1
#undef WC2
#undef H
#undef ONSA
#undef Y
#undef ACT
#undef MG
#undef ORET
#undef VTS
#undef VTW
#undef VTR
#undef KC
#undef VCT
#undef KS
#undef KW
#undef KR
}

#ifndef PHASE_MASK
#define PHASE_MASK 0x1fff
#endif
extern "C" void kernel_launch(void* const* d_in, const int* in_sizes, int n_in, void* d_out, int out_size, void* d_ws, size_t ws_size, hipStream_t stream) {
    static int grid_blocks = 0;
    if (grid_blocks == 0) {
        if (n_in != 18 || ws_size < WS_END) { fprintf(stderr, "kernel_launch: unexpected n_in %d or workspace %zu < %zu\n", n_in, ws_size, (size_t)WS_END); grid_blocks = -1; return; }
        int dev = 0, cus = 0, per_cu = 0;
        hipGetDevice(&dev);
        hipDeviceGetAttribute(&cus, hipDeviceAttributeMultiprocessorCount, dev);
        if (hipFuncSetAttribute((const void*)fwd_kernel, hipFuncAttributeMaxDynamicSharedMemorySize, LDS_BYTES) != hipSuccess) { fprintf(stderr, "kernel_launch: hipFuncSetAttribute failed\n"); grid_blocks = -1; return; }
        if (hipOccupancyMaxActiveBlocksPerMultiprocessor(&per_cu, (const void*)fwd_kernel, 512, LDS_BYTES) != hipSuccess || per_cu < 1) { fprintf(stderr, "kernel_launch: occupancy query gave %d\n", per_cu); per_cu = 1; }
        (void)hipGetLastError();
        grid_blocks = cus * 1;
    }
    if (grid_blocks < 0) return;
    (void)hipMemsetAsync((char*)d_ws + WS_CTL, 0, 4096, stream);
    Params p{};
    p.x = (const float*)d_in[0]; p.c = (const float*)d_in[1]; p.w_ada = (const float*)d_in[2]; p.b_ada = (const float*)d_in[3]; p.g_norm = (const float*)d_in[4];
    p.w_gate = (const float*)d_in[5]; p.w_up = (const float*)d_in[6]; p.w_down = (const float*)d_in[7]; p.w_in = (const float*)d_in[8]; p.g_qk = (const float*)d_in[9];
    p.cmp_pos = (const float*)d_in[10]; p.cmp_w1 = (const float*)d_in[11]; p.cmp_b1 = (const float*)d_in[12]; p.cmp_w2 = (const float*)d_in[13]; p.gn_gain = (const float*)d_in[14];
    p.w_pn = (const float*)d_in[15]; p.w_pr = (const float*)d_in[16]; p.w_out = (const float*)d_in[17];
    p.out = (float*)d_out; p.ws = (unsigned char*)d_ws; p.mask = PHASE_MASK; p.pad = 0;
    void* args[] = {&p};
    hipError_t e = hipLaunchCooperativeKernel((const void*)fwd_kernel, dim3(grid_blocks), dim3(512), args, LDS_BYTES, stream);
    if (e != hipSuccess) fprintf(stderr, "kernel_launch: cooperative launch failed: %s (grid %d)\n", hipGetErrorString(e), grid_blocks);
}
```

```cpp
#include <hip/hip_runtime.h>
#include <hip/hip_cooperative_groups.h>
#include <cstdio>
#include <cstdint>
namespace cg = cooperative_groups;
namespace pg8 {
#define PG8_LAS __attribute__((address_space(3)))
typedef unsigned short bf16_t;
typedef short bf16x8 __attribute__((ext_vector_type(8)));
typedef float f32x4 __attribute__((ext_vector_type(4)));
typedef unsigned u32x4 __attribute__((ext_vector_type(4)));
constexpr int BM = 256, BK = 64, HALF = 128, HTB = HALF * BK * 2  , STAGE_BYTES = 8 * HTB, NXCD = 8, WGM = 8;

__host__ __device__ __forceinline__ int lds_byte(int r, int c) { const int st = (r >> 4) * 2 + (c >> 5), rr = r & 15, cc = c & 31, ob = rr * 64 + cc * 2; return st * 1024 + (ob ^ (((ob >> 9) & 1) << 5)); }
__host__ __device__ __forceinline__ void stage_rc(int b, int& R, int& C) { const int st = b / 1024, sb = b % 1024, swz = sb ^ (((sb >> 9) & 1) << 5); R = (st >> 1) * 16 + swz / 64; C = (st & 1) * 32 + (swz % 64) / 2; }
__host__ __device__ __forceinline__ int perm32(int rho) { const int n = rho >> 4, i = rho & 15; return 8 * (i >> 2) + 4 * n + (i & 3); }

struct Unit { int pm, pn; };
struct Gemm { const bf16_t* A; const bf16_t* Bt; int M, N, K; };

struct StaticOrder {
    int nM, nN, nwg, G, c;
    __host__ __device__ void init(int M, int N, int G_, int c_) { nM = M / BM; nN = N / BM; nwg = nM * nN; G = G_; c = c_; }
    __host__ __device__ bool next(int i, Unit& u) const {
        const long L = (long)i * G + c; if (L >= nwg) return false;
        int wgid = (int)L; { const int q = nwg / NXCD, r = nwg % NXCD, xcd = wgid % NXCD, off = wgid / NXCD; wgid = (xcd < r ? xcd * (q + 1) : r * (q + 1) + (xcd - r) * q) + off; }
        const int nig = WGM * nN, gid = wgid / nig, fm = gid * WGM, gsz = (nM - fm) < WGM ? (nM - fm) : WGM;
        u.pm = fm + ((wgid % nig) % gsz); u.pn = (wgid % nig) / gsz; return true;
    }
    __device__ __forceinline__ void a_ready(const Unit&) const {}
    __device__ __forceinline__ void done(const Unit&) const {}
};

__device__ __forceinline__ unsigned cvt_pk_bf16(float lo, float hi) { unsigned r; asm volatile("v_cvt_pk_bf16_f32 %0, %1, %2" : "=v"(r) : "v"(lo), "v"(hi)); return r; }
typedef float f32x2 __attribute__((ext_vector_type(2)));
template <class Epi, class Sched, bool ALIGN_EPI = false, bool SP2 = false>
__device__ __forceinline__ void gemm_phase(PG8_LAS unsigned char* lds, const Gemm g, const Sched& S, const Epi& E) {
    int tid_o = threadIdx.x; asm volatile("" : "+v"(tid_o));
    const int tid = tid_o, wid = __builtin_amdgcn_readfirstlane(tid >> 6), lane = tid & 63, wr = wid >> 2, wc = wid & 3, fr = lane & 15, fq = lane >> 4;
    const int K = g.K, nt = K / BK;
    unsigned voffA[2], voffB[2];
#pragma unroll
    for (int i = 0; i < 2; ++i) { int R, C; stage_rc(tid * 16 + i * 8192, R, C); const int Rb = Epi::PERM ? ((R & ~31) + perm32(R & 31)) : R;
        voffA[i] = (unsigned)(R * K + C) * 2u; voffB[i] = (unsigned)(Rb * K + C) * 2u; }
    const size_t kstep = (size_t)(BK * 2);
    const size_t hstep = (size_t)HALF * K * 2;
    const size_t tstep = 2 * hstep;
    const unsigned ldsw = (unsigned)wid * 1024u;
    const int aoff = lds_byte(wr * 64 + fr, fq * 8), boff = lds_byte(wc * 32 + fr, fq * 8);
#define PG8_SA(b, h) (((b) * 2 + (h)) * HTB)
#define PG8_SB(b, h) ((4 + (b) * 2 + (h)) * HTB)
#define PG8_STAGE(bufoff, gbase, voff) do { _Pragma("unroll") for (int _i = 0; _i < 2; ++_i) \
        __builtin_amdgcn_global_load_lds((const unsigned*)((const char*)(gbase) + (voff)[_i]), (PG8_LAS unsigned*)(lds + (bufoff) + ldsw + _i * 8192), 16, 0, 0); } while (0)
#define PG8_LDA(dst, b, h) do { _Pragma("unroll") for (int m = 0; m < 4; ++m) _Pragma("unroll") for (int k = 0; k < 2; ++k) dst[m][k] = *(const PG8_LAS bf16x8*)(lds + PG8_SA(b, h) + aoff + m * 2048 + k * 1024); } while (0)
#define PG8_LDB(dst, b, h) do { _Pragma("unroll") for (int n = 0; n < 2; ++n) _Pragma("unroll") for (int k = 0; k < 2; ++k) dst[n][k] = *(const PG8_LAS bf16x8*)(lds + PG8_SB(b, h) + boff + n * 2048 + k * 1024); } while (0)
#define PG8_MMA(ai, bj, At, Bt) do { __builtin_amdgcn_s_setprio(1); _Pragma("unroll") for (int m = 0; m < 4; ++m) _Pragma("unroll") for (int n = 0; n < 2; ++n) _Pragma("unroll") for (int k = 0; k < 2; ++k) \
        acc[ai][bj][m][n] = __builtin_amdgcn_mfma_f32_16x16x32_bf16(Bt[n][k], At[m][k], acc[ai][bj][m][n], 0, 0, 0); __builtin_amdgcn_s_setprio(0); } while (0)
#define PG8_WAIT_V(n) asm volatile("s_waitcnt vmcnt(" #n ")" ::: "memory")
#define PG8_WAIT_L(n) asm volatile("s_waitcnt lgkmcnt(" #n ")" ::: "memory")
#define PG8_BAR __builtin_amdgcn_s_barrier()
#define PG8_SCHED __builtin_amdgcn_sched_barrier(0)
    Unit cur, nxt; int ui = 0;
    if (!S.next(0, cur)) return;
    f32x4 acc[2][2][4][2];
#pragma unroll
    for (int a = 0; a < 2; ++a)
#pragma unroll
        for (int b = 0; b < 2; ++b)
#pragma unroll
            for (int m = 0; m < 4; ++m)
#pragma unroll
                for (int n = 0; n < 2; ++n) acc[a][b][m][n] = (f32x4){0.f, 0.f, 0.f, 0.f};
    bf16x8 At[4][2], B0[2][2], B1[2][2];
    const char* cA = (const char*)g.A + (size_t)cur.pm * tstep; const char* cB = (const char*)g.Bt + (size_t)cur.pn * tstep;
    S.a_ready(cur);
    if constexpr (SP2) {
        PG8_STAGE(PG8_SB(0, 0), cB, voffB); PG8_STAGE(PG8_SB(0, 1), cB + hstep, voffB); PG8_STAGE(PG8_SA(0, 0), cA, voffA); PG8_STAGE(PG8_SA(0, 1), cA + hstep, voffA);
        if (wr == 1) PG8_BAR;
        PG8_WAIT_V(2); PG8_BAR;
        PG8_STAGE(PG8_SB(1, 0), cB + kstep, voffB); PG8_STAGE(PG8_SA(1, 0), cA + kstep, voffA); PG8_STAGE(PG8_SB(1, 1), cB + hstep + kstep, voffB);
        PG8_WAIT_V(6); PG8_BAR;
    } else {
        PG8_STAGE(PG8_SB(0, 0), cB, voffB); PG8_STAGE(PG8_SA(0, 0), cA, voffA); PG8_STAGE(PG8_SB(0, 1), cB + hstep, voffB); PG8_STAGE(PG8_SA(0, 1), cA + hstep, voffA);
        if (wr == 1) PG8_BAR;
        PG8_WAIT_V(4); PG8_BAR;
        PG8_STAGE(PG8_SB(1, 0), cB + kstep, voffB); PG8_STAGE(PG8_SA(1, 0), cA + kstep, voffA); PG8_STAGE(PG8_SB(1, 1), cB + hstep + kstep, voffB);
        PG8_WAIT_V(6); PG8_BAR;
    }
    for (;;) {
        const bool has_next = S.next(ui + 1, nxt);
        const char* nA = has_next ? (const char*)g.A + (size_t)nxt.pm * tstep : cA; const char* nB = has_next ? (const char*)g.Bt + (size_t)nxt.pn * tstep : cB;
        for (int t = 0; t < nt; t += 2) {
            const bool last = (t == nt - 2);
            const char* a1 = cA + (size_t)(t + 1) * kstep;
            const char* a2 = last ? nA : cA + (size_t)(t + 2) * kstep; const char* b2 = last ? nB : cB + (size_t)(t + 2) * kstep;
            const char* a3 = a2 + kstep; const char* b3 = b2 + kstep;
            if (last && has_next) S.a_ready(nxt);
            if constexpr (SP2) {
            PG8_LDB(B0, 0, 0); PG8_LDB(B1, 0, 1); PG8_SCHED; PG8_LDA(At, 0, 0); PG8_STAGE(PG8_SA(1, 1), a1 + hstep, voffA);
            PG8_WAIT_V(8); PG8_WAIT_L(0); PG8_BAR; PG8_MMA(0, 0, At, B0); PG8_MMA(0, 1, At, B1); PG8_BAR; PG8_SCHED;
            PG8_LDA(At, 0, 1); PG8_STAGE(PG8_SB(0, 0), b2, voffB); PG8_STAGE(PG8_SB(0, 1), b2 + hstep, voffB); PG8_STAGE(PG8_SA(0, 0), a2, voffA);
            PG8_WAIT_V(8); PG8_WAIT_L(0); PG8_BAR; PG8_MMA(1, 0, At, B0); PG8_MMA(1, 1, At, B1); PG8_BAR; PG8_SCHED;
            PG8_LDB(B0, 1, 0); PG8_LDB(B1, 1, 1); PG8_SCHED; PG8_LDA(At, 1, 0); PG8_STAGE(PG8_SA(0, 1), a2 + hstep, voffA);
            PG8_WAIT_V(8); PG8_WAIT_L(0); PG8_BAR; PG8_MMA(0, 0, At, B0); PG8_MMA(0, 1, At, B1); PG8_BAR; PG8_SCHED;
            PG8_LDA(At, 1, 1); PG8_STAGE(PG8_SB(1, 0), b3, voffB); PG8_STAGE(PG8_SB(1, 1), b3 + hstep, voffB); PG8_STAGE(PG8_SA(1, 0), a3, voffA);
            PG8_WAIT_V(8); PG8_WAIT_L(0); PG8_BAR; PG8_MMA(1, 0, At, B0); PG8_MMA(1, 1, At, B1); PG8_BAR; PG8_SCHED;
            } else {
            PG8_LDB(B0, 0, 0); PG8_SCHED; PG8_LDA(At, 0, 0); PG8_STAGE(PG8_SA(1, 1), a1 + hstep, voffA);
            PG8_WAIT_L(8); PG8_BAR; PG8_WAIT_L(0); PG8_MMA(0, 0, At, B0); PG8_BAR; PG8_SCHED;
            PG8_LDB(B1, 0, 1); PG8_STAGE(PG8_SB(0, 0), b2, voffB);
            PG8_BAR; PG8_WAIT_L(0); PG8_MMA(0, 1, At, B1); PG8_BAR;
            PG8_LDA(At, 0, 1); PG8_STAGE(PG8_SA(0, 0), a2, voffA);
            PG8_BAR; PG8_WAIT_L(0); PG8_MMA(1, 0, At, B0); PG8_BAR; PG8_SCHED;
            PG8_STAGE(PG8_SB(0, 1), b2 + hstep, voffB);
            PG8_WAIT_V(6); PG8_BAR; PG8_MMA(1, 1, At, B1); PG8_BAR;
            PG8_LDB(B0, 1, 0); PG8_SCHED; PG8_LDA(At, 1, 0); PG8_STAGE(PG8_SA(0, 1), a2 + hstep, voffA);
            PG8_WAIT_L(8); PG8_BAR; PG8_WAIT_L(0); PG8_MMA(0, 0, At, B0); PG8_BAR; PG8_SCHED;
            PG8_LDB(B1, 1, 1); PG8_STAGE(PG8_SB(1, 0), b3, voffB);
            PG8_BAR; PG8_WAIT_L(0); PG8_MMA(0, 1, At, B1); PG8_BAR;
            PG8_LDA(At, 1, 1); PG8_STAGE(PG8_SA(1, 0), a3, voffA);
            PG8_BAR; PG8_WAIT_L(0); PG8_MMA(1, 0, At, B0); PG8_BAR; PG8_SCHED;
            PG8_STAGE(PG8_SB(1, 1), b3 + hstep, voffB);
            PG8_WAIT_V(6); PG8_BAR; PG8_MMA(1, 1, At, B1); PG8_BAR;
            }
        }
        if constexpr (ALIGN_EPI) { if (wr == 0) PG8_BAR; }
        if constexpr (!Epi::AFTER_DRAIN) { E(acc, cur, wr, wc, fr, fq); S.done(cur); }
        if (!has_next) break;
#pragma unroll
        for (int a = 0; a < 2; ++a)
#pragma unroll
            for (int b = 0; b < 2; ++b)
#pragma unroll
                for (int m = 0; m < 4; ++m)
#pragma unroll
                    for (int n = 0; n < 2; ++n) acc[a][b][m][n] = (f32x4){0.f, 0.f, 0.f, 0.f};
        cur = nxt; cA = nA; cB = nB; ++ui;
        if constexpr (ALIGN_EPI) { if (wr == 1) PG8_BAR; }
    }
    PG8_WAIT_V(0);
    if constexpr (!ALIGN_EPI) { if (wr == 0) PG8_BAR; }
    PG8_BAR;
    if constexpr (Epi::AFTER_DRAIN) { E.fused(acc, cur, wr, wc, fr, fq, lds, wid, lane); S.done(cur); }
#undef PG8_SA
#undef PG8_SB
#undef PG8_STAGE
#undef PG8_LDA
#undef PG8_LDB
#undef PG8_MMA
#undef PG8_WAIT_V
#undef PG8_WAIT_L
#undef PG8_BAR
#undef PG8_SCHED
}
}

#define LAS __attribute__((address_space(3)))
typedef unsigned short bf16_t;
typedef short bf16x8 __attribute__((ext_vector_type(8)));
typedef short s16x4 __attribute__((ext_vector_type(4)));
typedef float f32x4 __attribute__((ext_vector_type(4)));
typedef unsigned u32x4 __attribute__((ext_vector_type(4)));
typedef unsigned u32x2 __attribute__((ext_vector_type(2)));

constexpr int T_ = 8192, D_ = 2048, FF_ = 5632, NIN_ = 15408, LDY = 15616, NADA = 18432;
constexpr int OFF_Q = 0, OFF_KV = 2048, OFF_QR = 5120, OFF_KR = 6144, OFF_VR = 7168, OFF_GR = 9216, OFF_GA = 11264, OFF_GB = 13312, OFF_GL = 15360;
constexpr float LOG2E = 1.4426950408889634f;
constexpr float EPS_ = 1e-6f;

constexpr size_t al256(size_t x) { return (x + 255) & ~(size_t)255; }
constexpr size_t WS_CTL = 0;
constexpr size_t WS_ADA = 4096;
constexpr size_t WS_WGU = al256(WS_ADA + (size_t)4 * NADA * 4);
constexpr size_t WS_WD  = WS_WGU + (size_t)2 * FF_ * D_ * 2;
constexpr size_t WS_WIN = WS_WD + (size_t)D_ * FF_ * 2;
constexpr size_t WS_WPN = WS_WIN + (size_t)LDY * D_ * 2;
constexpr size_t WS_WPR = WS_WPN + (size_t)D_ * D_ * 2;
constexpr size_t WS_WO  = WS_WPR + (size_t)D_ * D_ * 2;
constexpr size_t WS_WC1 = WS_WO + (size_t)D_ * D_ * 2;
constexpr size_t WS_WC2 = WS_WC1 + (size_t)2 * 128 * 4096 * 2;
constexpr size_t WS_H   = WS_WC2 + (size_t)2 * 128 * 128 * 2;
constexpr size_t WS_Y   = WS_H + (size_t)T_ * D_ * 2;
constexpr size_t WS_MG  = WS_Y + (size_t)T_ * LDY * 2;
constexpr size_t WS_ORET = WS_MG + (size_t)T_ * D_ * 2;
constexpr size_t WS_VTS = WS_ORET + (size_t)T_ * D_ * 2;
constexpr size_t WS_VTW = WS_VTS + (size_t)16 * 128 * 2048 * 2;
constexpr size_t WS_VTR = WS_VTW + (size_t)16 * 128 * 2048 * 2;
constexpr size_t WS_KC  = WS_VTR + (size_t)32 * 256 * 2048 * 2;
constexpr size_t WS_VCT = WS_KC + (size_t)16 * 128 * 128 * 2;
constexpr size_t WS_KS  = WS_VCT + (size_t)16 * 128 * 128 * 2;
constexpr size_t WS_KW  = WS_KS + (size_t)16 * 2048 * 128 * 2;
constexpr size_t WS_KR  = WS_KW + (size_t)16 * 2048 * 128 * 2;
constexpr size_t WS_END = WS_KR + (size_t)32 * 2048 * 128 * 2;

constexpr int LDS_BYTES = 131072 + 2048;

using pg8::cvt_pk_bf16;
__device__ __forceinline__ float bf_lo(unsigned w) { return __uint_as_float(w << 16); }
__device__ __forceinline__ float bf_hi(unsigned w) { return __uint_as_float(w & 0xffff0000u); }
__device__ __forceinline__ float bf2f(bf16_t h) { return __uint_as_float((unsigned)h << 16); }
__device__ __forceinline__ float ex2(float x) { return __builtin_amdgcn_exp2f(x); }
__device__ __forceinline__ float sigmoid_f(float x) { return __builtin_amdgcn_rcpf(1.0f + ex2(-x * LOG2E)); }
__device__ __forceinline__ float silu_f(float x) { return x * sigmoid_f(x); }
__device__ __forceinline__ float wave_sum(float v) {
#pragma unroll
    for (int o = 1; o < 64; o <<= 1) v += __shfl_xor(v, o);
    return v;
}
#define MFMA16(a, b, c) __builtin_amdgcn_mfma_f32_16x16x32_bf16((a), (b), (c), 0, 0, 0)

struct EpiSwiglu {
    static constexpr bool PERM = true, AFTER_DRAIN = false;
    bf16_t* O;
    __device__ __forceinline__ void operator()(const f32x4 (&acc)[2][2][4][2], const pg8::Unit& u, int wr, int wc, int fr, int fq) const {
        const int row0 = u.pm * 256 + wr * 64 + fr, col0 = u.pn * 128 + wc * 32 + 8 * fq;
#pragma unroll
        for (int ai = 0; ai < 2; ++ai)
#pragma unroll
            for (int m = 0; m < 4; ++m) {
                bf16_t* rowp = O + (size_t)(row0 + ai * 128 + m * 16) * FF_ + col0;
                const f32x4 g0 = acc[ai][0][m][0], g1 = acc[ai][0][m][1], u0 = acc[ai][1][m][0], u1 = acc[ai][1][m][1];
                u32x4 w;
                w.x = cvt_pk_bf16(silu_f(g0[0]) * u0[0], silu_f(g0[1]) * u0[1]);
                w.y = cvt_pk_bf16(silu_f(g0[2]) * u0[2], silu_f(g0[3]) * u0[3]);
                w.z = cvt_pk_bf16(silu_f(g1[0]) * u1[0], silu_f(g1[1]) * u1[1]);
                w.w = cvt_pk_bf16(silu_f(g1[2]) * u1[2], silu_f(g1[3]) * u1[3]);
                *(u32x4*)rowp = w;
            }
    }
};
struct EpiResid {
    static constexpr bool PERM = false, AFTER_DRAIN = false;
    const float* base; float* out; const float* gate; float coef;
    __device__ __forceinline__ void operator()(const f32x4 (&acc)[2][2][4][2], const pg8::Unit& u, int wr, int wc, int fr, int fq) const {
        const int row0 = u.pm * 256 + wr * 64 + fr, col0 = u.pn * 256 + wc * 32 + 4 * fq, b = u.pm >> 3;
        f32x4 gv[2][2];
#pragma unroll
        for (int bj = 0; bj < 2; ++bj)
#pragma unroll
            for (int n = 0; n < 2; ++n) gv[bj][n] = *(const f32x4*)(gate + (size_t)b * NADA + col0 + bj * 128 + n * 16) * coef;
#pragma unroll
        for (int ai = 0; ai < 2; ++ai)
#pragma unroll
            for (int m = 0; m < 4; ++m) {
                const size_t off = (size_t)(row0 + ai * 128 + m * 16) * D_ + col0;
#pragma unroll
                for (int bj = 0; bj < 2; ++bj)
#pragma unroll
                    for (int n = 0; n < 2; ++n) {
                        const size_t o = off + bj * 128 + n * 16;
                        *(f32x4*)(out + o) = *(const f32x4*)(base + o) + gv[bj][n] * acc[ai][bj][m][n];
                    }
            }
    }
};
struct EpiY {
    static constexpr bool PERM = true, AFTER_DRAIN = false;
    bf16_t* O;
    __device__ __forceinline__ void operator()(const f32x4 (&acc)[2][2][4][2], const pg8::Unit& u, int wr, int wc, int fr, int fq) const {
        const int row0 = u.pm * 256 + wr * 64 + fr, col0 = u.pn * 256 + wc * 32 + 8 * fq;
#pragma unroll
        for (int ai = 0; ai < 2; ++ai)
#pragma unroll
            for (int m = 0; m < 4; ++m) {
                bf16_t* rowp = O + (size_t)(row0 + ai * 128 + m * 16) * LDY + col0;
#pragma unroll
                for (int bj = 0; bj < 2; ++bj) {
                    const f32x4 v0 = acc[ai][bj][m][0], v1 = acc[ai][bj][m][1];
                    u32x4 w; w.x = cvt_pk_bf16(v0[0], v0[1]); w.y = cvt_pk_bf16(v0[2], v0[3]); w.z = cvt_pk_bf16(v1[0], v1[1]); w.w = cvt_pk_bf16(v1[2], v1[3]);
                    *(u32x4*)(rowp + bj * 128) = w;
                }
            }
    }
};
template <bool ADD> struct EpiMerge {
    static constexpr bool PERM = true, AFTER_DRAIN = false;
    bf16_t* O; const bf16_t* Yg; int goff;
    __device__ __forceinline__ void operator()(const f32x4 (&acc)[2][2][4][2], const pg8::Unit& u, int wr, int wc, int fr, int fq) const {
        const int row0 = u.pm * 256 + wr * 64 + fr, col0 = u.pn * 256 + wc * 32 + 8 * fq;
#pragma unroll
        for (int ai = 0; ai < 2; ++ai)
#pragma unroll
            for (int m = 0; m < 4; ++m) {
                const int row = row0 + ai * 128 + m * 16;
#pragma unroll
                for (int bj = 0; bj < 2; ++bj) {
                    const int col = col0 + bj * 128;
                    const u32x4 gw = *(const u32x4*)(Yg + (size_t)row * LDY + goff + col);
                    const f32x4 v0 = acc[ai][bj][m][0], v1 = acc[ai][bj][m][1];
                    float r[8];
                    r[0] = sigmoid_f(bf_lo(gw.x)) * v0[0]; r[1] = sigmoid_f(bf_hi(gw.x)) * v0[1];
                    r[2] = sigmoid_f(bf_lo(gw.y)) * v0[2]; r[3] = sigmoid_f(bf_hi(gw.y)) * v0[3];
                    r[4] = sigmoid_f(bf_lo(gw.z)) * v1[0]; r[5] = sigmoid_f(bf_hi(gw.z)) * v1[1];
                    r[6] = sigmoid_f(bf_lo(gw.w)) * v1[2]; r[7] = sigmoid_f(bf_hi(gw.w)) * v1[3];
                    bf16_t* op = O + (size_t)row * D_ + col;
                    if (ADD) {
                        const u32x4 pw = *(const u32x4*)op;
                        r[0] += bf_lo(pw.x); r[1] += bf_hi(pw.x); r[2] += bf_lo(pw.y); r[3] += bf_hi(pw.y);
                        r[4] += bf_lo(pw.z); r[5] += bf_hi(pw.z); r[6] += bf_lo(pw.w); r[7] += bf_hi(pw.w);
                    }
                    u32x4 w; w.x = cvt_pk_bf16(r[0], r[1]); w.y = cvt_pk_bf16(r[2], r[3]); w.z = cvt_pk_bf16(r[4], r[5]); w.w = cvt_pk_bf16(r[6], r[7]);
                    *(u32x4*)op = w;
                }
            }
    }
};

__device__ __forceinline__ int rowmap(int mode, int n) {
    if (mode == 0) return n;
    if (mode == 1) return ((n >> 7) << 8) + (n & 127);
    if (mode == 2) return ((n >> 7) << 8) + 128 + (n & 127);
    return n < 5120 ? n : (n < 5168 ? OFF_GL + (n - 5120) : n - 48);
}
__device__ __forceinline__ void transpose_item(const float* __restrict__ W, int K, int N, bf16_t* __restrict__ WT, int mode, LAS float* scr, int item, int lane) {
    const int nblk = (N + 31) >> 5, kb = item / nblk, nb = item - kb * nblk, k0 = 64 * kb, n0 = 32 * nb;
    const bool cok = (n0 + (lane & 31)) < N;
#pragma unroll 8
    for (int i = 0; i < 32; ++i) { const int kk = 2 * i + (lane >> 5); scr[kk * 33 + (lane & 31)] = cok ? W[(size_t)(k0 + kk) * N + n0 + (lane & 31)] : 0.f; }
    asm volatile("s_waitcnt lgkmcnt(0)" ::: "memory");
    const int c = lane & 7;
#pragma unroll
    for (int j = 0; j < 4; ++j) {
        const int n = (lane >> 3) + 8 * j; const LAS float* s = scr + (8 * c) * 33 + n;
        u32x4 o; o.x = cvt_pk_bf16(s[0 * 33], s[1 * 33]); o.y = cvt_pk_bf16(s[2 * 33], s[3 * 33]); o.z = cvt_pk_bf16(s[4 * 33], s[5 * 33]); o.w = cvt_pk_bf16(s[6 * 33], s[7 * 33]);
        if (n0 + n < N) *(u32x4*)(WT + (size_t)rowmap(mode, n0 + n) * K + k0 + 8 * c) = o;
    }
    asm volatile("s_waitcnt lgkmcnt(0)" ::: "memory");
}

__device__ __forceinline__ void norm_rows(const float* __restrict__ X, const float* __restrict__ g, const float* __restrict__ ada, int ish, int isc, bf16_t* __restrict__ H, int gw, int NGW, int lane) {
    for (int m = gw; m < T_; m += NGW) {
        const int b = m >> 11;
        const f32x4* xr = (const f32x4*)(X + (size_t)m * D_) + lane;
        f32x4 v[8]; float ss = 0.f;
#pragma unroll
        for (int j = 0; j < 8; ++j) { v[j] = xr[64 * j]; ss += (v[j].x * v[j].x + v[j].y * v[j].y) + (v[j].z * v[j].z + v[j].w * v[j].w); }
        const float r = 1.0f / sqrtf(wave_sum(ss) * (1.0f / D_) + EPS_);
        const f32x4* gp = (const f32x4*)g + lane;
        const f32x4* sh = (const f32x4*)(ada + (size_t)b * NADA + ish * D_) + lane;
        const f32x4* sc = (const f32x4*)(ada + (size_t)b * NADA + isc * D_) + lane;
        u32x2* o = (u32x2*)(H + (size_t)m * D_) + lane;
#pragma unroll
        for (int j = 0; j < 8; ++j) {
            const f32x4 y = v[j] * r * gp[64 * j] * (sc[64 * j] + 1.0f) + sh[64 * j];
            u32x2 w; w.x = cvt_pk_bf16(y.x, y.y); w.y = cvt_pk_bf16(y.z, y.w); o[64 * j] = w;
        }
    }
}

#ifndef VPRE
#define VPRE 4
#endif
template <int NR, int NDT, int MODE>
__device__ __forceinline__ void att_step(const bf16_t* __restrict__ Kf, const bf16_t* __restrict__ Vf, int k0, int tq  , int lane8  ,
                                         const LAS bf16x8* qs, f32x4 (&O)[NR][NDT], float (&m)[NR], float (&l)[NR], const float (&coef)[NR], bool vblk) {
    constexpr float SC = 0.08838834764831845f;
    const bf16_t* kb = Kf + (size_t)(k0 >> 4) * 2048 + lane8;
    const bf16_t* vb = Vf + (size_t)(k0 >> 5) * (NDT * 512) + lane8;
    const int dq = tq - k0;
    constexpr int PRE = (NR == 1) ? NDT : VPRE;
    bf16x8 vfr[PRE];
#pragma unroll
    for (int dt = 0; dt < PRE; ++dt) vfr[dt] = *(const bf16x8*)(vb + dt * 512);
    f32x4 sa[NR][2];
#pragma unroll
    for (int kt = 0; kt < 2; ++kt) {
        bf16x8 kf[4];
#pragma unroll
        for (int dc = 0; dc < 4; ++dc) kf[dc] = *(const bf16x8*)(kb + kt * 2048 + dc * 512);
#pragma unroll
        for (int r = 0; r < NR; ++r) { sa[r][kt] = (f32x4){0.f, 0.f, 0.f, 0.f};
#pragma unroll
            for (int dc = 0; dc < 4; ++dc) sa[r][kt] = MFMA16(kf[dc], qs[(r * 4 + dc) * 64], sa[r][kt]); }
        __builtin_amdgcn_sched_barrier(0);
    }
    bf16x8 Pb[NR];
    const float dqf = (float)dq;
#pragma unroll
    for (int r = 0; r < NR; ++r) {
        f32x4 s[2]; s[0] = sa[r][0]; s[1] = sa[r][1];
        float p[2][4];
        if (MODE == 2) {
#pragma unroll
            for (int kt = 0; kt < 2; ++kt)
#pragma unroll
                for (int j = 0; j < 4; ++j) { const bool valid = dq >= (16 * kt + j); p[kt][j] = valid ? s[kt][j] * SC * ex2(coef[r] * (dqf - (float)(16 * kt + j))) : 0.f; }
        } else {
            float mx = -INFINITY;
#pragma unroll
            for (int kt = 0; kt < 2; ++kt)
#pragma unroll
                for (int j = 0; j < 4; ++j) {
                    const bool valid = (MODE == 0) ? (vblk && dq >= (16 * kt + j)) : (dq >= (16 * kt + j) && dq < 512 + (16 * kt + j));
                    const float v = valid ? s[kt][j] * (SC * LOG2E) - coef[r] * (dqf - (float)(16 * kt + j)) : -INFINITY;
                    p[kt][j] = v; mx = fmaxf(mx, v);
                }
            mx = fmaxf(mx, __shfl_xor(mx, 16)); mx = fmaxf(mx, __shfl_xor(mx, 32));
            const float mnew = fmaxf(m[r], mx), muse = (mnew == -INFINITY) ? 0.f : mnew;
            const float alpha = ex2(m[r] - muse);
            float ps = 0.f;
#pragma unroll
            for (int kt = 0; kt < 2; ++kt)
#pragma unroll
                for (int j = 0; j < 4; ++j) { p[kt][j] = ex2(p[kt][j] - muse); ps += p[kt][j]; }
            l[r] = l[r] * alpha + ps; m[r] = mnew;
#pragma unroll
            for (int dt = 0; dt < NDT; ++dt) O[r][dt] *= alpha;
        }
        u32x4 pw; pw.x = cvt_pk_bf16(p[0][0], p[0][1]); pw.y = cvt_pk_bf16(p[0][2], p[0][3]); pw.z = cvt_pk_bf16(p[1][0], p[1][1]); pw.w = cvt_pk_bf16(p[1][2], p[1][3]);
        Pb[r] = __builtin_bit_cast(bf16x8, pw);
    }
#pragma unroll
    for (int dt = 0; dt < NDT; ++dt) {
        bf16x8 vf;
        if (dt < PRE) vf = vfr[dt]; else vf = *(const bf16x8*)(vb + dt * 512);
#pragma unroll
        for (int r = 0; r < NR; ++r) O[r][dt] = MFMA16(vf, Pb[r], O[r][dt]);
        if ((dt & 3) == 3) __builtin_amdgcn_sched_barrier(0);
    }
}

struct MixPtrs { const bf16_t* Y; bf16_t* ONSA; bf16_t* ORET; const bf16_t* VTS; const bf16_t* VTW; const bf16_t* VTR; const bf16_t* KC; const bf16_t* VCT; const float* gn; const bf16_t* KS; const bf16_t* KW; const bf16_t* KR; };

__device__ __forceinline__ void nsa_unit(const MixPtrs& P, int b, int g, int tile, int hp  , int lane, LAS bf16x8* qs  ) {
    const int l15 = lane & 15, fq = lane >> 4, t0 = tile * 16, t = t0 + l15, bg = b * 4 + g;
    const bf16_t* Yb = P.Y + (size_t)(b * 2048) * LDY;
    const bf16_t* Yt = Yb + (size_t)t * LDY;
    bf16_t* orow = P.ONSA + (size_t)(b * 2048 + t) * D_;
    constexpr float SC2 = 0.08838834764831845f * LOG2E;
    const int tq64 = t - 64 * fq; const float tq64f = (float)tq64 - 15.5f;
    const int tq = t - 4 * fq, lane8 = lane * 8;
    float pown[8], ptail[8];
#pragma unroll
    for (int kt = 0; kt < 8; ++kt) { pown[kt] = 0.f; ptail[kt] = 0.f; }
#pragma unroll
    for (int hd = 0; hd < 4; ++hd)
#pragma unroll
        for (int dc = 0; dc < 4; ++dc) qs[(hd * 4 + dc) * 64] = *(const bf16x8*)(Yt + OFF_Q + (4 * g + hd) * 128 + 32 * dc + 8 * fq);
#ifndef NO_CMP
#pragma unroll 1
    for (int hd = 0; hd < 4; ++hd) {
        const int hh = 4 * g + hd;
        const bf16_t* kcb = P.KC + (size_t)bg * 16384 + lane * 8;
        const bf16_t* vcb = P.VCT + (size_t)bg * 16384 + lane * 8;
        asm volatile("" : "+v"(kcb), "+v"(vcb));
        const LAS bf16x8* Qf = qs + hd * 4 * 64;
        f32x4 s[8];
#pragma unroll
        for (int kt = 0; kt < 8; ++kt) { s[kt] = (f32x4){0.f, 0.f, 0.f, 0.f};
#pragma unroll
            for (int dc = 0; dc < 4; ++dc) { const bf16x8 kf = *(const bf16x8*)(kcb + kt * 2048 + dc * 512); s[kt] = MFMA16(kf, Qf[dc * 64], s[kt]); }
            if (kt & 1) __builtin_amdgcn_sched_barrier(0); }
        const float slope2 = ex2(-0.5f * (float)(hh + 1)) * LOG2E;
        float mx = -INFINITY;
#pragma unroll
        for (int kt = 0; kt < 8; ++kt)
#pragma unroll
            for (int j = 0; j < 4; ++j) {
                const bool valid = (256 * kt + 16 * j + 31) <= tq64;
                const float v = valid ? s[kt][j] * SC2 - slope2 * (tq64f - (float)(256 * kt + 16 * j)) : -INFINITY;
                s[kt][j] = v; mx = fmaxf(mx, v);
            }
        mx = fmaxf(mx, __shfl_xor(mx, 16)); mx = fmaxf(mx, __shfl_xor(mx, 32));
        const float muse = (mx == -INFINITY) ? 0.f : mx;
        float ls = 0.f;
#pragma unroll
        for (int kt = 0; kt < 8; ++kt)
#pragma unroll
            for (int j = 0; j < 4; ++j) { const float pv = ex2(s[kt][j] - muse); s[kt][j] = pv; ls += pv; }
        ls += __shfl_xor(ls, 16); ls += __shfl_xor(ls, 32);
        const float inv = 1.0f / fmaxf(ls, 1.17549435e-38f);
#pragma unroll
        for (int kt = 0; kt < 8; ++kt)
#pragma unroll
            for (int j = 0; j < 4; ++j) s[kt][j] *= inv;
#pragma unroll
        for (int kt = 0; kt < 8; ++kt) { const float h3 = 0.5f * s[kt][3]; ptail[kt] += h3; pown[kt] += ((s[kt][0] + s[kt][1]) + s[kt][2]) + h3; }
        if ((hd >> 1) != hp) continue;
        f32x4 O[8];
#pragma unroll
        for (int dt = 0; dt < 8; ++dt) O[dt] = (f32x4){0.f, 0.f, 0.f, 0.f};
#pragma unroll
        for (int ks = 0; ks < 4; ++ks) {
            u32x4 pw; pw.x = cvt_pk_bf16(s[2 * ks][0], s[2 * ks][1]); pw.y = cvt_pk_bf16(s[2 * ks][2], s[2 * ks][3]);
            pw.z = cvt_pk_bf16(s[2 * ks + 1][0], s[2 * ks + 1][1]); pw.w = cvt_pk_bf16(s[2 * ks + 1][2], s[2 * ks + 1][3]);
            const bf16x8 Pb = __builtin_bit_cast(bf16x8, pw);
#pragma unroll
            for (int dt = 0; dt < 8; ++dt) {
                O[dt] = MFMA16(*(const bf16x8*)(vcb + (ks * 8 + dt) * 512), Pb, O[dt]);
            }
            __builtin_amdgcn_sched_barrier(0);
        }
        const float gate = sigmoid_f(bf2f(Yt[OFF_GL + hh]));
#pragma unroll
        for (int dt = 0; dt < 8; ++dt) {
            u32x2 w; w.x = cvt_pk_bf16(O[dt][0] * gate, O[dt][1] * gate); w.y = cvt_pk_bf16(O[dt][2] * gate, O[dt][3] * gate);
            *(u32x2*)(orow + hh * 128 + 16 * dt + 4 * fq) = w;
        }
    }
#endif
    unsigned sm = 0;
#ifdef NO_SEL
    sm = (unsigned)Yt[0];
#endif
#ifndef NO_SEL
    {
        float val[8], tail[8], sh[8];
        const int bq = (t >> 6) - fq;
#pragma unroll
        for (int kt = 0; kt < 8; ++kt) { tail[kt] = ptail[kt]; sh[kt] = __shfl(tail[kt], (lane + 48) & 63); }
#pragma unroll
        for (int kt = 0; kt < 8; ++kt) {
            const float prev = fq > 0 ? sh[kt] : (kt > 0 ? sh[kt > 0 ? kt - 1 : 0] : 0.f);
            const float imp = pown[kt] + prev;
            const bool forced = (kt == 0 && fq == 0) || (4 * kt == bq) || (4 * kt == bq - 1);
            val[kt] = forced ? 1e4f : (4 * kt <= bq ? imp : -1e4f);
        }
        int cnt[8];
#pragma unroll
        for (int kt = 0; kt < 8; ++kt) cnt[kt] = 0;
#pragma unroll 1
        for (int f2 = 0; f2 < 4; ++f2) {
            const int df = fq - f2;
#pragma unroll
            for (int k2 = 0; k2 < 8; ++k2) {
                const float o = __shfl(val[k2], l15 + 16 * f2);
#pragma unroll
                for (int kt = 0; kt < 8; ++kt) cnt[kt] += ((o > val[kt]) || (o == val[kt] && (4 * (k2 - kt)) < df)) ? 1 : 0;
            }
        }
        unsigned smq = 0;
#pragma unroll
        for (int kt = 0; kt < 8; ++kt) if (cnt[kt] < 16) smq |= 1u << (4 * kt);
        sm = smq << fq;
        sm |= __shfl_xor(sm, 16); sm |= __shfl_xor(sm, 32);
    }
#endif
#ifndef NO_SW
    {
        float coef[2], m[2], l[2]; f32x4 O[2][8];
        const LAS bf16x8* Qf = qs + hp * 8 * 64;
#pragma unroll
        for (int r = 0; r < 2; ++r) coef[r] = ex2(-0.5f * (float)(4 * g + 2 * hp + r + 1)) * LOG2E;
#pragma unroll 1
        for (int br = 1; br < 3; ++br) {
#pragma unroll
            for (int r = 0; r < 2; ++r) { m[r] = -INFINITY; l[r] = 0.f;
#pragma unroll
                for (int dt = 0; dt < 8; ++dt) O[r][dt] = (f32x4){0.f, 0.f, 0.f, 0.f}; }
            if (br == 1) {
                const bf16_t* Kp = P.KS + (size_t)bg * 262144; const bf16_t* Vt = P.VTS + (size_t)bg * 262144;
                const int blkmax = (t0 + 15) >> 6;
#pragma unroll 1
                for (int jb = 0; jb <= blkmax; ++jb) {
                    const bool vb = (sm >> jb) & 1u;
                    if (__ballot(vb) == 0ull) continue;
                    att_step<2, 8, 0>(Kp, Vt, 64 * jb, tq, lane8, Qf, O, m, l, coef, vb);
                    att_step<2, 8, 0>(Kp, Vt, 64 * jb + 32, tq, lane8, Qf, O, m, l, coef, vb);
                }
            } else {
                const bf16_t* Kp = P.KW + (size_t)bg * 262144; const bf16_t* Vt = P.VTW + (size_t)bg * 262144;
                int kstart = t0 - 511; kstart = kstart < 0 ? 0 : (kstart & ~31);
#pragma unroll 1
                for (int k0 = kstart; k0 <= t0; k0 += 32) att_step<2, 8, 1>(Kp, Vt, k0, tq, lane8, Qf, O, m, l, coef, true);
            }
#pragma unroll
            for (int r = 0; r < 2; ++r) {
                const int hh = 4 * g + 2 * hp + r;
                float lt = l[r]; lt += __shfl_xor(lt, 16); lt += __shfl_xor(lt, 32);
                const float sc = sigmoid_f(bf2f(Yt[OFF_GL + br * 16 + hh])) / fmaxf(lt, 1.17549435e-38f);
#pragma unroll
                for (int dt = 0; dt < 8; ++dt) {
                    u32x2* op = (u32x2*)(orow + hh * 128 + 16 * dt + 4 * fq);
                    const u32x2 pw = *op;
                    u32x2 w; w.x = cvt_pk_bf16(bf_lo(pw.x) + O[r][dt][0] * sc, bf_hi(pw.x) + O[r][dt][1] * sc);
                    w.y = cvt_pk_bf16(bf_lo(pw.y) + O[r][dt][2] * sc, bf_hi(pw.y) + O[r][dt][3] * sc);
                    *op = w;
                }
            }
        }
    }
#endif
}

__device__ __forceinline__ void ret_unit(const MixPtrs& P, int b, int h, int tile, int lane, LAS bf16x8* qs) {
    const int l15 = lane & 15, fq = lane >> 4, t0 = tile * 16, t = t0 + l15;
    const bf16_t* Yb = P.Y + (size_t)(b * 2048) * LDY;
    const bf16_t* Yt = Yb + (size_t)t * LDY;
    float coef[1], m[1], l[1]; f32x4 O[1][16];
    const LAS bf16x8* Qf = qs;
#pragma unroll
    for (int dc = 0; dc < 4; ++dc) qs[dc * 64] = *(const bf16x8*)(Yt + OFF_QR + h * 128 + 32 * dc + 8 * fq);
    coef[0] = log1pf(-exp2f(-5.0f - (float)h)) * LOG2E; m[0] = 0.f; l[0] = 0.f;
#pragma unroll
    for (int dt = 0; dt < 16; ++dt) O[0][dt] = (f32x4){0.f, 0.f, 0.f, 0.f};
    const bf16_t* Kp = P.KR + (size_t)(b * 8 + h) * 262144; const bf16_t* Vt = P.VTR + (size_t)(b * 8 + h) * 524288;
#pragma unroll 1
    for (int k0 = 0; k0 <= t0; k0 += 32) att_step<1, 16, 2>(Kp, Vt, k0, t - 4 * fq, lane * 8, Qf, O, m, l, coef, true);
    float sum = 0.f;
#pragma unroll
    for (int dt = 0; dt < 16; ++dt) sum += (O[0][dt][0] + O[0][dt][1]) + (O[0][dt][2] + O[0][dt][3]);
    sum += __shfl_xor(sum, 16); sum += __shfl_xor(sum, 32);
    const float mean = sum * (1.0f / 256.0f);
    float var = 0.f;
#pragma unroll
    for (int dt = 0; dt < 16; ++dt) { const f32x4 d = O[0][dt] - mean; var += (d[0] * d[0] + d[1] * d[1]) + (d[2] * d[2] + d[3] * d[3]); }
    var += __shfl_xor(var, 16); var += __shfl_xor(var, 32);
    const float rstd = 1.0f / sqrtf(var * (1.0f / 256.0f) + EPS_);
    bf16_t* orow = P.ORET + (size_t)(b * 2048 + t) * D_ + h * 256;
#pragma unroll
    for (int dt = 0; dt < 16; ++dt) {
        const int e = 16 * dt + 4 * fq;
        const f32x4 gain = *(const f32x4*)(P.gn + h * 256 + e);
        const u32x2 gw = *(const u32x2*)(Yt + OFF_GR + h * 256 + e);
        const f32x4 y = (O[0][dt] - mean) * rstd * gain;
        u32x2 w; w.x = cvt_pk_bf16(silu_f(bf_lo(gw.x)) * y[0], silu_f(bf_hi(gw.x)) * y[1]); w.y = cvt_pk_bf16(silu_f(bf_lo(gw.y)) * y[2], silu_f(bf_hi(gw.y)) * y[3]);
        *(u32x2*)(orow + e) = w;
    }
}

__device__ __forceinline__ void compress_unit(int unit, const bf16_t* __restrict__ Y, const float* __restrict__ cmp_pos, const float* __restrict__ cmp_b1, const float* __restrict__ g_qk,
                                              const bf16_t* __restrict__ WC1, const bf16_t* __restrict__ WC2, bf16_t* __restrict__ KC, bf16_t* __restrict__ VCT, LAS unsigned char* lds, int tid) {
    const int lane = tid & 63, wave = tid >> 6, l15 = lane & 15, fq = lane >> 4;
    const int i = unit >> 7, bg = (unit >> 3) & 15, ct = unit & 7, b = bg >> 2, g = bg & 3;
    const int c = 16 * ct + l15; const bool cvalid = c < 127;
    const bf16_t* Yc = Y + (size_t)(b * 2048 + 16 * (cvalid ? c : 0)) * LDY + OFF_KV + i * 512 + g * 128;
    LAS float* red = (LAS float*)lds;
    LAS bf16_t* hid = (LAS bf16_t*)(lds + 65536);
    f32x4 acc[8];
#pragma unroll
    for (int nt = 0; nt < 8; ++nt) acc[nt] = (f32x4){0.f, 0.f, 0.f, 0.f};
#pragma unroll 1
    for (int ls = 0; ls < 4; ++ls) {
        const int l = 4 * wave + ls;
#pragma unroll
        for (int dc = 0; dc < 4; ++dc) {
            const int d = 32 * dc + 8 * fq;
            u32x4 aw = (u32x4){0u, 0u, 0u, 0u};
            if (cvalid) {
                const u32x4 zw = *(const u32x4*)(Yc + (size_t)l * LDY + d);
                const f32x4 p0 = *(const f32x4*)(cmp_pos + (size_t)(i * 32 + l) * 128 + d), p1 = *(const f32x4*)(cmp_pos + (size_t)(i * 32 + l) * 128 + d + 4);
                aw.x = cvt_pk_bf16(bf_lo(zw.x) + p0[0], bf_hi(zw.x) + p0[1]); aw.y = cvt_pk_bf16(bf_lo(zw.y) + p0[2], bf_hi(zw.y) + p0[3]);
                aw.z = cvt_pk_bf16(bf_lo(zw.z) + p1[0], bf_hi(zw.z) + p1[1]); aw.w = cvt_pk_bf16(bf_lo(zw.w) + p1[2], bf_hi(zw.w) + p1[3]);
            }
            const bf16x8 a = __builtin_bit_cast(bf16x8, aw);
            const int kidx = l * 128 + 32 * dc + 8 * fq;
#pragma unroll
            for (int nt = 0; nt < 8; ++nt) { const bf16x8 bf = *(const bf16x8*)(WC1 + (size_t)(i * 128 + 16 * nt + l15) * 4096 + kidx); acc[nt] = MFMA16(a, bf, acc[nt]); }
        }
    }
#pragma unroll
    for (int nt = 0; nt < 8; ++nt)
#pragma unroll
        for (int j = 0; j < 4; ++j) red[(wave * 16 + 4 * fq + j) * 128 + 16 * nt + l15] = acc[nt][j];
    __syncthreads();
    {
        const int e = tid * 4, cc = e >> 7, n = e & 127;
        f32x4 s = *(const f32x4*)(cmp_b1 + i * 128 + n);
#pragma unroll
        for (int w = 0; w < 8; ++w) s += *(const LAS f32x4*)(red + (w * 16 + cc) * 128 + n);
        float o[4];
#pragma unroll
        for (int j = 0; j < 4; ++j) { const float x = s[j]; o[j] = 0.5f * x * (1.0f + tanhf(0.7978845608028654f * (x + 0.044715f * x * x * x))); }
        u32x2 w; w.x = cvt_pk_bf16(o[0], o[1]); w.y = cvt_pk_bf16(o[2], o[3]);
        *(LAS u32x2*)(hid + cc * 136 + n) = w;
    }
    __syncthreads();
    f32x4 o2 = (f32x4){0.f, 0.f, 0.f, 0.f};
#pragma unroll
    for (int kc = 0; kc < 4; ++kc) {
        const bf16x8 a = *(const LAS bf16x8*)(hid + l15 * 136 + 32 * kc + 8 * fq);
        const bf16x8 bf = *(const bf16x8*)(WC2 + (size_t)(i * 128 + 16 * wave + l15) * 128 + 32 * kc + 8 * fq);
        o2 = MFMA16(a, bf, o2);
    }
    if (i == 1) {
        const int cbase = 16 * ct + 4 * fq;
        u32x2 w; w.x = cvt_pk_bf16(cbase + 0 < 127 ? o2[0] : 0.f, cbase + 1 < 127 ? o2[1] : 0.f); w.y = cvt_pk_bf16(cbase + 2 < 127 ? o2[2] : 0.f, cbase + 3 < 127 ? o2[3] : 0.f);
        *(u32x2*)(VCT + (size_t)bg * 16384 + (((ct >> 1) * 8 + wave) * 64 + lane) * 8 + 4 * (ct & 1)) = w;
    } else {
#pragma unroll
        for (int j = 0; j < 4; ++j) red[(4 * fq + j) * 128 + 16 * wave + l15] = o2[j];
        __syncthreads();
        const int cc = tid >> 5, part = tid & 31;
        const f32x4 v = *(const LAS f32x4*)(red + cc * 128 + 4 * part);
        float ss = (v[0] * v[0] + v[1] * v[1]) + (v[2] * v[2] + v[3] * v[3]);
#pragma unroll
        for (int o = 1; o < 32; o <<= 1) ss += __shfl_xor(ss, o);
        const float r = 1.0f / sqrtf(ss * (1.0f / 128.0f) + EPS_);
        const f32x4 gq = *(const f32x4*)(g_qk + 128 + 4 * part);
        f32x4 y = v * r * gq;
        if (16 * ct + cc >= 127) y = (f32x4){0.f, 0.f, 0.f, 0.f};
        u32x2 w; w.x = cvt_pk_bf16(y[0], y[1]); w.y = cvt_pk_bf16(y[2], y[3]);
        *(u32x2*)(KC + (size_t)bg * 16384 + (ct * 4 + (part >> 3)) * 512 + ((part >> 1) & 3) * 128 + cc * 8 + 4 * (part & 1)) = w;
    }
    __syncthreads();
}

struct Params {
    const float *x, *c, *w_ada, *b_ada, *g_norm, *w_gate, *w_up, *w_down, *w_in, *g_qk, *cmp_pos, *cmp_w1, *cmp_b1, *cmp_w2, *gn_gain, *w_pn, *w_pr, *w_out;
    float* out; unsigned char* ws; int mask; int pad;
};

__device__ __forceinline__ void conv_ffn(const Params& p, int layer, bf16_t* WGU, bf16_t* WD, LAS float* scr, int gw, int NGW, int lane) {
    constexpr int I_G = (D_ / 64) * (FF_ / 32), I_D = (FF_ / 64) * (D_ / 32);
    const float* wg = p.w_gate + (size_t)layer * D_ * FF_; const float* wu = p.w_up + (size_t)layer * D_ * FF_; const float* wd = p.w_down + (size_t)layer * D_ * FF_;
    for (int it = gw; it < 2 * I_G + I_D; it += NGW) {
        int r = it;
        if (r < I_G) { transpose_item(wg, D_, FF_, WGU, 1, scr, r, lane); continue; } r -= I_G;
        if (r < I_G) { transpose_item(wu, D_, FF_, WGU, 2, scr, r, lane); continue; } r -= I_G;
        transpose_item(wd, FF_, D_, WD, 0, scr, r, lane);
    }
}

__global__ void __launch_bounds__(512, 2) fwd_kernel(Params p) {
    extern __shared__ __attribute__((aligned(16))) unsigned char lds_raw[];
    cg::grid_group grid = cg::this_grid();
    LAS unsigned char* lds = (LAS unsigned char*)lds_raw;
    const int tid = threadIdx.x, lane = tid & 63, wave = __builtin_amdgcn_readfirstlane(tid >> 6);
    const int G = gridDim.x, gw = blockIdx.x * 8 + wave, NGW = G * 8;
#define ctl ((unsigned*)(p.ws + WS_CTL))
#define ada ((float*)(p.ws + WS_ADA))
#define WGU ((bf16_t*)(p.ws + WS_WGU))
#define WD ((bf16_t*)(p.ws + WS_WD))
#define WIN ((bf16_t*)(p.ws + WS_WIN))
#define WPN ((bf16_t*)(p.ws + WS_WPN))
#define WPR ((bf16_t*)(p.ws + WS_WPR))
#define WO ((bf16_t*)(p.ws + WS_WO))
#define WC1 ((bf16_t*)(p.ws + WS_WC1))
#define WC2 ((bf16_t*)(p.ws + WS_WC2))
#define H ((bf16_t*)(p.ws + WS_H))
#define ONSA ((bf16_t*)(p.ws + WS_H))
#define Y ((bf16_t*)(p.ws + WS_Y))
#define ACT ((bf16_t*)(p.ws + WS_Y))
#define MG ((bf16_t*)(p.ws + WS_MG))
#define ORET ((bf16_t*)(p.ws + WS_ORET))
#define VTS ((bf16_t*)(p.ws + WS_VTS))
#define VTW ((bf16_t*)(p.ws + WS_VTW))
#define VTR ((bf16_t*)(p.ws + WS_VTR))
#define KC ((bf16_t*)(p.ws + WS_KC))
#define VCT ((bf16_t*)(p.ws + WS_VCT))
#define KS ((bf16_t*)(p.ws + WS_KS))
#define KW ((bf16_t*)(p.ws + WS_KW))
#define KR ((bf16_t*)(p.ws + WS_KR))
    const int mask = p.mask;
#ifndef DBL_MASK
#define DBL_MASK 0
#endif
#define REPS(k) (1 + ((DBL_MASK >> (k)) & 1))
#ifdef CT_MASK
#define ON(k) ((CT_MASK >> (k)) & 1)
#else
#define ON(k) ((mask >> (k)) & 1)
#endif

    for (int rep = 0; rep < REPS(0); ++rep) { if (rep) grid.sync();
    if (ON(0)) {
        LAS float* cond = (LAS float*)lds;
        LAS float* red = (LAS float*)(lds + 32768);
        for (int i = tid; i < 4 * D_; i += 512) cond[i] = silu_f(p.c[i]);
        __syncthreads();
        for (int it = blockIdx.x; it < NADA / 64; it += G) {
            const int n = it * 64 + lane; float a0 = 0.f, a1 = 0.f, a2 = 0.f, a3 = 0.f;
            const int kb = wave * 256;
#pragma unroll 8
            for (int kk = 0; kk < 256; ++kk) { const int k = kb + kk; const float w = p.w_ada[(size_t)k * NADA + n];
                a0 += cond[k] * w; a1 += cond[D_ + k] * w; a2 += cond[2 * D_ + k] * w; a3 += cond[3 * D_ + k] * w; }
            red[(wave * 4 + 0) * 64 + lane] = a0; red[(wave * 4 + 1) * 64 + lane] = a1; red[(wave * 4 + 2) * 64 + lane] = a2; red[(wave * 4 + 3) * 64 + lane] = a3;
            __syncthreads();
            if (tid < 256) { const int bb = tid >> 6, l = tid & 63; float s = p.b_ada[it * 64 + l];
#pragma unroll
                for (int w = 0; w < 8; ++w) s += red[(w * 4 + bb) * 64 + l];
                ada[(size_t)bb * NADA + it * 64 + l] = s; }
            __syncthreads();
        }
        __syncthreads();
        LAS float* scr = (LAS float*)(lds + wave * 16384);
        conv_ffn(p, 0, WGU, WD, scr, gw, NGW, lane);
        constexpr int I_IN = (D_ / 64) * ((NIN_ + 31) / 32), I_P = (D_ / 64) * (D_ / 32), I_C1 = (4096 / 64) * (128 / 32), I_C2 = (128 / 64) * (128 / 32);
        for (int it = gw; it < I_IN + 3 * I_P + 2 * I_C1 + 2 * I_C2; it += NGW) {
            int r = it;
            if (r < I_IN) { transpose_item(p.w_in, D_, NIN_, WIN, 3, scr, r, lane); continue; } r -= I_IN;
            if (r < I_P) { transpose_item(p.w_pn, D_, D_, WPN, 0, scr, r, lane); continue; } r -= I_P;
            if (r < I_P) { transpose_item(p.w_pr, D_, D_, WPR, 0, scr, r, lane); continue; } r -= I_P;
            if (r < I_P) { transpose_item(p.w_out, D_, D_, WO, 0, scr, r, lane); continue; } r -= I_P;
            if (r < 2 * I_C1) { const int i = r / I_C1; transpose_item(p.cmp_w1 + (size_t)i * 4096 * 128, 4096, 128, WC1 + (size_t)i * 128 * 4096, 0, scr, r - i * I_C1, lane); continue; } r -= 2 * I_C1;
            { const int i = r / I_C2; transpose_item(p.cmp_w2 + (size_t)i * 128 * 128, 128, 128, WC2 + (size_t)i * 128 * 128, 0, scr, r - i * I_C2, lane); }
        }
        { u32x4* z = (u32x4*)(WIN + (size_t)NIN_ * D_); const int nz = (LDY - NIN_) * D_ * 2 / 16;
          for (int i = blockIdx.x * 512 + tid; i < nz; i += G * 512) z[i] = (u32x4){0u, 0u, 0u, 0u}; }
    }
    }
    grid.sync();
    for (int rep = 0; rep < REPS(1); ++rep) { if (rep) grid.sync();
    if (ON(1)) norm_rows(p.x, p.g_norm, ada, 0, 1, H, gw, NGW, lane);
    }
    grid.sync();
    for (int rep = 0; rep < REPS(2); ++rep) { if (rep) grid.sync();
    if (ON(2)) {
        pg8::Gemm g{H, WGU, T_, 2 * FF_, D_}; pg8::StaticOrder S; S.init(T_, 2 * FF_, G, (int)blockIdx.x);
        EpiSwiglu E{ACT};
        pg8::gemm_phase<EpiSwiglu, pg8::StaticOrder, true, true>(lds, g, S, E);
    }
    }
    grid.sync();
    if (ON(3)) {
        pg8::Gemm g{ACT, WD, T_, D_, FF_}; pg8::StaticOrder S; S.init(T_, D_, G, (int)blockIdx.x);
        EpiResid E{p.x, p.out, ada + 2 * D_, 0.5f};
        pg8::gemm_phase<EpiResid, pg8::StaticOrder, true, true>(lds, g, S, E);
    } else {
        for (size_t i = (size_t)blockIdx.x * 512 + tid; i < (size_t)T_ * D_ / 4; i += (size_t)G * 512) ((f32x4*)p.out)[i] = ((const f32x4*)p.x)[i];
    }
    grid.sync();
    for (int rep = 0; rep < REPS(4); ++rep) { if (rep) grid.sync();
    if (ON(4)) {
        norm_rows(p.out, p.g_norm + D_, ada, 3, 4, H, gw, NGW, lane);
        LAS float* scr = (LAS float*)(lds + wave * 16384);
        conv_ffn(p, 1, WGU, WD, scr, gw, NGW, lane);
    }
    }
    grid.sync();
    for (int rep = 0; rep < REPS(5); ++rep) { if (rep) grid.sync();
    if (ON(5)) {
        pg8::Gemm g{H, WIN, T_, LDY, D_}; pg8::StaticOrder S; S.init(T_, LDY, G, (int)blockIdx.x);
        EpiY E{Y};
        pg8::gemm_phase<EpiY, pg8::StaticOrder, true, true>(lds, g, S, E);
    }
    }
    grid.sync();
    for (int rep = 0; rep < REPS(6); ++rep) { if (rep) grid.sync();
    if (ON(6)) {
        for (int unit = blockIdx.x; unit < 256; unit += G) compress_unit(unit, Y, p.cmp_pos, p.cmp_b1, p.g_qk, WC1, WC2, KC, VCT, lds, tid);
        __syncthreads();
        if (rep == 0) for (int tok = gw; tok < T_; tok += NGW) {
            bf16_t* row = Y + (size_t)tok * LDY;
            const int b = tok >> 11, sidx = tok & 2047, c16 = lane & 15, hsub = lane >> 4;
            const size_t fro = (size_t)((sidx >> 4) * 4 + (c16 >> 2)) * 512 + (c16 & 3) * 128 + (sidx & 15) * 8;
#pragma unroll 1
            for (int seg = 0; seg < 8; ++seg) {
                const int colbase = seg < 4 ? seg * 512 : (seg == 4 ? OFF_KV + 1024 : (seg == 5 ? OFF_KV + 2048 : OFF_KR + (seg - 6) * 512)), gi = seg < 4 ? 0 : (seg == 4 ? 2 : 3);
                const u32x4 w = *(const u32x4*)(row + colbase + lane * 8);
                u32x4 o = w;
                if (seg < 6) {
                    float f[8] = {bf_lo(w.x), bf_hi(w.x), bf_lo(w.y), bf_hi(w.y), bf_lo(w.z), bf_hi(w.z), bf_lo(w.w), bf_hi(w.w)};
                    float ss = 0.f;
#pragma unroll
                    for (int j = 0; j < 8; ++j) ss += f[j] * f[j];
                    ss += __shfl_xor(ss, 1); ss += __shfl_xor(ss, 2); ss += __shfl_xor(ss, 4); ss += __shfl_xor(ss, 8);
                    const float r = 1.0f / sqrtf(ss * (1.0f / 128.0f) + EPS_);
                    const float* gq = p.g_qk + gi * 128 + c16 * 8;
                    const f32x4 g0 = *(const f32x4*)gq, g1 = *(const f32x4*)(gq + 4);
                    o.x = cvt_pk_bf16(f[0] * r * g0[0], f[1] * r * g0[1]); o.y = cvt_pk_bf16(f[2] * r * g0[2], f[3] * r * g0[3]);
                    o.z = cvt_pk_bf16(f[4] * r * g1[0], f[5] * r * g1[1]); o.w = cvt_pk_bf16(f[6] * r * g1[2], f[7] * r * g1[3]);
                }
                bf16_t* dstp;
                if (seg < 4) dstp = row + colbase + lane * 8;
                else if (seg == 4) dstp = KS + (size_t)(b * 4 + hsub) * 262144 + fro;
                else if (seg == 5) dstp = KW + (size_t)(b * 4 + hsub) * 262144 + fro;
                else dstp = KR + (size_t)(b * 8 + (seg - 6) * 4 + hsub) * 262144 + fro;
                *(u32x4*)dstp = o;
            }
        }
        LAS bf16_t* tl = (LAS bf16_t*)(lds + wave * 16384);
        for (int it = gw; it < 48 * 128; it += NGW) {
            const int tt = it / 48, ct = it - tt * 48;
            int srccol, cc, HD; bf16_t* dst;
            if (ct < 8) { srccol = OFF_KV + 3 * 512 + ct * 64; cc = ct * 64; dst = VTS; HD = 128; }
            else if (ct < 16) { srccol = OFF_KV + 5 * 512 + (ct - 8) * 64; cc = (ct - 8) * 64; dst = VTW; HD = 128; }
            else { srccol = OFF_VR + (ct - 16) * 64; cc = (ct - 16) * 64; dst = VTR; HD = 256; }
            const int b = tt >> 5, s0 = (tt & 31) * 64;
            const int head = cc / HD, dt0 = (cc - head * HD) >> 4, NDTh = HD >> 4, nheads = (HD == 128) ? 4 : 8;
#pragma unroll
            for (int i = 0; i < 8; ++i) {
                const int tok = 8 * i + (lane >> 3), ch = lane & 7;
                const u32x4 w = *(const u32x4*)(Y + (size_t)(b * 2048 + s0 + tok) * LDY + srccol + ch * 8);
                LAS bf16_t* d = tl + (ch * 8) * 72 + tok;
                d[0 * 72] = (bf16_t)(w.x & 0xffffu); d[1 * 72] = (bf16_t)(w.x >> 16); d[2 * 72] = (bf16_t)(w.y & 0xffffu); d[3 * 72] = (bf16_t)(w.y >> 16);
                d[4 * 72] = (bf16_t)(w.z & 0xffffu); d[5 * 72] = (bf16_t)(w.z >> 16); d[6 * 72] = (bf16_t)(w.w & 0xffffu); d[7 * 72] = (bf16_t)(w.w >> 16);
            }
            asm volatile("s_waitcnt lgkmcnt(0)" ::: "memory");
            bf16_t* hb = dst + (size_t)(b * nheads + head) * (2048 * HD) + lane * 8;
#pragma unroll
            for (int i = 0; i < 8; ++i) {
                const int ks = i >> 2, dt = i & 3, col = 16 * dt + (lane & 15), fq4 = 4 * (lane >> 4);
                const u32x2 lo = *(const LAS u32x2*)(tl + col * 72 + 32 * ks + fq4), hi = *(const LAS u32x2*)(tl + col * 72 + 32 * ks + 16 + fq4);
                u32x4 w; w.x = lo.x; w.y = lo.y; w.z = hi.x; w.w = hi.y;
                *(u32x4*)(hb + (size_t)(((s0 >> 5) + ks) * NDTh + dt0 + dt) * 512) = w;
            }
            asm volatile("s_waitcnt lgkmcnt(0)" ::: "memory");
        }
    }
    }
    grid.sync();
    for (int rep = 0; rep < REPS(7); ++rep) { if (rep) grid.sync();
    if (ON(7)) {
        MixPtrs MP{Y, ONSA, ORET, VTS, VTW, VTR, KC, VCT, p.gn_gain, KS, KW, KR};
        LAS bf16x8* qs = (LAS bf16x8*)(lds + wave * 16384) + lane;
        const int x0 = blockIdx.x & 7;
#pragma unroll 1
        for (int qi = 0; qi < 8; ++qi) {
            const int x = (x0 + qi) & 7;
            unsigned* qc = ctl + 256 * rep + 16 * x;
            for (;;) {
                unsigned id = 0;
                if (lane == 0) id = atomicAdd(qc, 1u);
                id = (unsigned)__builtin_amdgcn_readfirstlane((int)id);
                if (id >= 1024u) break;
                const int tile = 127 - (int)(id >> 3), sub = (int)(id & 7u);
#ifndef NO_NSA
                if (sub < 4) { const int bg = x + 8 * (sub >> 1); nsa_unit(MP, bg >> 2, bg & 3, tile, sub & 1, lane, qs); }
#endif
#ifndef NO_RET
                if (sub >= 4) { const int bh = x + 8 * (sub - 4); ret_unit(MP, bh >> 3, bh & 7, tile, lane, qs); }
#endif
            }
        }
    }
    }
    grid.sync();
    for (int rep = 0; rep < REPS(8); ++rep) { if (rep) grid.sync();
    if (ON(8)) {
        { pg8::Gemm g{ONSA, WPN, T_, D_, D_}; pg8::StaticOrder S; S.init(T_, D_, G, (int)blockIdx.x);
          EpiMerge<false> E{MG, Y, OFF_GA};
          pg8::gemm_phase<EpiMerge<false>, pg8::StaticOrder, true, true>(lds, g, S, E); }
        __syncthreads();
        { pg8::Gemm g{ORET, WPR, T_, D_, D_}; pg8::StaticOrder S; S.init(T_, D_, G, (int)blockIdx.x);
          EpiMerge<true> E{MG, Y, OFF_GB};
          pg8::gemm_phase<EpiMerge<true>, pg8::StaticOrder, true, true>(lds, g, S, E); }
    }
    }
    grid.sync();
    if (ON(9)) {
        pg8::Gemm g{MG, WO, T_, D_, D_}; pg8::StaticOrder S; S.init(T_, D_, G, (int)blockIdx.x);
        EpiResid E{p.out, p.out, ada + 5 * D_, 1.0f};
        pg8::gemm_phase<EpiResid, pg8::StaticOrder, true, true>(lds, g, S, E);
    }
    grid.sync();
    for (int rep = 0; rep < REPS(10); ++rep) { if (rep) grid.sync();
    if (ON(10)) norm_rows(p.out, p.g_norm + 2 * D_, ada, 6, 7, H, gw, NGW, lane);
    }
    grid.sync();
    for (int rep = 0; rep < REPS(11); ++rep) { if (rep) grid.sync();
    if (ON(11)) {
        pg8::Gemm g{H, WGU, T_, 2 * FF_, D_}; pg8::StaticOrder S; S.init(T_, 2 * FF_, G, (int)blockIdx.x);
        EpiSwiglu E{ACT};
        pg8::gemm_phase<EpiSwiglu, pg8::StaticOrder, true, true>(lds, g, S, E);
    }
    }
    grid.sync();
    if (ON(12)) {
        pg8::Gemm g{ACT, WD, T_, D_, FF_}; pg8::StaticOrder S; S.init(T_, D_, G, (int)blockIdx.x);
        EpiResid E{p.out, p.out, ada + 8 * D_, 0.5f};
        pg8::gemm_phase<EpiResid, pg8::StaticOrder, true, true>(lds, g, S, E);
    }
#undef ON
#undef ctl
#undef ada
#undef WGU
#undef WD
#undef WIN
#undef WPN
#undef WPR
#undef WO
#undef WC1
#undef WC2
#undef H
#undef ONSA
#undef Y
#undef ACT
#undef MG
#undef ORET
#undef VTS
#undef VTW
#undef VTR
#undef KC
#undef VCT
#undef KS
#undef KW
#undef KR
}

#ifndef PHASE_MASK
#define PHASE_MASK 0x1fff
#endif
extern "C" void kernel_launch(void* const* d_in, const int* in_sizes, int n_in, void* d_out, int out_size, void* d_ws, size_t ws_size, hipStream_t stream) {
    static int grid_blocks = 0;
    if (grid_blocks == 0) {
        if (n_in != 18 || ws_size < WS_END) { fprintf(stderr, "kernel_launch: unexpected n_in %d or workspace %zu < %zu\n", n_in, ws_size, (size_t)WS_END); grid_blocks = -1; return; }
        int dev = 0, cus = 0, per_cu = 0;
        hipGetDevice(&dev);
        hipDeviceGetAttribute(&cus, hipDeviceAttributeMultiprocessorCount, dev);
        if (hipFuncSetAttribute((const void*)fwd_kernel, hipFuncAttributeMaxDynamicSharedMemorySize, LDS_BYTES) != hipSuccess) { fprintf(stderr, "kernel_launch: hipFuncSetAttribute failed\n"); grid_blocks = -1; return; }
        if (hipOccupancyMaxActiveBlocksPerMultiprocessor(&per_cu, (const void*)fwd_kernel, 512, LDS_BYTES) != hipSuccess || per_cu < 1) { fprintf(stderr, "kernel_launch: occupancy query gave %d\n", per_cu); per_cu = 1; }
        (void)hipGetLastError();
        grid_blocks = cus * 1;
    }
    if (grid_blocks < 0) return;
    (void)hipMemsetAsync((char*)d_ws + WS_CTL, 0, 4096, stream);
    Params p{};
    p.x = (const float*)d_in[0]; p.c = (const float*)d_in[1]; p.w_ada = (const float*)d_in[2]; p.b_ada = (const float*)d_in[3]; p.g_norm = (const float*)d_in[4];
    p.w_gate = (const float*)d_in[5]; p.w_up = (const float*)d_in[6]; p.w_down = (const float*)d_in[7]; p.w_in = (const float*)d_in[8]; p.g_qk = (const float*)d_in[9];
    p.cmp_pos = (const float*)d_in[10]; p.cmp_w1 = (const float*)d_in[11]; p.cmp_b1 = (const float*)d_in[12]; p.cmp_w2 = (const float*)d_in[13]; p.gn_gain = (const float*)d_in[14];
    p.w_pn = (const float*)d_in[15]; p.w_pr = (const float*)d_in[16]; p.w_out = (const float*)d_in[17];
    p.out = (float*)d_out; p.ws = (unsigned char*)d_ws; p.mask = PHASE_MASK; p.pad = 0;
    void* args[] = {&p};
    hipError_t e = hipLaunchCooperativeKernel((const void*)fwd_kernel, dim3(grid_blocks), dim3(512), args, LDS_BYTES, stream);
    if (e != hipSuccess) fprintf(stderr, "kernel_launch: cooperative launch failed: %s (grid %d)\n", hipGetErrorString(e), grid_blocks);
}
```

```cpp
#include <hip/hip_runtime.h>
#include <hip/hip_cooperative_groups.h>
#include <cstdio>
#include <cstdint>
namespace cg = cooperative_groups;
namespace pg8 {
#define PG8_LAS __attribute__((address_space(3)))
typedef unsigned short bf16_t;
typedef short bf16x8 __attribute__((ext_vector_type(8)));
typedef float f32x4 __attribute__((ext_vector_type(4)));
typedef unsigned u32x4 __attribute__((ext_vector_type(4)));
constexpr int BM = 256, BK = 64, HALF = 128, HTB = HALF * BK * 2  , STAGE_BYTES = 8 * HTB, NXCD = 8, WGM = 8;

__host__ __device__ __forceinline__ int lds_byte(int r, int c) { const int st = (r >> 4) * 2 + (c >> 5), rr = r & 15, cc = c & 31, ob = rr * 64 + cc * 2; return st * 1024 + (ob ^ (((ob >> 9) & 1) << 5)); }
__host__ __device__ __forceinline__ void stage_rc(int b, int& R, int& C) { const int st = b / 1024, sb = b % 1024, swz = sb ^ (((sb >> 9) & 1) << 5); R = (st >> 1) * 16 + swz / 64; C = (st & 1) * 32 + (swz % 64) / 2; }
__host__ __device__ __forceinline__ int perm32(int rho) { const int n = rho >> 4, i = rho & 15; return 8 * (i >> 2) + 4 * n + (i & 3); }

struct Unit { int pm, pn; };
struct Gemm { const bf16_t* A; const bf16_t* Bt; int M, N, K; };

struct StaticOrder {
    int nM, nN, nwg, G, c;
    __host__ __device__ void init(int M, int N, int G_, int c_) { nM = M / BM; nN = N / BM; nwg = nM * nN; G = G_; c = c_; }
    __host__ __device__ bool next(int i, Unit& u) const {
        const long L = (long)i * G + c; if (L >= nwg) return false;
        int wgid = (int)L; { const int q = nwg / NXCD, r = nwg % NXCD, xcd = wgid % NXCD, off = wgid / NXCD; wgid = (xcd < r ? xcd * (q + 1) : r * (q + 1) + (xcd - r) * q) + off; }
        const int nig = WGM * nN, gid = wgid / nig, fm = gid * WGM, gsz = (nM - fm) < WGM ? (nM - fm) : WGM;
        u.pm = fm + ((wgid % nig) % gsz); u.pn = (wgid % nig) / gsz; return true;
    }
    __device__ __forceinline__ void a_ready(const Unit&) const {}
    __device__ __forceinline__ void done(const Unit&) const {}
};

__device__ __forceinline__ unsigned cvt_pk_bf16(float lo, float hi) { unsigned r; asm volatile("v_cvt_pk_bf16_f32 %0, %1, %2" : "=v"(r) : "v"(lo), "v"(hi)); return r; }
typedef float f32x2 __attribute__((ext_vector_type(2)));
template <class Epi, class Sched, bool ALIGN_EPI = false, bool SP2 = false>
__device__ __forceinline__ void gemm_phase(PG8_LAS unsigned char* lds, const Gemm g, const Sched& S, const Epi& E) {
    int tid_o = threadIdx.x; asm volatile("" : "+v"(tid_o));
    const int tid = tid_o, wid = __builtin_amdgcn_readfirstlane(tid >> 6), lane = tid & 63, wr = wid >> 2, wc = wid & 3, fr = lane & 15, fq = lane >> 4;
    const int K = g.K, nt = K / BK;
    unsigned voffA[2], voffB[2];
#pragma unroll
    for (int i = 0; i < 2; ++i) { int R, C; stage_rc(tid * 16 + i * 8192, R, C); const int Rb = Epi::PERM ? ((R & ~31) + perm32(R & 31)) : R;
        voffA[i] = (unsigned)(R * K + C) * 2u; voffB[i] = (unsigned)(Rb * K + C) * 2u; }
    const size_t kstep = (size_t)(BK * 2);
    const size_t hstep = (size_t)HALF * K * 2;
    const size_t tstep = 2 * hstep;
    const unsigned ldsw = (unsigned)wid * 1024u;
    const int aoff = lds_byte(wr * 64 + fr, fq * 8), boff = lds_byte(wc * 32 + fr, fq * 8);
#define PG8_SA(b, h) (((b) * 2 + (h)) * HTB)
#define PG8_SB(b, h) ((4 + (b) * 2 + (h)) * HTB)
#define PG8_STAGE(bufoff, gbase, voff) do { _Pragma("unroll") for (int _i = 0; _i < 2; ++_i) \
        __builtin_amdgcn_global_load_lds((const unsigned*)((const char*)(gbase) + (voff)[_i]), (PG8_LAS unsigned*)(lds + (bufoff) + ldsw + _i * 8192), 16, 0, 0); } while (0)
#define PG8_LDA(dst, b, h) do { _Pragma("unroll") for (int m = 0; m < 4; ++m) _Pragma("unroll") for (int k = 0; k < 2; ++k) dst[m][k] = *(const PG8_LAS bf16x8*)(lds + PG8_SA(b, h) + aoff + m * 2048 + k * 1024); } while (0)
#define PG8_LDB(dst, b, h) do { _Pragma("unroll") for (int n = 0; n < 2; ++n) _Pragma("unroll") for (int k = 0; k < 2; ++k) dst[n][k] = *(const PG8_LAS bf16x8*)(lds + PG8_SB(b, h) + boff + n * 2048 + k * 1024); } while (0)
#define PG8_MMA(ai, bj, At, Bt) do { __builtin_amdgcn_s_setprio(1); _Pragma("unroll") for (int m = 0; m < 4; ++m) _Pragma("unroll") for (int n = 0; n < 2; ++n) _Pragma("unroll") for (int k = 0; k < 2; ++k) \
        acc[ai][bj][m][n] = __builtin_amdgcn_mfma_f32_16x16x32_bf16(Bt[n][k], At[m][k], acc[ai][bj][m][n], 0, 0, 0); __builtin_amdgcn_s_setprio(0); } while (0)
#define PG8_WAIT_V(n) asm volatile("s_waitcnt vmcnt(" #n ")" ::: "memory")
#define PG8_WAIT_L(n) asm volatile("s_waitcnt lgkmcnt(" #n ")" ::: "memory")
#define PG8_BAR __builtin_amdgcn_s_barrier()
#define PG8_SCHED __builtin_amdgcn_sched_barrier(0)
    Unit cur, nxt; int ui = 0;
    if (!S.next(0, cur)) return;
    f32x4 acc[2][2][4][2];
#pragma unroll
    for (int a = 0; a < 2; ++a)
#pragma unroll
        for (int b = 0; b < 2; ++b)
#pragma unroll
            for (int m = 0; m < 4; ++m)
#pragma unroll
                for (int n = 0; n < 2; ++n) acc[a][b][m][n] = (f32x4){0.f, 0.f, 0.f, 0.f};
    bf16x8 At[4][2], B0[2][2], B1[2][2];
    const char* cA = (const char*)g.A + (size_t)cur.pm * tstep; const char* cB = (const char*)g.Bt + (size_t)cur.pn * tstep;
    S.a_ready(cur);
    if constexpr (SP2) {
        PG8_STAGE(PG8_SB(0, 0), cB, voffB); PG8_STAGE(PG8_SB(0, 1), cB + hstep, voffB); PG8_STAGE(PG8_SA(0, 0), cA, voffA); PG8_STAGE(PG8_SA(0, 1), cA + hstep, voffA);
        if (wr == 1) PG8_BAR;
        PG8_WAIT_V(2); PG8_BAR;
        PG8_STAGE(PG8_SB(1, 0), cB + kstep, voffB); PG8_STAGE(PG8_SA(1, 0), cA + kstep, voffA); PG8_STAGE(PG8_SB(1, 1), cB + hstep + kstep, voffB);
        PG8_WAIT_V(6); PG8_BAR;
    } else {
        PG8_STAGE(PG8_SB(0, 0), cB, voffB); PG8_STAGE(PG8_SA(0, 0), cA, voffA); PG8_STAGE(PG8_SB(0, 1), cB + hstep, voffB); PG8_STAGE(PG8_SA(0, 1), cA + hstep, voffA);
        if (wr == 1) PG8_BAR;
        PG8_WAIT_V(4); PG8_BAR;
        PG8_STAGE(PG8_SB(1, 0), cB + kstep, voffB); PG8_STAGE(PG8_SA(1, 0), cA + kstep, voffA); PG8_STAGE(PG8_SB(1, 1), cB + hstep + kstep, voffB);
        PG8_WAIT_V(6); PG8_BAR;
    }
    for (;;) {
        const bool has_next = S.next(ui + 1, nxt);
        const char* nA = has_next ? (const char*)g.A + (size_t)nxt.pm * tstep : cA; const char* nB = has_next ? (const char*)g.Bt + (size_t)nxt.pn * tstep : cB;
        for (int t = 0; t < nt; t += 2) {
            const bool last = (t == nt - 2);
            const char* a1 = cA + (size_t)(t + 1) * kstep;
            const char* a2 = last ? nA : cA + (size_t)(t + 2) * kstep; const char* b2 = last ? nB : cB + (size_t)(t + 2) * kstep;
            const char* a3 = a2 + kstep; const char* b3 = b2 + kstep;
            if (last && has_next) S.a_ready(nxt);
            if constexpr (SP2) {
            PG8_LDB(B0, 0, 0); PG8_LDB(B1, 0, 1); PG8_SCHED; PG8_LDA(At, 0, 0); PG8_STAGE(PG8_SA(1, 1), a1 + hstep, voffA);
            PG8_WAIT_V(8); PG8_WAIT_L(0); PG8_BAR; PG8_MMA(0, 0, At, B0); PG8_MMA(0, 1, At, B1); PG8_BAR; PG8_SCHED;
            PG8_LDA(At, 0, 1); PG8_STAGE(PG8_SB(0, 0), b2, voffB); PG8_STAGE(PG8_SB(0, 1), b2 + hstep, voffB); PG8_STAGE(PG8_SA(0, 0), a2, voffA);
            PG8_WAIT_V(8); PG8_WAIT_L(0); PG8_BAR; PG8_MMA(1, 0, At, B0); PG8_MMA(1, 1, At, B1); PG8_BAR; PG8_SCHED;
            PG8_LDB(B0, 1, 0); PG8_LDB(B1, 1, 1); PG8_SCHED; PG8_LDA(At, 1, 0); PG8_STAGE(PG8_SA(0, 1), a2 + hstep, voffA);
            PG8_WAIT_V(8); PG8_WAIT_L(0); PG8_BAR; PG8_MMA(0, 0, At, B0); PG8_MMA(0, 1, At, B1); PG8_BAR; PG8_SCHED;
            PG8_LDA(At, 1, 1); PG8_STAGE(PG8_SB(1, 0), b3, voffB); PG8_STAGE(PG8_SB(1, 1), b3 + hstep, voffB); PG8_STAGE(PG8_SA(1, 0), a3, voffA);
            PG8_WAIT_V(8); PG8_WAIT_L(0); PG8_BAR; PG8_MMA(1, 0, At, B0); PG8_MMA(1, 1, At, B1); PG8_BAR; PG8_SCHED;
            } else {
            PG8_LDB(B0, 0, 0); PG8_SCHED; PG8_LDA(At, 0, 0); PG8_STAGE(PG8_SA(1, 1), a1 + hstep, voffA);
            PG8_WAIT_L(8); PG8_BAR; PG8_WAIT_L(0); PG8_MMA(0, 0, At, B0); PG8_BAR; PG8_SCHED;
            PG8_LDB(B1, 0, 1); PG8_STAGE(PG8_SB(0, 0), b2, voffB);
            PG8_BAR; PG8_WAIT_L(0); PG8_MMA(0, 1, At, B1); PG8_BAR;
            PG8_LDA(At, 0, 1); PG8_STAGE(PG8_SA(0, 0), a2, voffA);
            PG8_BAR; PG8_WAIT_L(0); PG8_MMA(1, 0, At, B0); PG8_BAR; PG8_SCHED;
            PG8_STAGE(PG8_SB(0, 1), b2 + hstep, voffB);
            PG8_WAIT_V(6); PG8_BAR; PG8_MMA(1, 1, At, B1); PG8_BAR;
            PG8_LDB(B0, 1, 0); PG8_SCHED; PG8_LDA(At, 1, 0); PG8_STAGE(PG8_SA(0, 1), a2 + hstep, voffA);
            PG8_WAIT_L(8); PG8_BAR; PG8_WAIT_L(0); PG8_MMA(0, 0, At, B0); PG8_BAR; PG8_SCHED;
            PG8_LDB(B1, 1, 1); PG8_STAGE(PG8_SB(1, 0), b3, voffB);
            PG8_BAR; PG8_WAIT_L(0); PG8_MMA(0, 1, At, B1); PG8_BAR;
            PG8_LDA(At, 1, 1); PG8_STAGE(PG8_SA(1, 0), a3, voffA);
            PG8_BAR; PG8_WAIT_L(0); PG8_MMA(1, 0, At, B0); PG8_BAR; PG8_SCHED;
            PG8_STAGE(PG8_SB(1, 1), b3 + hstep, voffB);
            PG8_WAIT_V(6); PG8_BAR; PG8_MMA(1, 1, At, B1); PG8_BAR;
            }
        }
        if constexpr (ALIGN_EPI) { if (wr == 0) PG8_BAR; }
        if constexpr (!Epi::AFTER_DRAIN) { E(acc, cur, wr, wc, fr, fq); S.done(cur); }
        if (!has_next) break;
#pragma unroll
        for (int a = 0; a < 2; ++a)
#pragma unroll
            for (int b = 0; b < 2; ++b)
#pragma unroll
                for (int m = 0; m < 4; ++m)
#pragma unroll
                    for (int n = 0; n < 2; ++n) acc[a][b][m][n] = (f32x4){0.f, 0.f, 0.f, 0.f};
        cur = nxt; cA = nA; cB = nB; ++ui;
        if constexpr (ALIGN_EPI) { if (wr == 1) PG8_BAR; }
    }
    PG8_WAIT_V(0);
    if constexpr (!ALIGN_EPI) { if (wr == 0) PG8_BAR; }
    PG8_BAR;
    if constexpr (Epi::AFTER_DRAIN) { E.fused(acc, cur, wr, wc, fr, fq, lds, wid, lane); S.done(cur); }
#undef PG8_SA
#undef PG8_SB
#undef PG8_STAGE
#undef PG8_LDA
#undef PG8_LDB
#undef PG8_MMA
#undef PG8_WAIT_V
#undef PG8_WAIT_L
#undef PG8_BAR
#undef PG8_SCHED
}
}

#define LAS __attribute__((address_space(3)))
typedef unsigned short bf16_t;
typedef short bf16x8 __attribute__((ext_vector_type(8)));
typedef short s16x4 __attribute__((ext_vector_type(4)));
typedef float f32x4 __attribute__((ext_vector_type(4)));
typedef unsigned u32x4 __attribute__((ext_vector_type(4)));
typedef unsigned u32x2 __attribute__((ext_vector_type(2)));

constexpr int T_ = 8192, D_ = 2048, FF_ = 5632, NIN_ = 15408, LDY = 15616, NADA = 18432;
constexpr int OFF_Q = 0, OFF_KV = 2048, OFF_QR = 5120, OFF_KR = 6144, OFF_VR = 7168, OFF_GR = 9216, OFF_GA = 11264, OFF_GB = 13312, OFF_GL = 15360;
constexpr float LOG2E = 1.4426950408889634f;
constexpr float EPS_ = 1e-6f;

constexpr size_t al256(size_t x) { return (x + 255) & ~(size_t)255; }
constexpr size_t WS_CTL = 0;
constexpr size_t WS_ADA = 4096;
constexpr size_t WS_WGU = al256(WS_ADA + (size_t)4 * NADA * 4);
constexpr size_t WS_WD  = WS_WGU + (size_t)2 * FF_ * D_ * 2;
constexpr size_t WS_WIN = WS_WD + (size_t)D_ * FF_ * 2;
constexpr size_t WS_WPN = WS_WIN + (size_t)LDY * D_ * 2;
constexpr size_t WS_WPR = WS_WPN + (size_t)D_ * D_ * 2;
constexpr size_t WS_WO  = WS_WPR + (size_t)D_ * D_ * 2;
constexpr size_t WS_WC1 = WS_WO + (size_t)D_ * D_ * 2;
constexpr size_t WS_WC2 = WS_WC1 + (size_t)2 * 128 * 4096 * 2;
constexpr size_t WS_H   = WS_WC2 + (size_t)2 * 128 * 128 * 2;
constexpr size_t WS_Y   = WS_H + (size_t)T_ * D_ * 2;
constexpr size_t WS_MG  = WS_Y + (size_t)T_ * LDY * 2;
constexpr size_t WS_ORET = WS_MG + (size_t)T_ * D_ * 2;
constexpr size_t WS_VTS = WS_ORET + (size_t)T_ * D_ * 2;
constexpr size_t WS_VTW = WS_VTS + (size_t)16 * 128 * 2048 * 2;
constexpr size_t WS_VTR = WS_VTW + (size_t)16 * 128 * 2048 * 2;
constexpr size_t WS_KC  = WS_VTR + (size_t)32 * 256 * 2048 * 2;
constexpr size_t WS_VCT = WS_KC + (size_t)16 * 128 * 128 * 2;
constexpr size_t WS_KS  = WS_VCT + (size_t)16 * 128 * 128 * 2;
constexpr size_t WS_KW  = WS_KS + (size_t)16 * 2048 * 128 * 2;
constexpr size_t WS_KR  = WS_KW + (size_t)16 * 2048 * 128 * 2;
constexpr size_t WS_END = WS_KR + (size_t)32 * 2048 * 128 * 2;

constexpr int LDS_BYTES = 131072 + 2048;

using pg8::cvt_pk_bf16;
__device__ __forceinline__ float bf_lo(unsigned w) { return __uint_as_float(w << 16); }
__device__ __forceinline__ float bf_hi(unsigned w) { return __uint_as_float(w & 0xffff0000u); }
__device__ __forceinline__ float bf2f(bf16_t h) { return __uint_as_float((unsigned)h << 16); }
__device__ __forceinline__ float ex2(float x) { return __builtin_amdgcn_exp2f(x); }
__device__ __forceinline__ float sigmoid_f(float x) { return __builtin_amdgcn_rcpf(1.0f + ex2(-x * LOG2E)); }
__device__ __forceinline__ float silu_f(float x) { return x * sigmoid_f(x); }
__device__ __forceinline__ float wave_sum(float v) {
#pragma unroll
    for (int o = 1; o < 64; o <<= 1) v += __shfl_xor(v, o);
    return v;
}
#define MFMA16(a, b, c) __builtin_amdgcn_mfma_f32_16x16x32_bf16((a), (b), (c), 0, 0, 0)

struct EpiSwiglu {
    static constexpr bool PERM = true, AFTER_DRAIN = false;
    bf16_t* O;
    __device__ __forceinline__ void operator()(const f32x4 (&acc)[2][2][4][2], const pg8::Unit& u, int wr, int wc, int fr, int fq) const {
        const int row0 = u.pm * 256 + wr * 64 + fr, col0 = u.pn * 128 + wc * 32 + 8 * fq;
#pragma unroll
        for (int ai = 0; ai < 2; ++ai)
#pragma unroll
            for (int m = 0; m < 4; ++m) {
                bf16_t* rowp = O + (size_t)(row0 + ai * 128 + m * 16) * FF_ + col0;
                const f32x4 g0 = acc[ai][0][m][0], g1 = acc[ai][0][m][1], u0 = acc[ai][1][m][0], u1 = acc[ai][1][m][1];
                u32x4 w;
                w.x = cvt_pk_bf16(silu_f(g0[0]) * u0[0], silu_f(g0[1]) * u0[1]);
                w.y = cvt_pk_bf16(silu_f(g0[2]) * u0[2], silu_f(g0[3]) * u0[3]);
                w.z = cvt_pk_bf16(silu_f(g1[0]) * u1[0], silu_f(g1[1]) * u1[1]);
                w.w = cvt_pk_bf16(silu_f(g1[2]) * u1[2], silu_f(g1[3]) * u1[3]);
                *(u32x4*)rowp = w;
            }
    }
};
struct EpiResid {
    static constexpr bool PERM = false, AFTER_DRAIN = false;
    const float* base; float* out; const float* gate; float coef;
    __device__ __forceinline__ void operator()(const f32x4 (&acc)[2][2][4][2], const pg8::Unit& u, int wr, int wc, int fr, int fq) const {
        const int row0 = u.pm * 256 + wr * 64 + fr, col0 = u.pn * 256 + wc * 32 + 4 * fq, b = u.pm >> 3;
        f32x4 gv[2][2];
#pragma unroll
        for (int bj = 0; bj < 2; ++bj)
#pragma unroll
            for (int n = 0; n < 2; ++n) gv[bj][n] = *(const f32x4*)(gate + (size_t)b * NADA + col0 + bj * 128 + n * 16) * coef;
#pragma unroll
        for (int ai = 0; ai < 2; ++ai)
#pragma unroll
            for (int m = 0; m < 4; ++m) {
                const size_t off = (size_t)(row0 + ai * 128 + m * 16) * D_ + col0;
#pragma unroll
                for (int bj = 0; bj < 2; ++bj)
#pragma unroll
                    for (int n = 0; n < 2; ++n) {
                        const size_t o = off + bj * 128 + n * 16;
                        *(f32x4*)(out + o) = *(const f32x4*)(base + o) + gv[bj][n] * acc[ai][bj][m][n];
                    }
            }
    }
};
struct EpiY {
    static constexpr bool PERM = true, AFTER_DRAIN = false;
    bf16_t* O;
    __device__ __forceinline__ void operator()(const f32x4 (&acc)[2][2][4][2], const pg8::Unit& u, int wr, int wc, int fr, int fq) const {
        const int row0 = u.pm * 256 + wr * 64 + fr, col0 = u.pn * 256 + wc * 32 + 8 * fq;
#pragma unroll
        for (int ai = 0; ai < 2; ++ai)
#pragma unroll
            for (int m = 0; m < 4; ++m) {
                bf16_t* rowp = O + (size_t)(row0 + ai * 128 + m * 16) * LDY + col0;
#pragma unroll
                for (int bj = 0; bj < 2; ++bj) {
                    const f32x4 v0 = acc[ai][bj][m][0], v1 = acc[ai][bj][m][1];
                    u32x4 w; w.x = cvt_pk_bf16(v0[0], v0[1]); w.y = cvt_pk_bf16(v0[2], v0[3]); w.z = cvt_pk_bf16(v1[0], v1[1]); w.w = cvt_pk_bf16(v1[2], v1[3]);
                    *(u32x4*)(rowp + bj * 128) = w;
                }
            }
    }
};
template <bool ADD> struct EpiMerge {
    static constexpr bool PERM = true, AFTER_DRAIN = false;
    bf16_t* O; const bf16_t* Yg; int goff;
    __device__ __forceinline__ void operator()(const f32x4 (&acc)[2][2][4][2], const pg8::Unit& u, int wr, int wc, int fr, int fq) const {
        const int row0 = u.pm * 256 + wr * 64 + fr, col0 = u.pn * 256 + wc * 32 + 8 * fq;
#pragma unroll
        for (int ai = 0; ai < 2; ++ai)
#pragma unroll
            for (int m = 0; m < 4; ++m) {
                const int row = row0 + ai * 128 + m * 16;
#pragma unroll
                for (int bj = 0; bj < 2; ++bj) {
                    const int col = col0 + bj * 128;
                    const u32x4 gw = *(const u32x4*)(Yg + (size_t)row * LDY + goff + col);
                    const f32x4 v0 = acc[ai][bj][m][0], v1 = acc[ai][bj][m][1];
                    float r[8];
                    r[0] = sigmoid_f(bf_lo(gw.x)) * v0[0]; r[1] = sigmoid_f(bf_hi(gw.x)) * v0[1];
                    r[2] = sigmoid_f(bf_lo(gw.y)) * v0[2]; r[3] = sigmoid_f(bf_hi(gw.y)) * v0[3];
                    r[4] = sigmoid_f(bf_lo(gw.z)) * v1[0]; r[5] = sigmoid_f(bf_hi(gw.z)) * v1[1];
                    r[6] = sigmoid_f(bf_lo(gw.w)) * v1[2]; r[7] = sigmoid_f(bf_hi(gw.w)) * v1[3];
                    bf16_t* op = O + (size_t)row * D_ + col;
                    if (ADD) {
                        const u32x4 pw = *(const u32x4*)op;
                        r[0] += bf_lo(pw.x); r[1] += bf_hi(pw.x); r[2] += bf_lo(pw.y); r[3] += bf_hi(pw.y);
                        r[4] += bf_lo(pw.z); r[5] += bf_hi(pw.z); r[6] += bf_lo(pw.w); r[7] += bf_hi(pw.w);
                    }
                    u32x4 w; w.x = cvt_pk_bf16(r[0], r[1]); w.y = cvt_pk_bf16(r[2], r[3]); w.z = cvt_pk_bf16(r[4], r[5]); w.w = cvt_pk_bf16(r[6], r[7]);
                    *(u32x4*)op = w;
                }
            }
    }
};

__device__ __forceinline__ int rowmap(int mode, int n) {
    if (mode == 0) return n;
    if (mode == 1) return ((n >> 7) << 8) + (n & 127);
    if (mode == 2) return ((n >> 7) << 8) + 128 + (n & 127);
    return n < 5120 ? n : (n < 5168 ? OFF_GL + (n - 5120) : n - 48);
}
__device__ __forceinline__ void norm_rows(const float* __restrict__ X, const float* __restrict__ g, const float* __restrict__ ada, int ish, int isc, bf16_t* __restrict__ H, int gw, int NGW, int lane) {
    for (int m = gw; m < T_; m += NGW) {
        const int b = m >> 11;
        const f32x4* xr = (const f32x4*)(X + (size_t)m * D_) + lane;
        f32x4 v[8]; float ss = 0.f;
#pragma unroll
        for (int j = 0; j < 8; ++j) { v[j] = xr[64 * j]; ss += (v[j].x * v[j].x + v[j].y * v[j].y) + (v[j].z * v[j].z + v[j].w * v[j].w); }
        const float r = 1.0f / sqrtf(wave_sum(ss) * (1.0f / D_) + EPS_);
        const f32x4* gp = (const f32x4*)g + lane;
        const f32x4* sh = (const f32x4*)(ada + (size_t)b * NADA + ish * D_) + lane;
        const f32x4* sc = (const f32x4*)(ada + (size_t)b * NADA + isc * D_) + lane;
        u32x2* o = (u32x2*)(H + (size_t)m * D_) + lane;
#pragma unroll
        for (int j = 0; j < 8; ++j) {
            const f32x4 y = v[j] * r * gp[64 * j] * (sc[64 * j] + 1.0f) + sh[64 * j];
            u32x2 w; w.x = cvt_pk_bf16(y.x, y.y); w.y = cvt_pk_bf16(y.z, y.w); o[64 * j] = w;
        }
    }
}

#ifndef VPRE
#define VPRE 4
#endif
template <int NR, int NDT, int MODE>
__device__ __forceinline__ void att_step(const bf16_t* __restrict__ Kf, const bf16_t* __restrict__ Vf, int k0, int tq  , int lane8  ,
                                         const LAS bf16x8* qs, f32x4 (&O)[NR][NDT], float (&m)[NR], float (&l)[NR], const float (&coef)[NR], bool vblk) {
    constexpr float SC = 0.08838834764831845f;
    const bf16_t* kb = Kf + (size_t)(k0 >> 4) * 2048 + lane8;
    const bf16_t* vb = Vf + (size_t)(k0 >> 5) * (NDT * 512) + lane8;
    const int dq = tq - k0;
    constexpr int PRE = (NR == 1) ? NDT : VPRE;
    bf16x8 vfr[PRE];
#pragma unroll
    for (int dt = 0; dt < PRE; ++dt) vfr[dt] = *(const bf16x8*)(vb + dt * 512);
    f32x4 sa[NR][2];
#pragma unroll
    for (int kt = 0; kt < 2; ++kt) {
        bf16x8 kf[4];
#pragma unroll
        for (int dc = 0; dc < 4; ++dc) kf[dc] = *(const bf16x8*)(kb + kt * 2048 + dc * 512);
#pragma unroll
        for (int r = 0; r < NR; ++r) { sa[r][kt] = (f32x4){0.f, 0.f, 0.f, 0.f};
#pragma unroll
            for (int dc = 0; dc < 4; ++dc) sa[r][kt] = MFMA16(kf[dc], qs[(r * 4 + dc) * 64], sa[r][kt]); }
        __builtin_amdgcn_sched_barrier(0);
    }
    bf16x8 Pb[NR];
    const float dqf = (float)dq;
#pragma unroll
    for (int r = 0; r < NR; ++r) {
        f32x4 s[2]; s[0] = sa[r][0]; s[1] = sa[r][1];
        float p[2][4];
        if (MODE == 2) {
#pragma unroll
            for (int kt = 0; kt < 2; ++kt)
#pragma unroll
                for (int j = 0; j < 4; ++j) { const bool valid = dq >= (16 * kt + j); p[kt][j] = valid ? s[kt][j] * SC * ex2(coef[r] * (dqf - (float)(16 * kt + j))) : 0.f; }
        } else {
            float mx = -INFINITY;
#pragma unroll
            for (int kt = 0; kt < 2; ++kt)
#pragma unroll
                for (int j = 0; j < 4; ++j) {
                    const bool valid = (MODE == 0) ? (vblk && dq >= (16 * kt + j)) : (dq >= (16 * kt + j) && dq < 512 + (16 * kt + j));
                    const float v = valid ? s[kt][j] * (SC * LOG2E) - coef[r] * (dqf - (float)(16 * kt + j)) : -INFINITY;
                    p[kt][j] = v; mx = fmaxf(mx, v);
                }
            mx = fmaxf(mx, __shfl_xor(mx, 16)); mx = fmaxf(mx, __shfl_xor(mx, 32));
            const float mnew = fmaxf(m[r], mx), muse = (mnew == -INFINITY) ? 0.f : mnew;
            const float alpha = ex2(m[r] - muse);
            float ps = 0.f;
#pragma unroll
            for (int kt = 0; kt < 2; ++kt)
#pragma unroll
                for (int j = 0; j < 4; ++j) { p[kt][j] = ex2(p[kt][j] - muse); ps += p[kt][j]; }
            l[r] = l[r] * alpha + ps; m[r] = mnew;
#pragma unroll
            for (int dt = 0; dt < NDT; ++dt) O[r][dt] *= alpha;
        }
        u32x4 pw; pw.x = cvt_pk_bf16(p[0][0], p[0][1]); pw.y = cvt_pk_bf16(p[0][2], p[0][3]); pw.z = cvt_pk_bf16(p[1][0], p[1][1]); pw.w = cvt_pk_bf16(p[1][2], p[1][3]);
        Pb[r] = __builtin_bit_cast(bf16x8, pw);
    }
#pragma unroll
    for (int dt = 0; dt < NDT; ++dt) {
        bf16x8 vf;
        if (dt < PRE) vf = vfr[dt]; else vf = *(const bf16x8*)(vb + dt * 512);
#pragma unroll
        for (int r = 0; r < NR; ++r) O[r][dt] = MFMA16(vf, Pb[r], O[r][dt]);
        if ((dt & 3) == 3) __builtin_amdgcn_sched_barrier(0);
    }
}

struct MixPtrs { const bf16_t* Y; bf16_t* ONSA; bf16_t* ORET; const bf16_t* VTS; const bf16_t* VTW; const bf16_t* VTR; const bf16_t* KC; const bf16_t* VCT; const float* gn; const bf16_t* KS; const bf16_t* KW; const bf16_t* KR; };

__device__ __forceinline__ void nsa_unit(const MixPtrs& P, int b, int g, int tile, int hp  , int lane, LAS bf16x8* qs  ) {
    const int l15 = lane & 15, fq = lane >> 4, t0 = tile * 16, t = t0 + l15, bg = b * 4 + g;
    const bf16_t* Yb = P.Y + (size_t)(b * 2048) * LDY;
    const bf16_t* Yt = Yb + (size_t)t * LDY;
    bf16_t* orow = P.ONSA + (size_t)(b * 2048 + t) * D_;
    constexpr float SC2 = 0.08838834764831845f * LOG2E;
    const int tq64 = t - 64 * fq; const float tq64f = (float)tq64 - 15.5f;
    const int tq = t - 4 * fq, lane8 = lane * 8;
    float pown[8], ptail[8];
#pragma unroll
    for (int kt = 0; kt < 8; ++kt) { pown[kt] = 0.f; ptail[kt] = 0.f; }
#pragma unroll
    for (int hd = 0; hd < 4; ++hd)
#pragma unroll
        for (int dc = 0; dc < 4; ++dc) qs[(hd * 4 + dc) * 64] = *(const bf16x8*)(Yt + OFF_Q + (4 * g + hd) * 128 + 32 * dc + 8 * fq);
#ifndef NO_CMP
#pragma unroll 1
    for (int hd = 0; hd < 4; ++hd) {
        const int hh = 4 * g + hd;
        const bf16_t* kcb = P.KC + (size_t)bg * 16384 + lane * 8;
        const bf16_t* vcb = P.VCT + (size_t)bg * 16384 + lane * 8;
        asm volatile("" : "+v"(kcb), "+v"(vcb));
        const LAS bf16x8* Qf = qs + hd * 4 * 64;
        f32x4 s[8];
#pragma unroll
        for (int kt = 0; kt < 8; ++kt) { s[kt] = (f32x4){0.f, 0.f, 0.f, 0.f};
#pragma unroll
            for (int dc = 0; dc < 4; ++dc) { const bf16x8 kf = *(const bf16x8*)(kcb + kt * 2048 + dc * 512); s[kt] = MFMA16(kf, Qf[dc * 64], s[kt]); }
            if (kt & 1) __builtin_amdgcn_sched_barrier(0); }
        const float slope2 = ex2(-0.5f * (float)(hh + 1)) * LOG2E;
        float mx = -INFINITY;
#pragma unroll
        for (int kt = 0; kt < 8; ++kt)
#pragma unroll
            for (int j = 0; j < 4; ++j) {
                const bool valid = (256 * kt + 16 * j + 31) <= tq64;
                const float v = valid ? s[kt][j] * SC2 - slope2 * (tq64f - (float)(256 * kt + 16 * j)) : -INFINITY;
                s[kt][j] = v; mx = fmaxf(mx, v);
            }
        mx = fmaxf(mx, __shfl_xor(mx, 16)); mx = fmaxf(mx, __shfl_xor(mx, 32));
        const float muse = (mx == -INFINITY) ? 0.f : mx;
        float ls = 0.f;
#pragma unroll
        for (int kt = 0; kt < 8; ++kt)
#pragma unroll
            for (int j = 0; j < 4; ++j) { const float pv = ex2(s[kt][j] - muse); s[kt][j] = pv; ls += pv; }
        ls += __shfl_xor(ls, 16); ls += __shfl_xor(ls, 32);
        const float inv = 1.0f / fmaxf(ls, 1.17549435e-38f);
#pragma unroll
        for (int kt = 0; kt < 8; ++kt)
#pragma unroll
            for (int j = 0; j < 4; ++j) s[kt][j] *= inv;
#pragma unroll
        for (int kt = 0; kt < 8; ++kt) { const float h3 = 0.5f * s[kt][3]; ptail[kt] += h3; pown[kt] += ((s[kt][0] + s[kt][1]) + s[kt][2]) + h3; }
        if ((hd >> 1) != hp) continue;
        f32x4 O[8];
#pragma unroll
        for (int dt = 0; dt < 8; ++dt) O[dt] = (f32x4){0.f, 0.f, 0.f, 0.f};
#pragma unroll
        for (int ks = 0; ks < 4; ++ks) {
            u32x4 pw; pw.x = cvt_pk_bf16(s[2 * ks][0], s[2 * ks][1]); pw.y = cvt_pk_bf16(s[2 * ks][2], s[2 * ks][3]);
            pw.z = cvt_pk_bf16(s[2 * ks + 1][0], s[2 * ks + 1][1]); pw.w = cvt_pk_bf16(s[2 * ks + 1][2], s[2 * ks + 1][3]);
            const bf16x8 Pb = __builtin_bit_cast(bf16x8, pw);
#pragma unroll
            for (int dt = 0; dt < 8; ++dt) {
                O[dt] = MFMA16(*(const bf16x8*)(vcb + (ks * 8 + dt) * 512), Pb, O[dt]);
            }
            __builtin_amdgcn_sched_barrier(0);
        }
        const float gate = sigmoid_f(bf2f(Yt[OFF_GL + hh]));
#pragma unroll
        for (int dt = 0; dt < 8; ++dt) {
            u32x2 w; w.x = cvt_pk_bf16(O[dt][0] * gate, O[dt][1] * gate); w.y = cvt_pk_bf16(O[dt][2] * gate, O[dt][3] * gate);
            *(u32x2*)(orow + hh * 128 + 16 * dt + 4 * fq) = w;
        }
    }
#endif
    unsigned sm = 0;
#ifdef NO_SEL
    sm = (unsigned)Yt[0];
#endif
#ifndef NO_SEL
    {
        float val[8], tail[8], sh[8];
        const int bq = (t >> 6) - fq;
#pragma unroll
        for (int kt = 0; kt < 8; ++kt) { tail[kt] = ptail[kt]; sh[kt] = __shfl(tail[kt], (lane + 48) & 63); }
#pragma unroll
        for (int kt = 0; kt < 8; ++kt) {
            const float prev = fq > 0 ? sh[kt] : (kt > 0 ? sh[kt > 0 ? kt - 1 : 0] : 0.f);
            const float imp = pown[kt] + prev;
            const bool forced = (kt == 0 && fq == 0) || (4 * kt == bq) || (4 * kt == bq - 1);
            val[kt] = forced ? 1e4f : (4 * kt <= bq ? imp : -1e4f);
        }
        int cnt[8];
#pragma unroll
        for (int kt = 0; kt < 8; ++kt) cnt[kt] = 0;
#pragma unroll 1
        for (int f2 = 0; f2 < 4; ++f2) {
            const int df = fq - f2;
#pragma unroll
            for (int k2 = 0; k2 < 8; ++k2) {
                const float o = __shfl(val[k2], l15 + 16 * f2);
#pragma unroll
                for (int kt = 0; kt < 8; ++kt) cnt[kt] += ((o > val[kt]) || (o == val[kt] && (4 * (k2 - kt)) < df)) ? 1 : 0;
            }
        }
        unsigned smq = 0;
#pragma unroll
        for (int kt = 0; kt < 8; ++kt) if (cnt[kt] < 16) smq |= 1u << (4 * kt);
        sm = smq << fq;
        sm |= __shfl_xor(sm, 16); sm |= __shfl_xor(sm, 32);
    }
#endif
#ifndef NO_SW
    {
        float coef[2], m[2], l[2]; f32x4 O[2][8];
        const LAS bf16x8* Qf = qs + hp * 8 * 64;
#pragma unroll
        for (int r = 0; r < 2; ++r) coef[r] = ex2(-0.5f * (float)(4 * g + 2 * hp + r + 1)) * LOG2E;
#pragma unroll 1
        for (int br = 1; br < 3; ++br) {
#pragma unroll
            for (int r = 0; r < 2; ++r) { m[r] = -INFINITY; l[r] = 0.f;
#pragma unroll
                for (int dt = 0; dt < 8; ++dt) O[r][dt] = (f32x4){0.f, 0.f, 0.f, 0.f}; }
            if (br == 1) {
                const bf16_t* Kp = P.KS + (size_t)bg * 262144; const bf16_t* Vt = P.VTS + (size_t)bg * 262144;
                const int blkmax = (t0 + 15) >> 6;
#pragma unroll 1
                for (int jb = 0; jb <= blkmax; ++jb) {
                    const bool vb = (sm >> jb) & 1u;
                    if (__ballot(vb) == 0ull) continue;
                    att_step<2, 8, 0>(Kp, Vt, 64 * jb, tq, lane8, Qf, O, m, l, coef, vb);
                    att_step<2, 8, 0>(Kp, Vt, 64 * jb + 32, tq, lane8, Qf, O, m, l, coef, vb);
                }
            } else {
                const bf16_t* Kp = P.KW + (size_t)bg * 262144; const bf16_t* Vt = P.VTW + (size_t)bg * 262144;
                int kstart = t0 - 511; kstart = kstart < 0 ? 0 : (kstart & ~31);
#pragma unroll 1
                for (int k0 = kstart; k0 <= t0; k0 += 32) att_step<2, 8, 1>(Kp, Vt, k0, tq, lane8, Qf, O, m, l, coef, true);
            }
#pragma unroll
            for (int r = 0; r < 2; ++r) {
                const int hh = 4 * g + 2 * hp + r;
                float lt = l[r]; lt += __shfl_xor(lt, 16); lt += __shfl_xor(lt, 32);
                const float sc = sigmoid_f(bf2f(Yt[OFF_GL + br * 16 + hh])) / fmaxf(lt, 1.17549435e-38f);
#pragma unroll
                for (int dt = 0; dt < 8; ++dt) {
                    u32x2* op = (u32x2*)(orow + hh * 128 + 16 * dt + 4 * fq);
                    const u32x2 pw = *op;
                    u32x2 w; w.x = cvt_pk_bf16(bf_lo(pw.x) + O[r][dt][0] * sc, bf_hi(pw.x) + O[r][dt][1] * sc);
                    w.y = cvt_pk_bf16(bf_lo(pw.y) + O[r][dt][2] * sc, bf_hi(pw.y) + O[r][dt][3] * sc);
                    *op = w;
                }
            }
        }
    }
#endif
}

__device__ __forceinline__ void ret_unit(const MixPtrs& P, int b, int h, int tile, int lane, LAS bf16x8* qs) {
    const int l15 = lane & 15, fq = lane >> 4, t0 = tile * 16, t = t0 + l15;
    const bf16_t* Yb = P.Y + (size_t)(b * 2048) * LDY;
    const bf16_t* Yt = Yb + (size_t)t * LDY;
    float coef[1], m[1], l[1]; f32x4 O[1][16];
    const LAS bf16x8* Qf = qs;
#pragma unroll
    for (int dc = 0; dc < 4; ++dc) qs[dc * 64] = *(const bf16x8*)(Yt + OFF_QR + h * 128 + 32 * dc + 8 * fq);
    coef[0] = log1pf(-exp2f(-5.0f - (float)h)) * LOG2E; m[0] = 0.f; l[0] = 0.f;
#pragma unroll
    for (int dt = 0; dt < 16; ++dt) O[0][dt] = (f32x4){0.f, 0.f, 0.f, 0.f};
    const bf16_t* Kp = P.KR + (size_t)(b * 8 + h) * 262144; const bf16_t* Vt = P.VTR + (size_t)(b * 8 + h) * 524288;
#pragma unroll 1
    for (int k0 = 0; k0 <= t0; k0 += 32) att_step<1, 16, 2>(Kp, Vt, k0, t - 4 * fq, lane * 8, Qf, O, m, l, coef, true);
    float sum = 0.f;
#pragma unroll
    for (int dt = 0; dt < 16; ++dt) sum += (O[0][dt][0] + O[0][dt][1]) + (O[0][dt][2] + O[0][dt][3]);
    sum += __shfl_xor(sum, 16); sum += __shfl_xor(sum, 32);
    const float mean = sum * (1.0f / 256.0f);
    float var = 0.f;
#pragma unroll
    for (int dt = 0; dt < 16; ++dt) { const f32x4 d = O[0][dt] - mean; var += (d[0] * d[0] + d[1] * d[1]) + (d[2] * d[2] + d[3] * d[3]); }
    var += __shfl_xor(var, 16); var += __shfl_xor(var, 32);
    const float rstd = 1.0f / sqrtf(var * (1.0f / 256.0f) + EPS_);
    bf16_t* orow = P.ORET + (size_t)(b * 2048 + t) * D_ + h * 256;
#pragma unroll
    for (int dt = 0; dt < 16; ++dt) {
        const int e = 16 * dt + 4 * fq;
        const f32x4 gain = *(const f32x4*)(P.gn + h * 256 + e);
        const u32x2 gw = *(const u32x2*)(Yt + OFF_GR + h * 256 + e);
        const f32x4 y = (O[0][dt] - mean) * rstd * gain;
        u32x2 w; w.x = cvt_pk_bf16(silu_f(bf_lo(gw.x)) * y[0], silu_f(bf_hi(gw.x)) * y[1]); w.y = cvt_pk_bf16(silu_f(bf_lo(gw.y)) * y[2], silu_f(bf_hi(gw.y)) * y[3]);
        *(u32x2*)(orow + e) = w;
    }
}

__device__ __forceinline__ void compress_unit(int unit, const bf16_t* __restrict__ Y, const float* __restrict__ cmp_pos, const float* __restrict__ cmp_b1, const float* __restrict__ g_qk,
                                              const bf16_t* __restrict__ WC1, const bf16_t* __restrict__ WC2, bf16_t* __restrict__ KC, bf16_t* __restrict__ VCT, LAS unsigned char* lds, int tid) {
    const int lane = tid & 63, wave = tid >> 6, l15 = lane & 15, fq = lane >> 4;
    const int i = unit >> 7, bg = (unit >> 3) & 15, ct = unit & 7, b = bg >> 2, g = bg & 3;
    const int c = 16 * ct + l15; const bool cvalid = c < 127;
    const bf16_t* Yc = Y + (size_t)(b * 2048 + 16 * (cvalid ? c : 0)) * LDY + OFF_KV + i * 512 + g * 128;
    LAS float* red = (LAS float*)lds;
    LAS bf16_t* hid = (LAS bf16_t*)(lds + 65536);
    f32x4 acc[8];
#pragma unroll
    for (int nt = 0; nt < 8; ++nt) acc[nt] = (f32x4){0.f, 0.f, 0.f, 0.f};
#pragma unroll 1
    for (int ls = 0; ls < 4; ++ls) {
        const int l = 4 * wave + ls;
#pragma unroll
        for (int dc = 0; dc < 4; ++dc) {
            const int d = 32 * dc + 8 * fq;
            u32x4 aw = (u32x4){0u, 0u, 0u, 0u};
            if (cvalid) {
                const u32x4 zw = *(const u32x4*)(Yc + (size_t)l * LDY + d);
                const f32x4 p0 = *(const f32x4*)(cmp_pos + (size_t)(i * 32 + l) * 128 + d), p1 = *(const f32x4*)(cmp_pos + (size_t)(i * 32 + l) * 128 + d + 4);
                aw.x = cvt_pk_bf16(bf_lo(zw.x) + p0[0], bf_hi(zw.x) + p0[1]); aw.y = cvt_pk_bf16(bf_lo(zw.y) + p0[2], bf_hi(zw.y) + p0[3]);
                aw.z = cvt_pk_bf16(bf_lo(zw.z) + p1[0], bf_hi(zw.z) + p1[1]); aw.w = cvt_pk_bf16(bf_lo(zw.w) + p1[2], bf_hi(zw.w) + p1[3]);
            }
            const bf16x8 a = __builtin_bit_cast(bf16x8, aw);
            const int kidx = l * 128 + 32 * dc + 8 * fq;
#pragma unroll
            for (int nt = 0; nt < 8; ++nt) { const bf16x8 bf = *(const bf16x8*)(WC1 + (size_t)(i * 128 + 16 * nt + l15) * 4096 + kidx); acc[nt] = MFMA16(a, bf, acc[nt]); }
        }
    }
#pragma unroll
    for (int nt = 0; nt < 8; ++nt)
#pragma unroll
        for (int j = 0; j < 4; ++j) red[(wave * 16 + 4 * fq + j) * 128 + 16 * nt + l15] = acc[nt][j];
    __syncthreads();
    {
        const int e = tid * 4, cc = e >> 7, n = e & 127;
        f32x4 s = *(const f32x4*)(cmp_b1 + i * 128 + n);
#pragma unroll
        for (int w = 0; w < 8; ++w) s += *(const LAS f32x4*)(red + (w * 16 + cc) * 128 + n);
        float o[4];
#pragma unroll
        for (int j = 0; j < 4; ++j) { const float x = s[j]; o[j] = 0.5f * x * (1.0f + tanhf(0.7978845608028654f * (x + 0.044715f * x * x * x))); }
        u32x2 w; w.x = cvt_pk_bf16(o[0], o[1]); w.y = cvt_pk_bf16(o[2], o[3]);
        *(LAS u32x2*)(hid + cc * 136 + n) = w;
    }
    __syncthreads();
    f32x4 o2 = (f32x4){0.f, 0.f, 0.f, 0.f};
#pragma unroll
    for (int kc = 0; kc < 4; ++kc) {
        const bf16x8 a = *(const LAS bf16x8*)(hid + l15 * 136 + 32 * kc + 8 * fq);
        const bf16x8 bf = *(const bf16x8*)(WC2 + (size_t)(i * 128 + 16 * wave + l15) * 128 + 32 * kc + 8 * fq);
        o2 = MFMA16(a, bf, o2);
    }
    if (i == 1) {
        const int cbase = 16 * ct + 4 * fq;
        u32x2 w; w.x = cvt_pk_bf16(cbase + 0 < 127 ? o2[0] : 0.f, cbase + 1 < 127 ? o2[1] : 0.f); w.y = cvt_pk_bf16(cbase + 2 < 127 ? o2[2] : 0.f, cbase + 3 < 127 ? o2[3] : 0.f);
        *(u32x2*)(VCT + (size_t)bg * 16384 + (((ct >> 1) * 8 + wave) * 64 + lane) * 8 + 4 * (ct & 1)) = w;
    } else {
#pragma unroll
        for (int j = 0; j < 4; ++j) red[(4 * fq + j) * 128 + 16 * wave + l15] = o2[j];
        __syncthreads();
        const int cc = tid >> 5, part = tid & 31;
        const f32x4 v = *(const LAS f32x4*)(red + cc * 128 + 4 * part);
        float ss = (v[0] * v[0] + v[1] * v[1]) + (v[2] * v[2] + v[3] * v[3]);
#pragma unroll
        for (int o = 1; o < 32; o <<= 1) ss += __shfl_xor(ss, o);
        const float r = 1.0f / sqrtf(ss * (1.0f / 128.0f) + EPS_);
        const f32x4 gq = *(const f32x4*)(g_qk + 128 + 4 * part);
        f32x4 y = v * r * gq;
        if (16 * ct + cc >= 127) y = (f32x4){0.f, 0.f, 0.f, 0.f};
        u32x2 w; w.x = cvt_pk_bf16(y[0], y[1]); w.y = cvt_pk_bf16(y[2], y[3]);
        *(u32x2*)(KC + (size_t)bg * 16384 + (ct * 4 + (part >> 3)) * 512 + ((part >> 1) & 3) * 128 + cc * 8 + 4 * (part & 1)) = w;
    }
    __syncthreads();
}

struct Params {
    const float *x, *c, *w_ada, *b_ada, *g_norm, *w_gate, *w_up, *w_down, *w_in, *g_qk, *cmp_pos, *cmp_w1, *cmp_b1, *cmp_w2, *gn_gain, *w_pn, *w_pr, *w_out;
    float* out; unsigned char* ws; int mask; int pad;
};

struct ConvTile { const float* W; bf16_t* WT; int K, N, mode, k0, n0; };
__device__ __forceinline__ ConvTile conv_tile(const Params& p, int set, int idx) {
    ConvTile c; int r = idx, nbn;
    constexpr int T_GU = (D_ / 128) * (FF_ / 128), T_IN = (D_ / 128) * ((NIN_ + 127) / 128), T_P = (D_ / 128) * (D_ / 128), T_C1 = 4096 / 128;
    const int layer = set;
    if (set == 1 || r < 3 * T_GU) {
        if (r < T_GU) { c.W = p.w_gate + (size_t)layer * D_ * FF_; c.WT = (bf16_t*)(p.ws + WS_WGU); c.K = D_; c.N = FF_; c.mode = 1; }
        else if (r < 2 * T_GU) { r -= T_GU; c.W = p.w_up + (size_t)layer * D_ * FF_; c.WT = (bf16_t*)(p.ws + WS_WGU); c.K = D_; c.N = FF_; c.mode = 2; }
        else { r -= 2 * T_GU; c.W = p.w_down + (size_t)layer * D_ * FF_; c.WT = (bf16_t*)(p.ws + WS_WD); c.K = FF_; c.N = D_; c.mode = 0; }
    } else {
        r -= 3 * T_GU;
        if (r < T_IN) { c.W = p.w_in; c.WT = (bf16_t*)(p.ws + WS_WIN); c.K = D_; c.N = NIN_; c.mode = 3; }
        else if (r < T_IN + 3 * T_P) { r -= T_IN; const int w = r / T_P; r -= w * T_P; c.W = w == 0 ? p.w_pn : (w == 1 ? p.w_pr : p.w_out);
            c.WT = (bf16_t*)(p.ws + (w == 0 ? WS_WPN : (w == 1 ? WS_WPR : WS_WO))); c.K = D_; c.N = D_; c.mode = 0; }
        else if (r < T_IN + 3 * T_P + 2 * T_C1) { r -= T_IN + 3 * T_P; const int i = r / T_C1; r -= i * T_C1; c.W = p.cmp_w1 + (size_t)i * 4096 * 128; c.WT = (bf16_t*)(p.ws + WS_WC1) + (size_t)i * 128 * 4096; c.K = 4096; c.N = 128; c.mode = 0; }
        else { r -= T_IN + 3 * T_P + 2 * T_C1; c.W = p.cmp_w2 + (size_t)r * 128 * 128; c.WT = (bf16_t*)(p.ws + WS_WC2) + (size_t)r * 128 * 128; c.K = 128; c.N = 128; c.mode = 0; r = 0; }
    }
    nbn = (c.N + 127) >> 7;
    const int kb = r / nbn, nb = r - kb * nbn; c.k0 = kb * 128; c.n0 = nb * 128;
    return c;
}
__device__ __forceinline__ void conv_load(const ConvTile& c, int tid, f32x4 (&r)[8]) {
    const int c4 = (tid & 31) * 4, r0 = 2 * (tid >> 5);
    const bool ok = (c.n0 + c4) < c.N;
    const float* src = c.W + (size_t)(c.k0 + r0) * c.N + c.n0 + c4;
#pragma unroll
    for (int i = 0; i < 4; ++i)
#pragma unroll
        for (int e = 0; e < 2; ++e) r[2 * i + e] = ok ? *(const f32x4*)(src + (size_t)(32 * i + e) * c.N) : (f32x4){0.f, 0.f, 0.f, 0.f};
}
__device__ __forceinline__ void conv_phase(const Params& p, int set, LAS unsigned char* lds, int tid, int bid, int G) {
    constexpr int T_GU = (D_ / 128) * (FF_ / 128), T_IN = (D_ / 128) * ((NIN_ + 127) / 128), T_P = (D_ / 128) * (D_ / 128), T_C1 = 4096 / 128;
    const int total = set == 0 ? 3 * T_GU + T_IN + 3 * T_P + 2 * T_C1 + 2 : 3 * T_GU;
    f32x4 r[8];
    int idx = bid;
    if (idx < total) { const ConvTile c = conv_tile(p, set, idx); conv_load(c, tid, r); }
    for (int it = 0; idx < total; ++it, idx += G) {
        const ConvTile c = conv_tile(p, set, idx);
        LAS bf16_t* buf = (LAS bf16_t*)(lds + (it & 1) * 34816);
        {
            const int c4 = (tid & 31) * 4, r0 = 2 * (tid >> 5);
#pragma unroll
            for (int i = 0; i < 4; ++i)
#pragma unroll
                for (int j = 0; j < 4; ++j) *(LAS unsigned*)(buf + (c4 + j) * 136 + r0 + 32 * i) = cvt_pk_bf16(r[2 * i][j], r[2 * i + 1][j]);
        }
        if (idx + G < total) { const ConvTile n = conv_tile(p, set, idx + G); conv_load(n, tid, r); }
        __syncthreads();
#pragma unroll
        for (int i = 0; i < 4; ++i) {
            const int q = tid + 512 * i, n = q >> 4, kc = q & 15;
            const u32x4 w = *(const LAS u32x4*)(buf + n * 136 + 8 * kc);
            if (c.n0 + n < c.N) *(u32x4*)(c.WT + (size_t)rowmap(c.mode, c.n0 + n) * c.K + c.k0 + 8 * kc) = w;
        }
    }
    __syncthreads();
}

__global__ void __launch_bounds__(512, 2) fwd_kernel(Params p) {
    extern __shared__ __attribute__((aligned(16))) unsigned char lds_raw[];
    cg::grid_group grid = cg::this_grid();
    LAS unsigned char* lds = (LAS unsigned char*)lds_raw;
    const int tid = threadIdx.x, lane = tid & 63, wave = __builtin_amdgcn_readfirstlane(tid >> 6);
    const int G = gridDim.x, gw = blockIdx.x * 8 + wave, NGW = G * 8;
#define ctl ((unsigned*)(p.ws + WS_CTL))
#define ada ((float*)(p.ws + WS_ADA))
#define WGU ((bf16_t*)(p.ws + WS_WGU))
#define WD ((bf16_t*)(p.ws + WS_WD))
#define WIN ((bf16_t*)(p.ws + WS_WIN))
#define WPN ((bf16_t*)(p.ws + WS_WPN))
#define WPR ((bf16_t*)(p.ws + WS_WPR))
#define WO ((bf16_t*)(p.ws + WS_WO))
#define WC1 ((bf16_t*)(p.ws + WS_WC1))
#define WC2 ((bf16_t*)(p.ws + WS_WC2))
#define H ((bf16_t*)(p.ws + WS_H))
#define ONSA ((bf16_t*)(p.ws + WS_H))
#define Y ((bf16_t*)(p.ws + WS_Y))
#define ACT ((bf16_t*)(p.ws + WS_Y))
#define MG ((bf16_t*)(p.ws + WS_MG))
#define ORET ((bf16_t*)(p.ws + WS_ORET))
#define VTS ((bf16_t*)(p.ws + WS_VTS))
#define VTW ((bf16_t*)(p.ws + WS_VTW))
#define VTR ((bf16_t*)(p.ws + WS_VTR))
#define KC ((bf16_t*)(p.ws + WS_KC))
#define VCT ((bf16_t*)(p.ws + WS_VCT))
#define KS ((bf16_t*)(p.ws + WS_KS))
#define KW ((bf16_t*)(p.ws + WS_KW))
#define KR ((bf16_t*)(p.ws + WS_KR))
    const int mask = p.mask;
#ifndef DBL_MASK
#define DBL_MASK 0
#endif
#define REPS(k) (1 + ((DBL_MASK >> (k)) & 1))
#ifdef CT_MASK
#define ON(k) ((CT_MASK >> (k)) & 1)
#else
#define ON(k) ((mask >> (k)) & 1)
#endif

    for (int rep = 0; rep < REPS(0); ++rep) { if (rep) grid.sync();
    if (ON(0)) {
        LAS float* cond = (LAS float*)lds;
        LAS float* red = (LAS float*)(lds + 32768);
        for (int i = tid; i < 4 * D_; i += 512) cond[i] = silu_f(p.c[i]);
        __syncthreads();
        for (int it = blockIdx.x; it < NADA / 64; it += G) {
            const int n = it * 64 + lane; float a0 = 0.f, a1 = 0.f, a2 = 0.f, a3 = 0.f;
            const int kb = wave * 256;
#pragma unroll 8
            for (int kk = 0; kk < 256; ++kk) { const int k = kb + kk; const float w = p.w_ada[(size_t)k * NADA + n];
                a0 += cond[k] * w; a1 += cond[D_ + k] * w; a2 += cond[2 * D_ + k] * w; a3 += cond[3 * D_ + k] * w; }
            red[(wave * 4 + 0) * 64 + lane] = a0; red[(wave * 4 + 1) * 64 + lane] = a1; red[(wave * 4 + 2) * 64 + lane] = a2; red[(wave * 4 + 3) * 64 + lane] = a3;
            __syncthreads();
            if (tid < 256) { const int bb = tid >> 6, l = tid & 63; float s = p.b_ada[it * 64 + l];
#pragma unroll
                for (int w = 0; w < 8; ++w) s += red[(w * 4 + bb) * 64 + l];
                ada[(size_t)bb * NADA + it * 64 + l] = s; }
            __syncthreads();
        }
        __syncthreads();
        conv_phase(p, 0, lds, tid, (int)blockIdx.x, G);
        { u32x4* z = (u32x4*)(WIN + (size_t)NIN_ * D_); const int nz = (LDY - NIN_) * D_ * 2 / 16;
          for (int i = blockIdx.x * 512 + tid; i < nz; i += G * 512) z[i] = (u32x4){0u, 0u, 0u, 0u}; }
    }
    }
    grid.sync();
    for (int rep = 0; rep < REPS(1); ++rep) { if (rep) grid.sync();
    if (ON(1)) norm_rows(p.x, p.g_norm, ada, 0, 1, H, gw, NGW, lane);
    }
    grid.sync();
    for (int rep = 0; rep < REPS(2); ++rep) { if (rep) grid.sync();
    if (ON(2)) {
        pg8::Gemm g{H, WGU, T_, 2 * FF_, D_}; pg8::StaticOrder S; S.init(T_, 2 * FF_, G, (int)blockIdx.x);
        EpiSwiglu E{ACT};
        pg8::gemm_phase<EpiSwiglu, pg8::StaticOrder, true, true>(lds, g, S, E);
    }
    }
    grid.sync();
    if (ON(3)) {
        pg8::Gemm g{ACT, WD, T_, D_, FF_}; pg8::StaticOrder S; S.init(T_, D_, G, (int)blockIdx.x);
        EpiResid E{p.x, p.out, ada + 2 * D_, 0.5f};
        pg8::gemm_phase<EpiResid, pg8::StaticOrder, true, true>(lds, g, S, E);
    } else {
        for (size_t i = (size_t)blockIdx.x * 512 + tid; i < (size_t)T_ * D_ / 4; i += (size_t)G * 512) ((f32x4*)p.out)[i] = ((const f32x4*)p.x)[i];
    }
    grid.sync();
    for (int rep = 0; rep < REPS(4); ++rep) { if (rep) grid.sync();
    if (ON(4)) {
        norm_rows(p.out, p.g_norm + D_, ada, 3, 4, H, gw, NGW, lane);
        __syncthreads();
        conv_phase(p, 1, lds, tid, (int)blockIdx.x, G);
    }
    }
    grid.sync();
    for (int rep = 0; rep < REPS(5); ++rep) { if (rep) grid.sync();
    if (ON(5)) {
        pg8::Gemm g{H, WIN, T_, LDY, D_}; pg8::StaticOrder S; S.init(T_, LDY, G, (int)blockIdx.x);
        EpiY E{Y};
        pg8::gemm_phase<EpiY, pg8::StaticOrder, true, true>(lds, g, S, E);
    }
    }
    grid.sync();
    for (int rep = 0; rep < REPS(6); ++rep) { if (rep) grid.sync();
    if (ON(6)) {
        for (int unit = blockIdx.x; unit < 256; unit += G) compress_unit(unit, Y, p.cmp_pos, p.cmp_b1, p.g_qk, WC1, WC2, KC, VCT, lds, tid);
        __syncthreads();
        if (rep == 0) for (int tok = gw; tok < T_; tok += NGW) {
            bf16_t* row = Y + (size_t)tok * LDY;
            const int b = tok >> 11, sidx = tok & 2047, c16 = lane & 15, hsub = lane >> 4;
            const size_t fro = (size_t)((sidx >> 4) * 4 + (c16 >> 2)) * 512 + (c16 & 3) * 128 + (sidx & 15) * 8;
#pragma unroll 1
            for (int seg = 0; seg < 8; ++seg) {
                const int colbase = seg < 4 ? seg * 512 : (seg == 4 ? OFF_KV + 1024 : (seg == 5 ? OFF_KV + 2048 : OFF_KR + (seg - 6) * 512)), gi = seg < 4 ? 0 : (seg == 4 ? 2 : 3);
                const u32x4 w = *(const u32x4*)(row + colbase + lane * 8);
                u32x4 o = w;
                if (seg < 6) {
                    float f[8] = {bf_lo(w.x), bf_hi(w.x), bf_lo(w.y), bf_hi(w.y), bf_lo(w.z), bf_hi(w.z), bf_lo(w.w), bf_hi(w.w)};
                    float ss = 0.f;
#pragma unroll
                    for (int j = 0; j < 8; ++j) ss += f[j] * f[j];
                    ss += __shfl_xor(ss, 1); ss += __shfl_xor(ss, 2); ss += __shfl_xor(ss, 4); ss += __shfl_xor(ss, 8);
                    const float r = 1.0f / sqrtf(ss * (1.0f / 128.0f) + EPS_);
                    const float* gq = p.g_qk + gi * 128 + c16 * 8;
                    const f32x4 g0 = *(const f32x4*)gq, g1 = *(const f32x4*)(gq + 4);
                    o.x = cvt_pk_bf16(f[0] * r * g0[0], f[1] * r * g0[1]); o.y = cvt_pk_bf16(f[2] * r * g0[2], f[3] * r * g0[3]);
                    o.z = cvt_pk_bf16(f[4] * r * g1[0], f[5] * r * g1[1]); o.w = cvt_pk_bf16(f[6] * r * g1[2], f[7] * r * g1[3]);
                }
                bf16_t* dstp;
                if (seg < 4) dstp = row + colbase + lane * 8;
                else if (seg == 4) dstp = KS + (size_t)(b * 4 + hsub) * 262144 + fro;
                else if (seg == 5) dstp = KW + (size_t)(b * 4 + hsub) * 262144 + fro;
                else dstp = KR + (size_t)(b * 8 + (seg - 6) * 4 + hsub) * 262144 + fro;
                *(u32x4*)dstp = o;
            }
        }
        LAS bf16_t* tl = (LAS bf16_t*)(lds + wave * 16384);
        for (int it = gw; it < 48 * 128; it += NGW) {
            const int tt = it / 48, ct = it - tt * 48;
            int srccol, cc, HD; bf16_t* dst;
            if (ct < 8) { srccol = OFF_KV + 3 * 512 + ct * 64; cc = ct * 64; dst = VTS; HD = 128; }
            else if (ct < 16) { srccol = OFF_KV + 5 * 512 + (ct - 8) * 64; cc = (ct - 8) * 64; dst = VTW; HD = 128; }
            else { srccol = OFF_VR + (ct - 16) * 64; cc = (ct - 16) * 64; dst = VTR; HD = 256; }
            const int b = tt >> 5, s0 = (tt & 31) * 64;
            const int head = cc / HD, dt0 = (cc - head * HD) >> 4, NDTh = HD >> 4, nheads = (HD == 128) ? 4 : 8;
#pragma unroll
            for (int i = 0; i < 8; ++i) {
                const int tok = 8 * i + (lane >> 3), ch = lane & 7;
                const u32x4 w = *(const u32x4*)(Y + (size_t)(b * 2048 + s0 + tok) * LDY + srccol + ch * 8);
                LAS bf16_t* d = tl + (ch * 8) * 72 + tok;
                d[0 * 72] = (bf16_t)(w.x & 0xffffu); d[1 * 72] = (bf16_t)(w.x >> 16); d[2 * 72] = (bf16_t)(w.y & 0xffffu); d[3 * 72] = (bf16_t)(w.y >> 16);
                d[4 * 72] = (bf16_t)(w.z & 0xffffu); d[5 * 72] = (bf16_t)(w.z >> 16); d[6 * 72] = (bf16_t)(w.w & 0xffffu); d[7 * 72] = (bf16_t)(w.w >> 16);
            }
            asm volatile("s_waitcnt lgkmcnt(0)" ::: "memory");
            bf16_t* hb = dst + (size_t)(b * nheads + head) * (2048 * HD) + lane * 8;
#pragma unroll
            for (int i = 0; i < 8; ++i) {
                const int ks = i >> 2, dt = i & 3, col = 16 * dt + (lane & 15), fq4 = 4 * (lane >> 4);
                const u32x2 lo = *(const LAS u32x2*)(tl + col * 72 + 32 * ks + fq4), hi = *(const LAS u32x2*)(tl + col * 72 + 32 * ks + 16 + fq4);
                u32x4 w; w.x = lo.x; w.y = lo.y; w.z = hi.x; w.w = hi.y;
                *(u32x4*)(hb + (size_t)(((s0 >> 5) + ks) * NDTh + dt0 + dt) * 512) = w;
            }
            asm volatile("s_waitcnt lgkmcnt(0)" ::: "memory");
        }
    }
    }
    grid.sync();
    for (int rep = 0; rep < REPS(7); ++rep) { if (rep) grid.sync();
    if (ON(7)) {
        MixPtrs MP{Y, ONSA, ORET, VTS, VTW, VTR, KC, VCT, p.gn_gain, KS, KW, KR};
        LAS bf16x8* qs = (LAS bf16x8*)(lds + wave * 16384) + lane;
        const int x0 = blockIdx.x & 7;
#pragma unroll 1
        for (int qi = 0; qi < 8; ++qi) {
            const int x = (x0 + qi) & 7;
            unsigned* qc = ctl + 256 * rep + 16 * x;
            for (;;) {
                unsigned id = 0;
                if (lane == 0) id = atomicAdd(qc, 1u);
                id = (unsigned)__builtin_amdgcn_readfirstlane((int)id);
                if (id >= 1024u) break;
                const int tile = 127 - (int)(id >> 3), sub = (int)(id & 7u);
#ifndef NO_NSA
                if (sub < 4) { const int bg = x + 8 * (sub >> 1); nsa_unit(MP, bg >> 2, bg & 3, tile, sub & 1, lane, qs); }
#endif
#ifndef NO_RET
                if (sub >= 4) { const int bh = x + 8 * (sub - 4); ret_unit(MP, bh >> 3, bh & 7, tile, lane, qs); }
#endif
            }
        }
    }
    }
    grid.sync();
    for (int rep = 0; rep < REPS(8); ++rep) { if (rep) grid.sync();
    if (ON(8)) {
        { pg8::Gemm g{ONSA, WPN, T_, D_, D_}; pg8::StaticOrder S; S.init(T_, D_, G, (int)blockIdx.x);
          EpiMerge<false> E{MG, Y, OFF_GA};
          pg8::gemm_phase<EpiMerge<false>, pg8::StaticOrder, true, true>(lds, g, S, E); }
        __syncthreads();
        { pg8::Gemm g{ORET, WPR, T_, D_, D_}; pg8::StaticOrder S; S.init(T_, D_, G, (int)blockIdx.x);
          EpiMerge<true> E{MG, Y, OFF_GB};
          pg8::gemm_phase<EpiMerge<true>, pg8::StaticOrder, true, true>(lds, g, S, E); }
    }
    }
    grid.sync();
    if (ON(9)) {
        pg8::Gemm g{MG, WO, T_, D_, D_}; pg8::StaticOrder S; S.init(T_, D_, G, (int)blockIdx.x);
        EpiResid E{p.out, p.out, ada + 5 * D_, 1.0f};
        pg8::gemm_phase<EpiResid, pg8::StaticOrder, true, true>(lds, g, S, E);
    }
    grid.sync();
    for (int rep = 0; rep < REPS(10); ++rep) { if (rep) grid.sync();
    if (ON(10)) norm_rows(p.out, p.g_norm + 2 * D_, ada, 6, 7, H, gw, NGW, lane);
    }
    grid.sync();
    for (int rep = 0; rep < REPS(11); ++rep) { if (rep) grid.sync();
    if (ON(11)) {
        pg8::Gemm g{H, WGU, T_, 2 * FF_, D_}; pg8::StaticOrder S; S.init(T_, 2 * FF_, G, (int)blockIdx.x);
        EpiSwiglu E{ACT};
        pg8::gemm_phase<EpiSwiglu, pg8::StaticOrder, true, true>(lds, g, S, E);
    }
    }
    grid.sync();
    if (ON(12)) {
        pg8::Gemm g{ACT, WD, T_, D_, FF_}; pg8::StaticOrder S; S.init(T_, D_, G, (int)blockIdx.x);
        EpiResid E{p.out, p.out, ada + 8 * D_, 0.5f};
        pg8::gemm_phase<EpiResid, pg8::StaticOrder, true, true>(lds, g, S, E);
    }
#undef ON
#undef ctl
#undef ada
#undef WGU
#undef WD
#undef WIN
#undef WPN
#undef WPR
#undef WO
#undef WC1
#undef WC2
#undef H
#undef ONSA
#undef Y
#undef ACT
#undef MG
#undef ORET
#undef VTS
#undef VTW
#undef VTR
#undef KC
#undef VCT
#undef KS
#undef KW
#undef KR
}

#ifndef PHASE_MASK
#define PHASE_MASK 0x1fff
#endif
extern "C" void kernel_launch(void* const* d_in, const int* in_sizes, int n_in, void* d_out, int out_size, void* d_ws, size_t ws_size, hipStream_t stream) {
    static int grid_blocks = 0;
    if (grid_blocks == 0) {
        if (n_in != 18 || ws_size < WS_END) { fprintf(stderr, "kernel_launch: unexpected n_in %d or workspace %zu < %zu\n", n_in, ws_size, (size_t)WS_END); grid_blocks = -1; return; }
        int dev = 0, cus = 0, per_cu = 0;
        hipGetDevice(&dev);
        hipDeviceGetAttribute(&cus, hipDeviceAttributeMultiprocessorCount, dev);
        if (hipFuncSetAttribute((const void*)fwd_kernel, hipFuncAttributeMaxDynamicSharedMemorySize, LDS_BYTES) != hipSuccess) { fprintf(stderr, "kernel_launch: hipFuncSetAttribute failed\n"); grid_blocks = -1; return; }
        if (hipOccupancyMaxActiveBlocksPerMultiprocessor(&per_cu, (const void*)fwd_kernel, 512, LDS_BYTES) != hipSuccess || per_cu < 1) { fprintf(stderr, "kernel_launch: occupancy query gave %d\n", per_cu); per_cu = 1; }
        (void)hipGetLastError();
        grid_blocks = cus * 1;
    }
    if (grid_blocks < 0) return;
    (void)hipMemsetAsync((char*)d_ws + WS_CTL, 0, 4096, stream);
    Params p{};
    p.x = (const float*)d_in[0]; p.c = (const float*)d_in[1]; p.w_ada = (const float*)d_in[2]; p.b_ada = (const float*)d_in[3]; p.g_norm = (const float*)d_in[4];
    p.w_gate = (const float*)d_in[5]; p.w_up = (const float*)d_in[6]; p.w_down = (const float*)d_in[7]; p.w_in = (const float*)d_in[8]; p.g_qk = (const float*)d_in[9];
    p.cmp_pos = (const float*)d_in[10]; p.cmp_w1 = (const float*)d_in[11]; p.cmp_b1 = (const float*)d_in[12]; p.cmp_w2 = (const float*)d_in[13]; p.gn_gain = (const float*)d_in[14];
    p.w_pn = (const float*)d_in[15]; p.w_pr = (const float*)d_in[16]; p.w_out = (const float*)d_in[17];
    p.out = (float*)d_out; p.ws = (unsigned char*)d_ws; p.mask = PHASE_MASK; p.pad = 0;
    void* args[] = {&p};
    hipError_t e = hipLaunchCooperativeKernel((const void*)fwd_kernel, dim3(grid_blocks), dim3(512), args, LDS_BYTES, stream);
    if (e != hipSuccess) fprintf(stderr, "kernel_launch: cooperative launch failed: %s (grid %d)\n", hipGetErrorString(e), grid_blocks);
}
```

```cpp
#include <hip/hip_runtime.h>
#include <hip/hip_cooperative_groups.h>
#include <cstdio>
#include <cstdint>
namespace cg = cooperative_groups;
namespace pg8 {
#define PG8_LAS __attribute__((address_space(3)))
typedef unsigned short bf16_t;
typedef short bf16x8 __attribute__((ext_vector_type(8)));
typedef float f32x4 __attribute__((ext_vector_type(4)));
typedef unsigned u32x4 __attribute__((ext_vector_type(4)));
constexpr int BM = 256, BK = 64, HALF = 128, HTB = HALF * BK * 2  , STAGE_BYTES = 8 * HTB, NXCD = 8, WGM = 8;

__host__ __device__ __forceinline__ int lds_byte(int r, int c) { const int st = (r >> 4) * 2 + (c >> 5), rr = r & 15, cc = c & 31, ob = rr * 64 + cc * 2; return st * 1024 + (ob ^ (((ob >> 9) & 1) << 5)); }
__host__ __device__ __forceinline__ void stage_rc(int b, int& R, int& C) { const int st = b / 1024, sb = b % 1024, swz = sb ^ (((sb >> 9) & 1) << 5); R = (st >> 1) * 16 + swz / 64; C = (st & 1) * 32 + (swz % 64) / 2; }
__host__ __device__ __forceinline__ int perm32(int rho) { const int n = rho >> 4, i = rho & 15; return 8 * (i >> 2) + 4 * n + (i & 3); }

struct Unit { int pm, pn; };
struct Gemm { const bf16_t* A; const bf16_t* Bt; int M, N, K; };

struct StaticOrder {
    int nM, nN, nwg, G, c;
    __host__ __device__ void init(int M, int N, int G_, int c_) { nM = M / BM; nN = N / BM; nwg = nM * nN; G = G_; c = c_; }
    __host__ __device__ bool next(int i, Unit& u) const {
        const long L = (long)i * G + c; if (L >= nwg) return false;
        int wgid = (int)L; { const int q = nwg / NXCD, r = nwg % NXCD, xcd = wgid % NXCD, off = wgid / NXCD; wgid = (xcd < r ? xcd * (q + 1) : r * (q + 1) + (xcd - r) * q) + off; }
        const int nig = WGM * nN, gid = wgid / nig, fm = gid * WGM, gsz = (nM - fm) < WGM ? (nM - fm) : WGM;
        u.pm = fm + ((wgid % nig) % gsz); u.pn = (wgid % nig) / gsz; return true;
    }
    __device__ __forceinline__ void a_ready(const Unit&) const {}
    __device__ __forceinline__ void done(const Unit&) const {}
};

__device__ __forceinline__ unsigned cvt_pk_bf16(float lo, float hi) { unsigned r; asm volatile("v_cvt_pk_bf16_f32 %0, %1, %2" : "=v"(r) : "v"(lo), "v"(hi)); return r; }
typedef float f32x2 __attribute__((ext_vector_type(2)));
template <class Epi, class Sched, bool ALIGN_EPI = false, bool SP2 = false>
__device__ __forceinline__ void gemm_phase(PG8_LAS unsigned char* lds, const Gemm g, const Sched& S, const Epi& E) {
    int tid_o = threadIdx.x; asm volatile("" : "+v"(tid_o));
    const int tid = tid_o, wid = __builtin_amdgcn_readfirstlane(tid >> 6), lane = tid & 63, wr = wid >> 2, wc = wid & 3, fr = lane & 15, fq = lane >> 4;
    const int K = g.K, nt = K / BK;
    unsigned voffA[2], voffB[2];
#pragma unroll
    for (int i = 0; i < 2; ++i) { int R, C; stage_rc(tid * 16 + i * 8192, R, C); const int Rb = Epi::PERM ? ((R & ~31) + perm32(R & 31)) : R;
        voffA[i] = (unsigned)(R * K + C) * 2u; voffB[i] = (unsigned)(Rb * K + C) * 2u; }
    const size_t kstep = (size_t)(BK * 2);
    const size_t hstep = (size_t)HALF * K * 2;
    const size_t tstep = 2 * hstep;
    const unsigned ldsw = (unsigned)wid * 1024u;
    const int aoff = lds_byte(wr * 64 + fr, fq * 8), boff = lds_byte(wc * 32 + fr, fq * 8);
#define PG8_SA(b, h) (((b) * 2 + (h)) * HTB)
#define PG8_SB(b, h) ((4 + (b) * 2 + (h)) * HTB)
#define PG8_STAGE(bufoff, gbase, voff) do { _Pragma("unroll") for (int _i = 0; _i < 2; ++_i) \
        __builtin_amdgcn_global_load_lds((const unsigned*)((const char*)(gbase) + (voff)[_i]), (PG8_LAS unsigned*)(lds + (bufoff) + ldsw + _i * 8192), 16, 0, 0); } while (0)
#define PG8_LDA(dst, b, h) do { _Pragma("unroll") for (int m = 0; m < 4; ++m) _Pragma("unroll") for (int k = 0; k < 2; ++k) dst[m][k] = *(const PG8_LAS bf16x8*)(lds + PG8_SA(b, h) + aoff + m * 2048 + k * 1024); } while (0)
#define PG8_LDB(dst, b, h) do { _Pragma("unroll") for (int n = 0; n < 2; ++n) _Pragma("unroll") for (int k = 0; k < 2; ++k) dst[n][k] = *(const PG8_LAS bf16x8*)(lds + PG8_SB(b, h) + boff + n * 2048 + k * 1024); } while (0)
#define PG8_MMA(ai, bj, At, Bt) do { __builtin_amdgcn_s_setprio(1); _Pragma("unroll") for (int m = 0; m < 4; ++m) _Pragma("unroll") for (int n = 0; n < 2; ++n) _Pragma("unroll") for (int k = 0; k < 2; ++k) \
        acc[ai][bj][m][n] = __builtin_amdgcn_mfma_f32_16x16x32_bf16(Bt[n][k], At[m][k], acc[ai][bj][m][n], 0, 0, 0); __builtin_amdgcn_s_setprio(0); } while (0)
#define PG8_WAIT_V(n) asm volatile("s_waitcnt vmcnt(" #n ")" ::: "memory")
#define PG8_WAIT_L(n) asm volatile("s_waitcnt lgkmcnt(" #n ")" ::: "memory")
#define PG8_BAR __builtin_amdgcn_s_barrier()
#define PG8_SCHED __builtin_amdgcn_sched_barrier(0)
    Unit cur, nxt; int ui = 0;
    if (!S.next(0, cur)) return;
    f32x4 acc[2][2][4][2];
#pragma unroll
    for (int a = 0; a < 2; ++a)
#pragma unroll
        for (int b = 0; b < 2; ++b)
#pragma unroll
            for (int m = 0; m < 4; ++m)
#pragma unroll
                for (int n = 0; n < 2; ++n) acc[a][b][m][n] = (f32x4){0.f, 0.f, 0.f, 0.f};
    bf16x8 At[4][2], B0[2][2], B1[2][2];
    const char* cA = (const char*)g.A + (size_t)cur.pm * tstep; const char* cB = (const char*)g.Bt + (size_t)cur.pn * tstep;
    S.a_ready(cur);
    if constexpr (SP2) {
        PG8_STAGE(PG8_SB(0, 0), cB, voffB); PG8_STAGE(PG8_SB(0, 1), cB + hstep, voffB); PG8_STAGE(PG8_SA(0, 0), cA, voffA); PG8_STAGE(PG8_SA(0, 1), cA + hstep, voffA);
        if (wr == 1) PG8_BAR;
        PG8_WAIT_V(2); PG8_BAR;
        PG8_STAGE(PG8_SB(1, 0), cB + kstep, voffB); PG8_STAGE(PG8_SA(1, 0), cA + kstep, voffA); PG8_STAGE(PG8_SB(1, 1), cB + hstep + kstep, voffB);
        PG8_WAIT_V(6); PG8_BAR;
    } else {
        PG8_STAGE(PG8_SB(0, 0), cB, voffB); PG8_STAGE(PG8_SA(0, 0), cA, voffA); PG8_STAGE(PG8_SB(0, 1), cB + hstep, voffB); PG8_STAGE(PG8_SA(0, 1), cA + hstep, voffA);
        if (wr == 1) PG8_BAR;
        PG8_WAIT_V(4); PG8_BAR;
        PG8_STAGE(PG8_SB(1, 0), cB + kstep, voffB); PG8_STAGE(PG8_SA(1, 0), cA + kstep, voffA); PG8_STAGE(PG8_SB(1, 1), cB + hstep + kstep, voffB);
        PG8_WAIT_V(6); PG8_BAR;
    }
    for (;;) {
        const bool has_next = S.next(ui + 1, nxt);
        const char* nA = has_next ? (const char*)g.A + (size_t)nxt.pm * tstep : cA; const char* nB = has_next ? (const char*)g.Bt + (size_t)nxt.pn * tstep : cB;
        for (int t = 0; t < nt; t += 2) {
            const bool last = (t == nt - 2);
            const char* a1 = cA + (size_t)(t + 1) * kstep;
            const char* a2 = last ? nA : cA + (size_t)(t + 2) * kstep; const char* b2 = last ? nB : cB + (size_t)(t + 2) * kstep;
            const char* a3 = a2 + kstep; const char* b3 = b2 + kstep;
            if (last && has_next) S.a_ready(nxt);
            if constexpr (SP2) {
            PG8_LDB(B0, 0, 0); PG8_LDB(B1, 0, 1); PG8_SCHED; PG8_LDA(At, 0, 0); PG8_STAGE(PG8_SA(1, 1), a1 + hstep, voffA);
            PG8_WAIT_V(8); PG8_WAIT_L(0); PG8_BAR; PG8_MMA(0, 0, At, B0); PG8_MMA(0, 1, At, B1); PG8_BAR; PG8_SCHED;
            PG8_LDA(At, 0, 1); PG8_STAGE(PG8_SB(0, 0), b2, voffB); PG8_STAGE(PG8_SB(0, 1), b2 + hstep, voffB); PG8_STAGE(PG8_SA(0, 0), a2, voffA);
            PG8_WAIT_V(8); PG8_WAIT_L(0); PG8_BAR; PG8_MMA(1, 0, At, B0); PG8_MMA(1, 1, At, B1); PG8_BAR; PG8_SCHED;
            PG8_LDB(B0, 1, 0); PG8_LDB(B1, 1, 1); PG8_SCHED; PG8_LDA(At, 1, 0); PG8_STAGE(PG8_SA(0, 1), a2 + hstep, voffA);
            PG8_WAIT_V(8); PG8_WAIT_L(0); PG8_BAR; PG8_MMA(0, 0, At, B0); PG8_MMA(0, 1, At, B1); PG8_BAR; PG8_SCHED;
            PG8_LDA(At, 1, 1); PG8_STAGE(PG8_SB(1, 0), b3, voffB); PG8_STAGE(PG8_SB(1, 1), b3 + hstep, voffB); PG8_STAGE(PG8_SA(1, 0), a3, voffA);
            PG8_WAIT_V(8); PG8_WAIT_L(0); PG8_BAR; PG8_MMA(1, 0, At, B0); PG8_MMA(1, 1, At, B1); PG8_BAR; PG8_SCHED;
            } else {
            PG8_LDB(B0, 0, 0); PG8_SCHED; PG8_LDA(At, 0, 0); PG8_STAGE(PG8_SA(1, 1), a1 + hstep, voffA);
            PG8_WAIT_L(8); PG8_BAR; PG8_WAIT_L(0); PG8_MMA(0, 0, At, B0); PG8_BAR; PG8_SCHED;
            PG8_LDB(B1, 0, 1); PG8_STAGE(PG8_SB(0, 0), b2, voffB);
            PG8_BAR; PG8_WAIT_L(0); PG8_MMA(0, 1, At, B1); PG8_BAR;
            PG8_LDA(At, 0, 1); PG8_STAGE(PG8_SA(0, 0), a2, voffA);
            PG8_BAR; PG8_WAIT_L(0); PG8_MMA(1, 0, At, B0); PG8_BAR; PG8_SCHED;
            PG8_STAGE(PG8_SB(0, 1), b2 + hstep, voffB);
            PG8_WAIT_V(6); PG8_BAR; PG8_MMA(1, 1, At, B1); PG8_BAR;
            PG8_LDB(B0, 1, 0); PG8_SCHED; PG8_LDA(At, 1, 0); PG8_STAGE(PG8_SA(0, 1), a2 + hstep, voffA);
            PG8_WAIT_L(8); PG8_BAR; PG8_WAIT_L(0); PG8_MMA(0, 0, At, B0); PG8_BAR; PG8_SCHED;
            PG8_LDB(B1, 1, 1); PG8_STAGE(PG8_SB(1, 0), b3, voffB);
            PG8_BAR; PG8_WAIT_L(0); PG8_MMA(0, 1, At, B1); PG8_BAR;
            PG8_LDA(At, 1, 1); PG8_STAGE(PG8_SA(1, 0), a3, voffA);
            PG8_BAR; PG8_WAIT_L(0); PG8_MMA(1, 0, At, B0); PG8_BAR; PG8_SCHED;
            PG8_STAGE(PG8_SB(1, 1), b3 + hstep, voffB);
            PG8_WAIT_V(6); PG8_BAR; PG8_MMA(1, 1, At, B1); PG8_BAR;
            }
        }
        if constexpr (ALIGN_EPI) { if (wr == 0) PG8_BAR; }
        if constexpr (!Epi::AFTER_DRAIN) { E(acc, cur, wr, wc, fr, fq); S.done(cur); }
        if (!has_next) break;
#pragma unroll
        for (int a = 0; a < 2; ++a)
#pragma unroll
            for (int b = 0; b < 2; ++b)
#pragma unroll
                for (int m = 0; m < 4; ++m)
#pragma unroll
                    for (int n = 0; n < 2; ++n) acc[a][b][m][n] = (f32x4){0.f, 0.f, 0.f, 0.f};
        cur = nxt; cA = nA; cB = nB; ++ui;
        if constexpr (ALIGN_EPI) { if (wr == 1) PG8_BAR; }
    }
    PG8_WAIT_V(0);
    if constexpr (!ALIGN_EPI) { if (wr == 0) PG8_BAR; }
    PG8_BAR;
    if constexpr (Epi::AFTER_DRAIN) { E.fused(acc, cur, wr, wc, fr, fq, lds, wid, lane); S.done(cur); }
#undef PG8_SA
#undef PG8_SB
#undef PG8_STAGE
#undef PG8_LDA
#undef PG8_LDB
#undef PG8_MMA
#undef PG8_WAIT_V
#undef PG8_WAIT_L
#undef PG8_BAR
#undef PG8_SCHED
}
}

#define LAS __attribute__((address_space(3)))
typedef unsigned short bf16_t;
typedef short bf16x8 __attribute__((ext_vector_type(8)));
typedef short s16x4 __attribute__((ext_vector_type(4)));
typedef float f32x4 __attribute__((ext_vector_type(4)));
typedef unsigned u32x4 __attribute__((ext_vector_type(4)));
typedef unsigned u32x2 __attribute__((ext_vector_type(2)));

constexpr int T_ = 8192, D_ = 2048, FF_ = 5632, NIN_ = 15408, LDY = 15616, NADA = 18432;
constexpr int OFF_Q = 0, OFF_KV = 2048, OFF_QR = 5120, OFF_KR = 6144, OFF_VR = 7168, OFF_GR = 9216, OFF_GA = 11264, OFF_GB = 13312, OFF_GL = 15360;
constexpr float LOG2E = 1.4426950408889634f;
constexpr float EPS_ = 1e-6f;

constexpr size_t al256(size_t x) { return (x + 255) & ~(size_t)255; }
constexpr size_t WS_CTL = 0;
constexpr size_t WS_ADA = 4096;
constexpr size_t WS_WGU = al256(WS_ADA + (size_t)4 * NADA * 4);
constexpr size_t WS_WD  = WS_WGU + (size_t)2 * FF_ * D_ * 2;
constexpr size_t WS_WIN = WS_WD + (size_t)D_ * FF_ * 2;
constexpr size_t WS_WPN = WS_WIN + (size_t)LDY * D_ * 2;
constexpr size_t WS_WPR = WS_WPN + (size_t)D_ * D_ * 2;
constexpr size_t WS_WO  = WS_WPR + (size_t)D_ * D_ * 2;
constexpr size_t WS_WC1 = WS_WO + (size_t)D_ * D_ * 2;
constexpr size_t WS_WC2 = WS_WC1 + (size_t)2 * 128 * 4096 * 2;
constexpr size_t WS_H   = WS_WC2 + (size_t)2 * 128 * 128 * 2;
constexpr size_t WS_Y   = WS_H + (size_t)T_ * D_ * 2;
constexpr size_t WS_MG  = WS_Y + (size_t)T_ * LDY * 2;
constexpr size_t WS_ORET = WS_MG + (size_t)T_ * D_ * 2;
constexpr size_t WS_VTS = WS_ORET + (size_t)T_ * D_ * 2;
constexpr size_t WS_VTW = WS_VTS + (size_t)16 * 128 * 2048 * 2;
constexpr size_t WS_VTR = WS_VTW + (size_t)16 * 128 * 2048 * 2;
constexpr size_t WS_KC  = WS_VTR + (size_t)32 * 256 * 2048 * 2;
constexpr size_t WS_VCT = WS_KC + (size_t)16 * 128 * 128 * 2;
constexpr size_t WS_KS  = WS_VCT + (size_t)16 * 128 * 128 * 2;
constexpr size_t WS_KW  = WS_KS + (size_t)16 * 2048 * 128 * 2;
constexpr size_t WS_KR  = WS_KW + (size_t)16 * 2048 * 128 * 2;
constexpr size_t WS_SM  = WS_KR + (size_t)32 * 2048 * 128 * 2;
constexpr size_t WS_END = WS_SM + (size_t)16 * 2048 * 4;

constexpr int LDS_BYTES = 131072 + 2048;

using pg8::cvt_pk_bf16;
__device__ __forceinline__ float bf_lo(unsigned w) { return __uint_as_float(w << 16); }
__device__ __forceinline__ float bf_hi(unsigned w) { return __uint_as_float(w & 0xffff0000u); }
__device__ __forceinline__ float bf2f(bf16_t h) { return __uint_as_float((unsigned)h << 16); }
__device__ __forceinline__ float ex2(float x) { return __builtin_amdgcn_exp2f(x); }
__device__ __forceinline__ float sigmoid_f(float x) { return __builtin_amdgcn_rcpf(1.0f + ex2(-x * LOG2E)); }
__device__ __forceinline__ float silu_f(float x) { return x * sigmoid_f(x); }
__device__ __forceinline__ float wave_sum(float v) {
#pragma unroll
    for (int o = 1; o < 64; o <<= 1) v += __shfl_xor(v, o);
    return v;
}
#define MFMA16(a, b, c) __builtin_amdgcn_mfma_f32_16x16x32_bf16((a), (b), (c), 0, 0, 0)
__device__ __forceinline__ float rowred_max(float x) {
    auto a = __builtin_amdgcn_permlane16_swap(__float_as_uint(x), __float_as_uint(x), false, false);
    x = fmaxf(__uint_as_float(a[0]), __uint_as_float(a[1]));
    auto b = __builtin_amdgcn_permlane32_swap(__float_as_uint(x), __float_as_uint(x), false, false);
    return fmaxf(__uint_as_float(b[0]), __uint_as_float(b[1]));
}
__device__ __forceinline__ float rowred_sum(float x) {
    auto a = __builtin_amdgcn_permlane16_swap(__float_as_uint(x), __float_as_uint(x), false, false);
    x = __uint_as_float(a[0]) + __uint_as_float(a[1]);
    auto b = __builtin_amdgcn_permlane32_swap(__float_as_uint(x), __float_as_uint(x), false, false);
    return __uint_as_float(b[0]) + __uint_as_float(b[1]);
}

struct EpiSwiglu {
    static constexpr bool PERM = true, AFTER_DRAIN = false;
    bf16_t* O;
    __device__ __forceinline__ void operator()(const f32x4 (&acc)[2][2][4][2], const pg8::Unit& u, int wr, int wc, int fr, int fq) const {
        const int row0 = u.pm * 256 + wr * 64 + fr, col0 = u.pn * 128 + wc * 32 + 8 * fq;
#pragma unroll
        for (int ai = 0; ai < 2; ++ai)
#pragma unroll
            for (int m = 0; m < 4; ++m) {
                bf16_t* rowp = O + (size_t)(row0 + ai * 128 + m * 16) * FF_ + col0;
                const f32x4 g0 = acc[ai][0][m][0], g1 = acc[ai][0][m][1], u0 = acc[ai][1][m][0], u1 = acc[ai][1][m][1];
                u32x4 w;
                w.x = cvt_pk_bf16(silu_f(g0[0]) * u0[0], silu_f(g0[1]) * u0[1]);
                w.y = cvt_pk_bf16(silu_f(g0[2]) * u0[2], silu_f(g0[3]) * u0[3]);
                w.z = cvt_pk_bf16(silu_f(g1[0]) * u1[0], silu_f(g1[1]) * u1[1]);
                w.w = cvt_pk_bf16(silu_f(g1[2]) * u1[2], silu_f(g1[3]) * u1[3]);
                *(u32x4*)rowp = w;
            }
    }
};
struct EpiResid {
    static constexpr bool PERM = false, AFTER_DRAIN = false;
    const float* base; float* out; const float* gate; float coef;
    __device__ __forceinline__ void operator()(const f32x4 (&acc)[2][2][4][2], const pg8::Unit& u, int wr, int wc, int fr, int fq) const {
        const int row0 = u.pm * 256 + wr * 64 + fr, col0 = u.pn * 256 + wc * 32 + 4 * fq, b = u.pm >> 3;
        f32x4 gv[2][2];
#pragma unroll
        for (int bj = 0; bj < 2; ++bj)
#pragma unroll
            for (int n = 0; n < 2; ++n) gv[bj][n] = *(const f32x4*)(gate + (size_t)b * NADA + col0 + bj * 128 + n * 16) * coef;
#pragma unroll
        for (int ai = 0; ai < 2; ++ai)
#pragma unroll
            for (int m = 0; m < 4; ++m) {
                const size_t off = (size_t)(row0 + ai * 128 + m * 16) * D_ + col0;
#pragma unroll
                for (int bj = 0; bj < 2; ++bj)
#pragma unroll
                    for (int n = 0; n < 2; ++n) {
                        const size_t o = off + bj * 128 + n * 16;
                        *(f32x4*)(out + o) = *(const f32x4*)(base + o) + gv[bj][n] * acc[ai][bj][m][n];
                    }
            }
    }
};
struct EpiY {
    static constexpr bool PERM = true, AFTER_DRAIN = false;
    bf16_t* O;
    __device__ __forceinline__ void operator()(const f32x4 (&acc)[2][2][4][2], const pg8::Unit& u, int wr, int wc, int fr, int fq) const {
        const int row0 = u.pm * 256 + wr * 64 + fr, col0 = u.pn * 256 + wc * 32 + 8 * fq;
#pragma unroll
        for (int ai = 0; ai < 2; ++ai)
#pragma unroll
            for (int m = 0; m < 4; ++m) {
                bf16_t* rowp = O + (size_t)(row0 + ai * 128 + m * 16) * LDY + col0;
#pragma unroll
                for (int bj = 0; bj < 2; ++bj) {
                    const f32x4 v0 = acc[ai][bj][m][0], v1 = acc[ai][bj][m][1];
                    u32x4 w; w.x = cvt_pk_bf16(v0[0], v0[1]); w.y = cvt_pk_bf16(v0[2], v0[3]); w.z = cvt_pk_bf16(v1[0], v1[1]); w.w = cvt_pk_bf16(v1[2], v1[3]);
                    *(u32x4*)(rowp + bj * 128) = w;
                }
            }
    }
};
template <bool ADD> struct EpiMerge {
    static constexpr bool PERM = true, AFTER_DRAIN = false;
    bf16_t* O; const bf16_t* Yg; int goff;
    __device__ __forceinline__ void operator()(const f32x4 (&acc)[2][2][4][2], const pg8::Unit& u, int wr, int wc, int fr, int fq) const {
        const int row0 = u.pm * 256 + wr * 64 + fr, col0 = u.pn * 256 + wc * 32 + 8 * fq;
#pragma unroll
        for (int ai = 0; ai < 2; ++ai)
#pragma unroll
            for (int m = 0; m < 4; ++m) {
                const int row = row0 + ai * 128 + m * 16;
#pragma unroll
                for (int bj = 0; bj < 2; ++bj) {
                    const int col = col0 + bj * 128;
                    const u32x4 gw = *(const u32x4*)(Yg + (size_t)row * LDY + goff + col);
                    const f32x4 v0 = acc[ai][bj][m][0], v1 = acc[ai][bj][m][1];
                    float r[8];
                    r[0] = sigmoid_f(bf_lo(gw.x)) * v0[0]; r[1] = sigmoid_f(bf_hi(gw.x)) * v0[1];
                    r[2] = sigmoid_f(bf_lo(gw.y)) * v0[2]; r[3] = sigmoid_f(bf_hi(gw.y)) * v0[3];
                    r[4] = sigmoid_f(bf_lo(gw.z)) * v1[0]; r[5] = sigmoid_f(bf_hi(gw.z)) * v1[1];
                    r[6] = sigmoid_f(bf_lo(gw.w)) * v1[2]; r[7] = sigmoid_f(bf_hi(gw.w)) * v1[3];
                    bf16_t* op = O + (size_t)row * D_ + col;
                    if (ADD) {
                        const u32x4 pw = *(const u32x4*)op;
                        r[0] += bf_lo(pw.x); r[1] += bf_hi(pw.x); r[2] += bf_lo(pw.y); r[3] += bf_hi(pw.y);
                        r[4] += bf_lo(pw.z); r[5] += bf_hi(pw.z); r[6] += bf_lo(pw.w); r[7] += bf_hi(pw.w);
                    }
                    u32x4 w; w.x = cvt_pk_bf16(r[0], r[1]); w.y = cvt_pk_bf16(r[2], r[3]); w.z = cvt_pk_bf16(r[4], r[5]); w.w = cvt_pk_bf16(r[6], r[7]);
                    *(u32x4*)op = w;
                }
            }
    }
};

__device__ __forceinline__ int rowmap(int mode, int n) {
    if (mode == 0) return n;
    if (mode == 1) return ((n >> 7) << 8) + (n & 127);
    if (mode == 2) return ((n >> 7) << 8) + 128 + (n & 127);
    return n < 5120 ? n : (n < 5168 ? OFF_GL + (n - 5120) : n - 48);
}
__device__ __forceinline__ void norm_rows(const float* __restrict__ X, const float* __restrict__ g, const float* __restrict__ ada, int ish, int isc, bf16_t* __restrict__ H, int gw, int NGW, int lane) {
    for (int m = gw; m < T_; m += NGW) {
        const int b = m >> 11;
        const f32x4* xr = (const f32x4*)(X + (size_t)m * D_) + lane;
        f32x4 v[8]; float ss = 0.f;
#pragma unroll
        for (int j = 0; j < 8; ++j) { v[j] = xr[64 * j]; ss += (v[j].x * v[j].x + v[j].y * v[j].y) + (v[j].z * v[j].z + v[j].w * v[j].w); }
        const float r = 1.0f / sqrtf(wave_sum(ss) * (1.0f / D_) + EPS_);
        const f32x4* gp = (const f32x4*)g + lane;
        const f32x4* sh = (const f32x4*)(ada + (size_t)b * NADA + ish * D_) + lane;
        const f32x4* sc = (const f32x4*)(ada + (size_t)b * NADA + isc * D_) + lane;
        u32x2* o = (u32x2*)(H + (size_t)m * D_) + lane;
#pragma unroll
        for (int j = 0; j < 8; ++j) {
            const f32x4 y = v[j] * r * gp[64 * j] * (sc[64 * j] + 1.0f) + sh[64 * j];
            u32x2 w; w.x = cvt_pk_bf16(y.x, y.y); w.y = cvt_pk_bf16(y.z, y.w); o[64 * j] = w;
        }
    }
}

#ifndef VPRE
#define VPRE 4
#endif
__device__ __forceinline__ void att_kdma(const bf16_t* __restrict__ Kf, int k0, int lane8, LAS unsigned char* ring) {
    const bf16_t* kb = Kf + (size_t)(k0 >> 4) * 2048 + lane8;
#pragma unroll
    for (int s8 = 0; s8 < 8; ++s8) __builtin_amdgcn_global_load_lds((const unsigned*)(kb + s8 * 512), (LAS unsigned*)(ring + s8 * 1024), 16, 0, 0);
}
template <int NR, int NDT, int MODE>
__device__ __forceinline__ void att_step(const bf16_t* __restrict__ Kf, const bf16_t* __restrict__ Vf, int k0, int k0n  , int tq  , int lane8  ,
                                         const LAS bf16x8* qs, LAS unsigned char* ring, int lane, f32x4 (&O)[NR][NDT], float (&m)[NR], float (&l)[NR], const float (&coef)[NR], bool vblk, bool full = false) {
    constexpr float SC = 0.08838834764831845f;
    const bf16_t* vb = Vf + (size_t)(k0 >> 5) * (NDT * 512) + lane8;
    const int dq = tq - k0;
    asm volatile("s_waitcnt vmcnt(0)" ::: "memory");
    bf16x8 vfr[NDT];
#pragma unroll
    for (int dt = 0; dt < NDT; ++dt) vfr[dt] = *(const bf16x8*)(vb + dt * 512);
    f32x4 sa[NR][2];
    const LAS bf16x8* kr = (const LAS bf16x8*)ring + lane;
#pragma unroll
    for (int kt = 0; kt < 2; ++kt) {
#pragma unroll
        for (int r = 0; r < NR; ++r) { sa[r][kt] = (f32x4){0.f, 0.f, 0.f, 0.f};
#pragma unroll
            for (int dc = 0; dc < 4; ++dc) sa[r][kt] = MFMA16(kr[(kt * 4 + dc) * 64], qs[(r * 4 + dc) * 64], sa[r][kt]); }
    }
    asm volatile("s_waitcnt lgkmcnt(0)" ::: "memory");
    __builtin_amdgcn_sched_barrier(0);
    if (k0n >= 0) att_kdma(Kf, k0n, lane8, ring);
    __builtin_amdgcn_sched_barrier(0);
    bf16x8 Pb[NR];
    const float dqf = (float)dq;
#pragma unroll
    for (int r = 0; r < NR; ++r) {
        f32x4 s[2]; s[0] = sa[r][0]; s[1] = sa[r][1];
        float p[2][4];
        if (MODE == 2) {
#pragma unroll
            for (int kt = 0; kt < 2; ++kt)
#pragma unroll
                for (int j = 0; j < 4; ++j) { const bool valid = dq >= (16 * kt + j); p[kt][j] = valid ? s[kt][j] * SC * ex2(coef[r] * (dqf - (float)(16 * kt + j))) : 0.f; }
        } else {
            float mx = -INFINITY;
            const float base = -coef[r] * dqf;
            if (full) {
#pragma unroll
                for (int kt = 0; kt < 2; ++kt)
#pragma unroll
                    for (int j = 0; j < 4; ++j) { const float v = fmaf(coef[r], (float)(16 * kt + j), fmaf(s[kt][j], SC * LOG2E, base)); p[kt][j] = v; mx = fmaxf(mx, v); }
            } else {
#pragma unroll
                for (int kt = 0; kt < 2; ++kt)
#pragma unroll
                    for (int j = 0; j < 4; ++j) {
                        const bool valid = (MODE == 0) ? (vblk && dq >= (16 * kt + j)) : (dq >= (16 * kt + j) && dq < 512 + (16 * kt + j));
                        const float v = valid ? fmaf(coef[r], (float)(16 * kt + j), fmaf(s[kt][j], SC * LOG2E, base)) : -INFINITY;
                        p[kt][j] = v; mx = fmaxf(mx, v);
                    }
            }
            mx = rowred_max(mx);
            const float mnew = (mx - m[r] > 8.0f) ? mx : m[r], muse = (mnew == -INFINITY) ? 0.f : mnew;
            float ps = 0.f;
#pragma unroll
            for (int kt = 0; kt < 2; ++kt)
#pragma unroll
                for (int j = 0; j < 4; ++j) { p[kt][j] = ex2(p[kt][j] - muse); ps += p[kt][j]; }
#ifdef ALWAYS_RESCALE
            {
#else
            if (__ballot(mnew != m[r]) != 0ull) {
#endif
                const float alpha = ex2(m[r] - muse);
                l[r] *= alpha;
#pragma unroll
                for (int dt = 0; dt < NDT; ++dt) O[r][dt] *= alpha;
            }
            l[r] += ps; m[r] = mnew;
        }
        u32x4 pw; pw.x = cvt_pk_bf16(p[0][0], p[0][1]); pw.y = cvt_pk_bf16(p[0][2], p[0][3]); pw.z = cvt_pk_bf16(p[1][0], p[1][1]); pw.w = cvt_pk_bf16(p[1][2], p[1][3]);
        Pb[r] = __builtin_bit_cast(bf16x8, pw);
    }
#pragma unroll
    for (int dt = 0; dt < NDT; ++dt) {
#pragma unroll
        for (int r = 0; r < NR; ++r) O[r][dt] = MFMA16(vfr[dt], Pb[r], O[r][dt]);
        if ((dt & 3) == 3) __builtin_amdgcn_sched_barrier(0);
    }
}

struct MixPtrs { const bf16_t* Y; bf16_t* ONSA; bf16_t* ORET; const bf16_t* VTS; const bf16_t* VTW; const bf16_t* VTR; const bf16_t* KC; const bf16_t* VCT; const float* gn; const bf16_t* KS; const bf16_t* KW; const bf16_t* KR; };

__device__ __forceinline__ void cmp_unit(const MixPtrs& P, unsigned* __restrict__ SM, int bg, int grp, LAS unsigned char* lds, int tid) {
    const int lane = tid & 63, wave = __builtin_amdgcn_readfirstlane(tid >> 6), l15 = lane & 15, fq = lane >> 4;
    const int b = bg >> 2, g = bg & 3, t0 = (grp * 8 + wave) * 16, t = t0 + l15;
#pragma unroll
    for (int i = 0; i < 8; ++i) {
        const int blk = wave * 8 + i;
        const bf16_t* src = (blk < 32 ? P.KC + (size_t)bg * 16384 + blk * 512 : P.VCT + (size_t)bg * 16384 + (blk - 32) * 512) + lane * 8;
        __builtin_amdgcn_global_load_lds((const unsigned*)src, (LAS unsigned*)(lds + blk * 1024), 16, 0, 0);
    }
    const bf16_t* Yt = P.Y + (size_t)(b * 2048 + t) * LDY;
    bf16_t* orow = P.ONSA + (size_t)(b * 2048 + t) * D_;
    constexpr float SC2 = 0.08838834764831845f * LOG2E;
    const int tq64 = t - 64 * fq; const float tq64f = (float)tq64 - 15.5f;
    const LAS bf16x8* kl = (const LAS bf16x8*)lds + lane;
    const LAS bf16x8* vl = (const LAS bf16x8*)(lds + 32768) + lane;
    float pown[8], ptail[8];
#pragma unroll
    for (int kt = 0; kt < 8; ++kt) { pown[kt] = 0.f; ptail[kt] = 0.f; }
    asm volatile("s_waitcnt vmcnt(0)" ::: "memory");
    __syncthreads();
#pragma unroll 1
    for (int hd = 0; hd < 4; ++hd) {
        const int hh = 4 * g + hd;
        bf16x8 Qf[4];
#pragma unroll
        for (int dc = 0; dc < 4; ++dc) Qf[dc] = *(const bf16x8*)(Yt + OFF_Q + hh * 128 + 32 * dc + 8 * fq);
        const float gate = sigmoid_f(bf2f(Yt[OFF_GL + hh]));
        f32x4 s[8];
#pragma unroll
        for (int kt = 0; kt < 8; ++kt) { s[kt] = (f32x4){0.f, 0.f, 0.f, 0.f};
#pragma unroll
            for (int dc = 0; dc < 4; ++dc) s[kt] = MFMA16(kl[(kt * 4 + dc) * 64], Qf[dc], s[kt]); }
        const float slope2 = ex2(-0.5f * (float)(hh + 1)) * LOG2E;
        float mx = -INFINITY;
#pragma unroll
        for (int kt = 0; kt < 8; ++kt)
#pragma unroll
            for (int j = 0; j < 4; ++j) {
                const bool valid = (256 * kt + 16 * j + 31) <= tq64;
                const float v = valid ? s[kt][j] * SC2 - slope2 * (tq64f - (float)(256 * kt + 16 * j)) : -INFINITY;
                s[kt][j] = v; mx = fmaxf(mx, v);
            }
        mx = rowred_max(mx);
        const float muse = (mx == -INFINITY) ? 0.f : mx;
        float ls = 0.f;
#pragma unroll
        for (int kt = 0; kt < 8; ++kt)
#pragma unroll
            for (int j = 0; j < 4; ++j) { const float pv = ex2(s[kt][j] - muse); s[kt][j] = pv; ls += pv; }
        ls = rowred_sum(ls);
        const float inv = 1.0f / fmaxf(ls, 1.17549435e-38f);
#pragma unroll
        for (int kt = 0; kt < 8; ++kt)
#pragma unroll
            for (int j = 0; j < 4; ++j) s[kt][j] *= inv;
#pragma unroll
        for (int kt = 0; kt < 8; ++kt) { const float h3 = 0.5f * s[kt][3]; ptail[kt] += h3; pown[kt] += ((s[kt][0] + s[kt][1]) + s[kt][2]) + h3; }
        f32x4 O[8];
#pragma unroll
        for (int dt = 0; dt < 8; ++dt) O[dt] = (f32x4){0.f, 0.f, 0.f, 0.f};
#pragma unroll
        for (int ks = 0; ks < 4; ++ks) {
            u32x4 pw; pw.x = cvt_pk_bf16(s[2 * ks][0], s[2 * ks][1]); pw.y = cvt_pk_bf16(s[2 * ks][2], s[2 * ks][3]);
            pw.z = cvt_pk_bf16(s[2 * ks + 1][0], s[2 * ks + 1][1]); pw.w = cvt_pk_bf16(s[2 * ks + 1][2], s[2 * ks + 1][3]);
            const bf16x8 Pb = __builtin_bit_cast(bf16x8, pw);
#pragma unroll
            for (int dt = 0; dt < 8; ++dt) O[dt] = MFMA16(vl[(ks * 8 + dt) * 64], Pb, O[dt]);
        }
#pragma unroll
        for (int dt = 0; dt < 8; ++dt) {
            u32x2 w; w.x = cvt_pk_bf16(O[dt][0] * gate, O[dt][1] * gate); w.y = cvt_pk_bf16(O[dt][2] * gate, O[dt][3] * gate);
            *(u32x2*)(orow + hh * 128 + 16 * dt + 4 * fq) = w;
        }
    }
    {
        float val[8], sh[8];
        const int bq = (t >> 6) - fq;
#pragma unroll
        for (int kt = 0; kt < 8; ++kt) sh[kt] = __shfl(ptail[kt], (lane + 48) & 63);
#pragma unroll
        for (int kt = 0; kt < 8; ++kt) {
            const float prev = fq > 0 ? sh[kt] : (kt > 0 ? sh[kt > 0 ? kt - 1 : 0] : 0.f);
            const float imp = pown[kt] + prev;
            const bool forced = (kt == 0 && fq == 0) || (4 * kt == bq) || (4 * kt == bq - 1);
            val[kt] = forced ? 1e4f : (4 * kt <= bq ? imp : -1e4f);
        }
        int cnt[8];
#pragma unroll
        for (int kt = 0; kt < 8; ++kt) cnt[kt] = 0;
#pragma unroll 1
        for (int f2 = 0; f2 < 4; ++f2) {
            const int df = fq - f2;
#pragma unroll
            for (int k2 = 0; k2 < 8; ++k2) {
                const float o = __shfl(val[k2], l15 + 16 * f2);
#pragma unroll
                for (int kt = 0; kt < 8; ++kt) cnt[kt] += ((o > val[kt]) || (o == val[kt] && (4 * (k2 - kt)) < df)) ? 1 : 0;
            }
        }
        unsigned smq = 0;
#pragma unroll
        for (int kt = 0; kt < 8; ++kt) if (cnt[kt] < 16) smq |= 1u << (4 * kt);
        unsigned sm = smq << fq;
        sm |= __shfl_xor(sm, 16); sm |= __shfl_xor(sm, 32);
        if (fq == 0) SM[bg * 2048 + t] = sm;
    }
    __syncthreads();
}

__device__ __forceinline__ void nsa_unit(const MixPtrs& P, const unsigned* __restrict__ SM, int b, int g, int tile, int hp  , int lane, LAS bf16x8* qs  , LAS unsigned char* qbase  ) {
    const int l15 = lane & 15, fq = lane >> 4, t0 = tile * 16, t = t0 + l15, bg = b * 4 + g;
    const bf16_t* Yt = P.Y + (size_t)(b * 2048 + t) * LDY;
    bf16_t* orow = P.ONSA + (size_t)(b * 2048 + t) * D_;
    const int tq = t - 4 * fq, lane8 = lane * 8;
    const unsigned sm = SM[bg * 2048 + t];
#pragma unroll
    for (int r = 0; r < 2; ++r)
#pragma unroll
        for (int dc = 0; dc < 4; ++dc) qs[(r * 4 + dc) * 64] = *(const bf16x8*)(Yt + OFF_Q + (4 * g + 2 * hp + r) * 128 + 32 * dc + 8 * fq);
    {
        float coef[2], m[2], l[2]; f32x4 O[2][8];
        const LAS bf16x8* Qf = qs;
        LAS unsigned char* ring = qbase + 8192;
#pragma unroll
        for (int r = 0; r < 2; ++r) coef[r] = ex2(-0.5f * (float)(4 * g + 2 * hp + r + 1)) * LOG2E;
        asm volatile("s_waitcnt lgkmcnt(0)" ::: "memory");
#pragma unroll 1
        for (int br = 1; br < 3; ++br) {
#pragma unroll
            for (int r = 0; r < 2; ++r) { m[r] = -INFINITY; l[r] = 0.f;
#pragma unroll
                for (int dt = 0; dt < 8; ++dt) O[r][dt] = (f32x4){0.f, 0.f, 0.f, 0.f}; }
            if (br == 1) {
                const bf16_t* Kp = P.KS + (size_t)bg * 262144; const bf16_t* Vt = P.VTS + (size_t)bg * 262144;
                const int blkmax = (t0 + 15) >> 6;
                unsigned U = 0;
#pragma unroll 1
                for (int jb = 0; jb <= blkmax; ++jb) if (__ballot((sm >> jb) & 1u) != 0ull) U |= 1u << jb;
                int jb = __builtin_ctz(U), k0 = 64 * jb;
                att_kdma(Kp, k0, lane8, ring);
#pragma unroll 1
                for (;;) {
                    int k0n, jbn = jb;
                    if ((k0 & 32) == 0) k0n = k0 + 32;
                    else { const unsigned rest = jb >= 31 ? 0u : (U >> (jb + 1)); if (rest == 0u) k0n = -1; else { jbn = jb + 1 + __builtin_ctz(rest); k0n = 64 * jbn; } }
                    const bool vb = (sm >> jb) & 1u;
                    const bool full = (k0 + 31 <= t0) && (__ballot(vb) == ~0ull);
                    att_step<2, 8, 0>(Kp, Vt, k0, k0n, tq, lane8, Qf, ring, lane, O, m, l, coef, vb, full);
                    if (k0n < 0) break;
                    k0 = k0n; jb = jbn;
                }
            } else {
                const bf16_t* Kp = P.KW + (size_t)bg * 262144; const bf16_t* Vt = P.VTW + (size_t)bg * 262144;
                int kstart = t0 - 511; kstart = kstart < 0 ? 0 : (kstart & ~31);
                att_kdma(Kp, kstart, lane8, ring);
#pragma unroll 1
                for (int k0 = kstart; k0 <= t0; k0 += 32) att_step<2, 8, 1>(Kp, Vt, k0, (k0 + 32 <= t0) ? k0 + 32 : -1, tq, lane8, Qf, ring, lane, O, m, l, coef, true, (k0 + 31 <= t0) && (k0 >= t0 - 496));
            }
#pragma unroll
            for (int r = 0; r < 2; ++r) {
                const int hh = 4 * g + 2 * hp + r;
                const float lt = rowred_sum(l[r]);
                const float sc = sigmoid_f(bf2f(Yt[OFF_GL + br * 16 + hh])) / fmaxf(lt, 1.17549435e-38f);
#pragma unroll
                for (int dt = 0; dt < 8; ++dt) {
                    u32x2* op = (u32x2*)(orow + hh * 128 + 16 * dt + 4 * fq);
                    const u32x2 pw = *op;
                    u32x2 w; w.x = cvt_pk_bf16(bf_lo(pw.x) + O[r][dt][0] * sc, bf_hi(pw.x) + O[r][dt][1] * sc);
                    w.y = cvt_pk_bf16(bf_lo(pw.y) + O[r][dt][2] * sc, bf_hi(pw.y) + O[r][dt][3] * sc);
                    *op = w;
                }
            }
        }
    }
}

__device__ __forceinline__ void ret_unit(const MixPtrs& P, int b, int h, int tile, int lane, LAS bf16x8* qs, LAS unsigned char* qbase) {
    const int l15 = lane & 15, fq = lane >> 4, t0 = tile * 16, t = t0 + l15;
    const bf16_t* Yb = P.Y + (size_t)(b * 2048) * LDY;
    const bf16_t* Yt = Yb + (size_t)t * LDY;
    float coef[1], m[1], l[1]; f32x4 O[1][16];
    const LAS bf16x8* Qf = qs;
#pragma unroll
    for (int dc = 0; dc < 4; ++dc) qs[dc * 64] = *(const bf16x8*)(Yt + OFF_QR + h * 128 + 32 * dc + 8 * fq);
    coef[0] = log1pf(-exp2f(-5.0f - (float)h)) * LOG2E; m[0] = 0.f; l[0] = 0.f;
#pragma unroll
    for (int dt = 0; dt < 16; ++dt) O[0][dt] = (f32x4){0.f, 0.f, 0.f, 0.f};
    const bf16_t* Kp = P.KR + (size_t)(b * 8 + h) * 262144; const bf16_t* Vt = P.VTR + (size_t)(b * 8 + h) * 524288;
    LAS unsigned char* ring = qbase + 8192;
    asm volatile("s_waitcnt lgkmcnt(0)" ::: "memory");
    att_kdma(Kp, 0, lane * 8, ring);
#pragma unroll 1
    for (int k0 = 0; k0 <= t0; k0 += 32) att_step<1, 16, 2>(Kp, Vt, k0, (k0 + 32 <= t0) ? k0 + 32 : -1, t - 4 * fq, lane * 8, Qf, ring, lane, O, m, l, coef, true);
    float sum = 0.f;
#pragma unroll
    for (int dt = 0; dt < 16; ++dt) sum += (O[0][dt][0] + O[0][dt][1]) + (O[0][dt][2] + O[0][dt][3]);
    sum = rowred_sum(sum);
    const float mean = sum * (1.0f / 256.0f);
    float var = 0.f;
#pragma unroll
    for (int dt = 0; dt < 16; ++dt) { const f32x4 d = O[0][dt] - mean; var += (d[0] * d[0] + d[1] * d[1]) + (d[2] * d[2] + d[3] * d[3]); }
    var = rowred_sum(var);
    const float rstd = 1.0f / sqrtf(var * (1.0f / 256.0f) + EPS_);
    bf16_t* orow = P.ORET + (size_t)(b * 2048 + t) * D_ + h * 256;
#pragma unroll
    for (int dt = 0; dt < 16; ++dt) {
        const int e = 16 * dt + 4 * fq;
        const f32x4 gain = *(const f32x4*)(P.gn + h * 256 + e);
        const u32x2 gw = *(const u32x2*)(Yt + OFF_GR + h * 256 + e);
        const f32x4 y = (O[0][dt] - mean) * rstd * gain;
        u32x2 w; w.x = cvt_pk_bf16(silu_f(bf_lo(gw.x)) * y[0], silu_f(bf_hi(gw.x)) * y[1]); w.y = cvt_pk_bf16(silu_f(bf_lo(gw.y)) * y[2], silu_f(bf_hi(gw.y)) * y[3]);
        *(u32x2*)(orow + e) = w;
    }
}

__device__ __forceinline__ void compress_unit(int unit, const bf16_t* __restrict__ Y, const float* __restrict__ cmp_pos, const float* __restrict__ cmp_b1, const float* __restrict__ g_qk,
                                              const bf16_t* __restrict__ WC1, const bf16_t* __restrict__ WC2, bf16_t* __restrict__ KC, bf16_t* __restrict__ VCT, LAS unsigned char* lds, int tid) {
    const int lane = tid & 63, wave = tid >> 6, l15 = lane & 15, fq = lane >> 4;
    const int i = unit >> 7, bg = (unit >> 3) & 15, ct = unit & 7, b = bg >> 2, g = bg & 3;
    const int c = 16 * ct + l15; const bool cvalid = c < 127;
    const bf16_t* Yc = Y + (size_t)(b * 2048 + 16 * (cvalid ? c : 0)) * LDY + OFF_KV + i * 512 + g * 128;
    LAS float* red = (LAS float*)lds;
    LAS bf16_t* hid = (LAS bf16_t*)(lds + 65536);
    f32x4 acc[8];
#pragma unroll
    for (int nt = 0; nt < 8; ++nt) acc[nt] = (f32x4){0.f, 0.f, 0.f, 0.f};
#pragma unroll 1
    for (int ls = 0; ls < 4; ++ls) {
        const int l = 4 * wave + ls;
#pragma unroll
        for (int dc = 0; dc < 4; ++dc) {
            const int d = 32 * dc + 8 * fq;
            u32x4 aw = (u32x4){0u, 0u, 0u, 0u};
            if (cvalid) {
                const u32x4 zw = *(const u32x4*)(Yc + (size_t)l * LDY + d);
                const f32x4 p0 = *(const f32x4*)(cmp_pos + (size_t)(i * 32 + l) * 128 + d), p1 = *(const f32x4*)(cmp_pos + (size_t)(i * 32 + l) * 128 + d + 4);
                aw.x = cvt_pk_bf16(bf_lo(zw.x) + p0[0], bf_hi(zw.x) + p0[1]); aw.y = cvt_pk_bf16(bf_lo(zw.y) + p0[2], bf_hi(zw.y) + p0[3]);
                aw.z = cvt_pk_bf16(bf_lo(zw.z) + p1[0], bf_hi(zw.z) + p1[1]); aw.w = cvt_pk_bf16(bf_lo(zw.w) + p1[2], bf_hi(zw.w) + p1[3]);
            }
            const bf16x8 a = __builtin_bit_cast(bf16x8, aw);
            const int kidx = l * 128 + 32 * dc + 8 * fq;
#pragma unroll
            for (int nt = 0; nt < 8; ++nt) { const bf16x8 bf = *(const bf16x8*)(WC1 + (size_t)i * 524288 + (size_t)(((l * 4 + dc) * 8 + nt) * 64 + lane) * 8); acc[nt] = MFMA16(a, bf, acc[nt]); }
        }
    }
#pragma unroll
    for (int nt = 0; nt < 8; ++nt)
#pragma unroll
        for (int j = 0; j < 4; ++j) red[(wave * 16 + 4 * fq + j) * 128 + 16 * nt + l15] = acc[nt][j];
    __syncthreads();
    {
        const int e = tid * 4, cc = e >> 7, n = e & 127;
        f32x4 s = *(const f32x4*)(cmp_b1 + i * 128 + n);
#pragma unroll
        for (int w = 0; w < 8; ++w) s += *(const LAS f32x4*)(red + (w * 16 + cc) * 128 + n);
        float o[4];
#pragma unroll
        for (int j = 0; j < 4; ++j) { const float x = s[j]; o[j] = 0.5f * x * (1.0f + tanhf(0.7978845608028654f * (x + 0.044715f * x * x * x))); }
        u32x2 w; w.x = cvt_pk_bf16(o[0], o[1]); w.y = cvt_pk_bf16(o[2], o[3]);
        *(LAS u32x2*)(hid + cc * 136 + n) = w;
    }
    __syncthreads();
    f32x4 o2 = (f32x4){0.f, 0.f, 0.f, 0.f};
#pragma unroll
    for (int kc = 0; kc < 4; ++kc) {
        const bf16x8 a = *(const LAS bf16x8*)(hid + l15 * 136 + 32 * kc + 8 * fq);
        const bf16x8 bf = *(const bf16x8*)(WC2 + (size_t)(i * 128 + 16 * wave + l15) * 128 + 32 * kc + 8 * fq);
        o2 = MFMA16(a, bf, o2);
    }
    if (i == 1) {
        const int cbase = 16 * ct + 4 * fq;
        u32x2 w; w.x = cvt_pk_bf16(cbase + 0 < 127 ? o2[0] : 0.f, cbase + 1 < 127 ? o2[1] : 0.f); w.y = cvt_pk_bf16(cbase + 2 < 127 ? o2[2] : 0.f, cbase + 3 < 127 ? o2[3] : 0.f);
        *(u32x2*)(VCT + (size_t)bg * 16384 + (((ct >> 1) * 8 + wave) * 64 + lane) * 8 + 4 * (ct & 1)) = w;
    } else {
#pragma unroll
        for (int j = 0; j < 4; ++j) red[(4 * fq + j) * 128 + 16 * wave + l15] = o2[j];
        __syncthreads();
        const int cc = tid >> 5, part = tid & 31;
        const f32x4 v = *(const LAS f32x4*)(red + cc * 128 + 4 * part);
        float ss = (v[0] * v[0] + v[1] * v[1]) + (v[2] * v[2] + v[3] * v[3]);
#pragma unroll
        for (int o = 1; o < 32; o <<= 1) ss += __shfl_xor(ss, o);
        const float r = 1.0f / sqrtf(ss * (1.0f / 128.0f) + EPS_);
        const f32x4 gq = *(const f32x4*)(g_qk + 128 + 4 * part);
        f32x4 y = v * r * gq;
        if (16 * ct + cc >= 127) y = (f32x4){0.f, 0.f, 0.f, 0.f};
        u32x2 w; w.x = cvt_pk_bf16(y[0], y[1]); w.y = cvt_pk_bf16(y[2], y[3]);
        *(u32x2*)(KC + (size_t)bg * 16384 + (ct * 4 + (part >> 3)) * 512 + ((part >> 1) & 3) * 128 + cc * 8 + 4 * (part & 1)) = w;
    }
    __syncthreads();
}

struct Params {
    const float *x, *c, *w_ada, *b_ada, *g_norm, *w_gate, *w_up, *w_down, *w_in, *g_qk, *cmp_pos, *cmp_w1, *cmp_b1, *cmp_w2, *gn_gain, *w_pn, *w_pr, *w_out;
    float* out; unsigned char* ws; int mask; int pad;
};

struct ConvTile { const float* W; bf16_t* WT; int K, N, mode, k0, n0; };
__device__ __forceinline__ ConvTile conv_tile(const Params& p, int set, int idx) {
    ConvTile c; int r = idx, nbn;
    constexpr int T_GU = (D_ / 128) * (FF_ / 128), T_IN = (D_ / 128) * ((NIN_ + 127) / 128), T_P = (D_ / 128) * (D_ / 128), T_C1 = 4096 / 128;
    const int layer = set;
    if (set == 1 || r < 3 * T_GU) {
        if (r < T_GU) { c.W = p.w_gate + (size_t)layer * D_ * FF_; c.WT = (bf16_t*)(p.ws + WS_WGU); c.K = D_; c.N = FF_; c.mode = 1; }
        else if (r < 2 * T_GU) { r -= T_GU; c.W = p.w_up + (size_t)layer * D_ * FF_; c.WT = (bf16_t*)(p.ws + WS_WGU); c.K = D_; c.N = FF_; c.mode = 2; }
        else { r -= 2 * T_GU; c.W = p.w_down + (size_t)layer * D_ * FF_; c.WT = (bf16_t*)(p.ws + WS_WD); c.K = FF_; c.N = D_; c.mode = 0; }
    } else {
        r -= 3 * T_GU;
        if (r < T_IN) { c.W = p.w_in; c.WT = (bf16_t*)(p.ws + WS_WIN); c.K = D_; c.N = NIN_; c.mode = 3; }
        else if (r < T_IN + 3 * T_P) { r -= T_IN; const int w = r / T_P; r -= w * T_P; c.W = w == 0 ? p.w_pn : (w == 1 ? p.w_pr : p.w_out);
            c.WT = (bf16_t*)(p.ws + (w == 0 ? WS_WPN : (w == 1 ? WS_WPR : WS_WO))); c.K = D_; c.N = D_; c.mode = 0; }
        else if (r < T_IN + 3 * T_P + 2 * T_C1) { r -= T_IN + 3 * T_P; const int i = r / T_C1; r -= i * T_C1; c.W = p.cmp_w1 + (size_t)i * 4096 * 128; c.WT = (bf16_t*)(p.ws + WS_WC1) + (size_t)i * 128 * 4096; c.K = 4096; c.N = 128; c.mode = 4; }
        else { r -= T_IN + 3 * T_P + 2 * T_C1; c.W = p.cmp_w2 + (size_t)r * 128 * 128; c.WT = (bf16_t*)(p.ws + WS_WC2) + (size_t)r * 128 * 128; c.K = 128; c.N = 128; c.mode = 0; r = 0; }
    }
    nbn = (c.N + 127) >> 7;
    const int kb = r / nbn, nb = r - kb * nbn; c.k0 = kb * 128; c.n0 = nb * 128;
    return c;
}
__device__ __forceinline__ void conv_load(const ConvTile& c, int tid, f32x4 (&r)[8]) {
    const int c4 = (tid & 31) * 4, r0 = 2 * (tid >> 5);
    const bool ok = (c.n0 + c4) < c.N;
    const float* src = c.W + (size_t)(c.k0 + r0) * c.N + c.n0 + c4;
#pragma unroll
    for (int i = 0; i < 4; ++i)
#pragma unroll
        for (int e = 0; e < 2; ++e) r[2 * i + e] = ok ? *(const f32x4*)(src + (size_t)(32 * i + e) * c.N) : (f32x4){0.f, 0.f, 0.f, 0.f};
}
__device__ __forceinline__ void conv_phase(const Params& p, int set, LAS unsigned char* lds, int tid, int bid, int G) {
    constexpr int T_GU = (D_ / 128) * (FF_ / 128), T_IN = (D_ / 128) * ((NIN_ + 127) / 128), T_P = (D_ / 128) * (D_ / 128), T_C1 = 4096 / 128;
    const int total = set == 0 ? 3 * T_GU + T_IN + 3 * T_P + 2 * T_C1 + 2 : 3 * T_GU;
    f32x4 r[8];
    int idx = bid;
    if (idx < total) { const ConvTile c = conv_tile(p, set, idx); conv_load(c, tid, r); }
    for (int it = 0; idx < total; ++it, idx += G) {
        const ConvTile c = conv_tile(p, set, idx);
        LAS bf16_t* buf = (LAS bf16_t*)(lds + (it & 1) * 34816);
        {
            const int c4 = (tid & 31) * 4, r0 = 2 * (tid >> 5);
#pragma unroll
            for (int i = 0; i < 4; ++i)
#pragma unroll
                for (int j = 0; j < 4; ++j) *(LAS unsigned*)(buf + (c4 + j) * 136 + r0 + 32 * i) = cvt_pk_bf16(r[2 * i][j], r[2 * i + 1][j]);
        }
        if (idx + G < total) { const ConvTile n = conv_tile(p, set, idx + G); conv_load(n, tid, r); }
        __syncthreads();
#pragma unroll
        for (int i = 0; i < 4; ++i) {
            const int q = tid + 512 * i, n = q >> 4, kc = q & 15;
            const u32x4 w = *(const LAS u32x4*)(buf + n * 136 + 8 * kc);
            if (c.mode == 4) {
                const int k = c.k0 + 8 * kc;
                *(u32x4*)(c.WT + (size_t)((((k >> 5) * 8 + (n >> 4)) * 64 + ((k >> 3) & 3) * 16 + (n & 15)) * 8)) = w;
            } else if (c.n0 + n < c.N) *(u32x4*)(c.WT + (size_t)rowmap(c.mode, c.n0 + n) * c.K + c.k0 + 8 * kc) = w;
        }
    }
    __syncthreads();
}

__global__ void __launch_bounds__(512, 2) fwd_kernel(Params p) {
    extern __shared__ __attribute__((aligned(16))) unsigned char lds_raw[];
    cg::grid_group grid = cg::this_grid();
    LAS unsigned char* lds = (LAS unsigned char*)lds_raw;
    const int tid = threadIdx.x, lane = tid & 63, wave = __builtin_amdgcn_readfirstlane(tid >> 6);
    const int G = gridDim.x, gw = blockIdx.x * 8 + wave, NGW = G * 8;
#define ctl ((unsigned*)(p.ws + WS_CTL))
#define ada ((float*)(p.ws + WS_ADA))
#define WGU ((bf16_t*)(p.ws + WS_WGU))
#define WD ((bf16_t*)(p.ws + WS_WD))
#define WIN ((bf16_t*)(p.ws + WS_WIN))
#define WPN ((bf16_t*)(p.ws + WS_WPN))
#define WPR ((bf16_t*)(p.ws + WS_WPR))
#define WO ((bf16_t*)(p.ws + WS_WO))
#define WC1 ((bf16_t*)(p.ws + WS_WC1))
#define WC2 ((bf16_t*)(p.ws + WS_WC2))
#define H ((bf16_t*)(p.ws + WS_H))
#define ONSA ((bf16_t*)(p.ws + WS_H))
#define Y ((bf16_t*)(p.ws + WS_Y))
#define ACT ((bf16_t*)(p.ws + WS_Y))
#define MG ((bf16_t*)(p.ws + WS_MG))
#define ORET ((bf16_t*)(p.ws + WS_ORET))
#define VTS ((bf16_t*)(p.ws + WS_VTS))
#define VTW ((bf16_t*)(p.ws + WS_VTW))
#define VTR ((bf16_t*)(p.ws + WS_VTR))
#define KC ((bf16_t*)(p.ws + WS_KC))
#define VCT ((bf16_t*)(p.ws + WS_VCT))
#define KS ((bf16_t*)(p.ws + WS_KS))
#define KW ((bf16_t*)(p.ws + WS_KW))
#define KR ((bf16_t*)(p.ws + WS_KR))
    const int mask = p.mask;
#ifndef DBL_MASK
#define DBL_MASK 0
#endif
#ifdef PROBE_CMP_FIRST
#define CMP_ONLY_COND (rep == 0)
#else
#define CMP_ONLY_COND false
#endif
#define REPS(k) (1 + ((DBL_MASK >> (k)) & 1))
#ifdef CT_MASK
#define ON(k) ((CT_MASK >> (k)) & 1)
#else
#define ON(k) ((mask >> (k)) & 1)
#endif

    for (int rep = 0; rep < REPS(0); ++rep) { if (rep) grid.sync();
    if (ON(0)) {
        LAS float* cond = (LAS float*)lds;
        LAS float* red = (LAS float*)(lds + 32768);
        for (int i = tid; i < 4 * D_; i += 512) cond[i] = silu_f(p.c[i]);
        __syncthreads();
        for (int it = blockIdx.x; it < NADA / 64; it += G) {
            const int n = it * 64 + lane; float a0 = 0.f, a1 = 0.f, a2 = 0.f, a3 = 0.f;
            const int kb = wave * 256;
#pragma unroll 8
            for (int kk = 0; kk < 256; ++kk) { const int k = kb + kk; const float w = p.w_ada[(size_t)k * NADA + n];
                a0 += cond[k] * w; a1 += cond[D_ + k] * w; a2 += cond[2 * D_ + k] * w; a3 += cond[3 * D_ + k] * w; }
            red[(wave * 4 + 0) * 64 + lane] = a0; red[(wave * 4 + 1) * 64 + lane] = a1; red[(wave * 4 + 2) * 64 + lane] = a2; red[(wave * 4 + 3) * 64 + lane] = a3;
            __syncthreads();
            if (tid < 256) { const int bb = tid >> 6, l = tid & 63; float s = p.b_ada[it * 64 + l];
#pragma unroll
                for (int w = 0; w < 8; ++w) s += red[(w * 4 + bb) * 64 + l];
                ada[(size_t)bb * NADA + it * 64 + l] = s; }
            __syncthreads();
        }
        __syncthreads();
        conv_phase(p, 0, lds, tid, (int)blockIdx.x, G);
        { u32x4* z = (u32x4*)(WIN + (size_t)NIN_ * D_); const int nz = (LDY - NIN_) * D_ * 2 / 16;
          for (int i = blockIdx.x * 512 + tid; i < nz; i += G * 512) z[i] = (u32x4){0u, 0u, 0u, 0u}; }
    }
    }
    grid.sync();
    for (int rep = 0; rep < REPS(1); ++rep) { if (rep) grid.sync();
    if (ON(1)) norm_rows(p.x, p.g_norm, ada, 0, 1, H, gw, NGW, lane);
    }
    grid.sync();
    for (int rep = 0; rep < REPS(2); ++rep) { if (rep) grid.sync();
    if (ON(2)) {
        pg8::Gemm g{H, WGU, T_, 2 * FF_, D_}; pg8::StaticOrder S; S.init(T_, 2 * FF_, G, (int)blockIdx.x);
        EpiSwiglu E{ACT};
        pg8::gemm_phase<EpiSwiglu, pg8::StaticOrder, true, true>(lds, g, S, E);
    }
    }
    grid.sync();
    if (ON(3)) {
        pg8::Gemm g{ACT, WD, T_, D_, FF_}; pg8::StaticOrder S; S.init(T_, D_, G, (int)blockIdx.x);
        EpiResid E{p.x, p.out, ada + 2 * D_, 0.5f};
        pg8::gemm_phase<EpiResid, pg8::StaticOrder, true, true>(lds, g, S, E);
    } else {
        for (size_t i = (size_t)blockIdx.x * 512 + tid; i < (size_t)T_ * D_ / 4; i += (size_t)G * 512) ((f32x4*)p.out)[i] = ((const f32x4*)p.x)[i];
    }
    grid.sync();
    for (int rep = 0; rep < REPS(4); ++rep) { if (rep) grid.sync();
    if (ON(4)) {
        norm_rows(p.out, p.g_norm + D_, ada, 3, 4, H, gw, NGW, lane);
        __syncthreads();
        conv_phase(p, 1, lds, tid, (int)blockIdx.x, G);
    }
    }
    grid.sync();
    for (int rep = 0; rep < REPS(5); ++rep) { if (rep) grid.sync();
    if (ON(5)) {
        pg8::Gemm g{H, WIN, T_, LDY, D_}; pg8::StaticOrder S; S.init(T_, LDY, G, (int)blockIdx.x);
        EpiY E{Y};
        pg8::gemm_phase<EpiY, pg8::StaticOrder, true, true>(lds, g, S, E);
    }
    }
    grid.sync();
    for (int rep = 0; rep < REPS(6); ++rep) { if (rep) grid.sync();
    if (ON(6)) {
        for (int unit = blockIdx.x; unit < 256; unit += G) compress_unit(unit, Y, p.cmp_pos, p.cmp_b1, p.g_qk, WC1, WC2, KC, VCT, lds, tid);
        __syncthreads();
        if (rep == 0) for (int tok = gw; tok < T_; tok += NGW) {
            bf16_t* row = Y + (size_t)tok * LDY;
            const int b = tok >> 11, sidx = tok & 2047, c16 = lane & 15, hsub = lane >> 4;
            const size_t fro = (size_t)((sidx >> 4) * 4 + (c16 >> 2)) * 512 + (c16 & 3) * 128 + (sidx & 15) * 8;
#pragma unroll 1
            for (int seg = 0; seg < 8; ++seg) {
                const int colbase = seg < 4 ? seg * 512 : (seg == 4 ? OFF_KV + 1024 : (seg == 5 ? OFF_KV + 2048 : OFF_KR + (seg - 6) * 512)), gi = seg < 4 ? 0 : (seg == 4 ? 2 : 3);
                const u32x4 w = *(const u32x4*)(row + colbase + lane * 8);
                u32x4 o = w;
                if (seg < 6) {
                    float f[8] = {bf_lo(w.x), bf_hi(w.x), bf_lo(w.y), bf_hi(w.y), bf_lo(w.z), bf_hi(w.z), bf_lo(w.w), bf_hi(w.w)};
                    float ss = 0.f;
#pragma unroll
                    for (int j = 0; j < 8; ++j) ss += f[j] * f[j];
                    ss += __shfl_xor(ss, 1); ss += __shfl_xor(ss, 2); ss += __shfl_xor(ss, 4); ss += __shfl_xor(ss, 8);
                    const float r = 1.0f / sqrtf(ss * (1.0f / 128.0f) + EPS_);
                    const float* gq = p.g_qk + gi * 128 + c16 * 8;
                    const f32x4 g0 = *(const f32x4*)gq, g1 = *(const f32x4*)(gq + 4);
                    o.x = cvt_pk_bf16(f[0] * r * g0[0], f[1] * r * g0[1]); o.y = cvt_pk_bf16(f[2] * r * g0[2], f[3] * r * g0[3]);
                    o.z = cvt_pk_bf16(f[4] * r * g1[0], f[5] * r * g1[1]); o.w = cvt_pk_bf16(f[6] * r * g1[2], f[7] * r * g1[3]);
                }
                bf16_t* dstp;
                if (seg < 4) dstp = row + colbase + lane * 8;
                else if (seg == 4) dstp = KS + (size_t)(b * 4 + hsub) * 262144 + fro;
                else if (seg == 5) dstp = KW + (size_t)(b * 4 + hsub) * 262144 + fro;
                else dstp = KR + (size_t)(b * 8 + (seg - 6) * 4 + hsub) * 262144 + fro;
                *(u32x4*)dstp = o;
            }
        }
        LAS bf16_t* tl = (LAS bf16_t*)(lds + wave * 16384);
        for (int it = gw; it < 48 * 128; it += NGW) {
            const int tt = it / 48, ct = it - tt * 48;
            int srccol, cc, HD; bf16_t* dst;
            if (ct < 8) { srccol = OFF_KV + 3 * 512 + ct * 64; cc = ct * 64; dst = VTS; HD = 128; }
            else if (ct < 16) { srccol = OFF_KV + 5 * 512 + (ct - 8) * 64; cc = (ct - 8) * 64; dst = VTW; HD = 128; }
            else { srccol = OFF_VR + (ct - 16) * 64; cc = (ct - 16) * 64; dst = VTR; HD = 256; }
            const int b = tt >> 5, s0 = (tt & 31) * 64;
            const int head = cc / HD, dt0 = (cc - head * HD) >> 4, NDTh = HD >> 4, nheads = (HD == 128) ? 4 : 8;
#pragma unroll
            for (int i = 0; i < 8; ++i) {
                const int tok = 8 * i + (lane >> 3), ch = lane & 7;
                const u32x4 w = *(const u32x4*)(Y + (size_t)(b * 2048 + s0 + tok) * LDY + srccol + ch * 8);
                LAS bf16_t* d = tl + (ch * 8) * 72 + tok;
                d[0 * 72] = (bf16_t)(w.x & 0xffffu); d[1 * 72] = (bf16_t)(w.x >> 16); d[2 * 72] = (bf16_t)(w.y & 0xffffu); d[3 * 72] = (bf16_t)(w.y >> 16);
                d[4 * 72] = (bf16_t)(w.z & 0xffffu); d[5 * 72] = (bf16_t)(w.z >> 16); d[6 * 72] = (bf16_t)(w.w & 0xffffu); d[7 * 72] = (bf16_t)(w.w >> 16);
            }
            asm volatile("s_waitcnt lgkmcnt(0)" ::: "memory");
            bf16_t* hb = dst + (size_t)(b * nheads + head) * (2048 * HD) + lane * 8;
#pragma unroll
            for (int i = 0; i < 8; ++i) {
                const int ks = i >> 2, dt = i & 3, col = 16 * dt + (lane & 15), fq4 = 4 * (lane >> 4);
                const u32x2 lo = *(const LAS u32x2*)(tl + col * 72 + 32 * ks + fq4), hi = *(const LAS u32x2*)(tl + col * 72 + 32 * ks + 16 + fq4);
                u32x4 w; w.x = lo.x; w.y = lo.y; w.z = hi.x; w.w = hi.y;
                *(u32x4*)(hb + (size_t)(((s0 >> 5) + ks) * NDTh + dt0 + dt) * 512) = w;
            }
            asm volatile("s_waitcnt lgkmcnt(0)" ::: "memory");
        }
    }
    }
    grid.sync();
    for (int rep = 0; rep < REPS(7); ++rep) { if (rep) grid.sync();
    if (ON(7)) {
        MixPtrs MP{Y, ONSA, ORET, VTS, VTW, VTR, KC, VCT, p.gn_gain, KS, KW, KR};
        unsigned* SM = (unsigned*)(p.ws + WS_SM);
        for (int u = blockIdx.x; u < 256; u += G) cmp_unit(MP, SM, u >> 4, u & 15, lds, tid);
    }
    grid.sync();
    if (ON(7)) {
        MixPtrs MP{Y, ONSA, ORET, VTS, VTW, VTR, KC, VCT, p.gn_gain, KS, KW, KR};
        const unsigned* SM = (const unsigned*)(p.ws + WS_SM);
        LAS bf16x8* qs = (LAS bf16x8*)(lds + wave * 16384) + lane;
        if (G == 256) {
            const int x = blockIdx.x & 7, wl = (blockIdx.x >> 3) * 8 + wave;
#pragma unroll 1
            for (int k = 0; k < 4; ++k) {
                const int r = (k & 1) ? 255 - wl : wl;
                if (k < 2) { const int bg = x + 8 * k; nsa_unit(MP, SM, bg >> 2, bg & 3, 127 - (r >> 1), r & 1, lane, qs, lds + wave * 16384); }
                else { const int bh = x + 8 * (2 * (k - 2) + (r >> 7)); ret_unit(MP, bh >> 3, bh & 7, 127 - (r & 127), lane, qs, lds + wave * 16384); }
            }
        } else {
            for (int id = gw; id < 8192; id += NGW) {
                if (id < 4096) { const int bg = id >> 8, r = id & 255; nsa_unit(MP, SM, bg >> 2, bg & 3, 127 - (r >> 1), r & 1, lane, qs, lds + wave * 16384); }
                else { const int r = id - 4096, bh = r >> 7; ret_unit(MP, bh >> 3, bh & 7, 127 - (r & 127), lane, qs, lds + wave * 16384); }
            }
        }
    }
    }
    grid.sync();
    for (int rep = 0; rep < REPS(8); ++rep) { if (rep) grid.sync();
    if (ON(8)) {
        { pg8::Gemm g{ONSA, WPN, T_, D_, D_}; pg8::StaticOrder S; S.init(T_, D_, G, (int)blockIdx.x);
          EpiMerge<false> E{MG, Y, OFF_GA};
          pg8::gemm_phase<EpiMerge<false>, pg8::StaticOrder, true, true>(lds, g, S, E); }
        __syncthreads();
        { pg8::Gemm g{ORET, WPR, T_, D_, D_}; pg8::StaticOrder S; S.init(T_, D_, G, (int)blockIdx.x);
          EpiMerge<true> E{MG, Y, OFF_GB};
          pg8::gemm_phase<EpiMerge<true>, pg8::StaticOrder, true, true>(lds, g, S, E); }
    }
    }
    grid.sync();
    if (ON(9)) {
        pg8::Gemm g{MG, WO, T_, D_, D_}; pg8::StaticOrder S; S.init(T_, D_, G, (int)blockIdx.x);
        EpiResid E{p.out, p.out, ada + 5 * D_, 1.0f};
        pg8::gemm_phase<EpiResid, pg8::StaticOrder, true, true>(lds, g, S, E);
    }
    grid.sync();
    for (int rep = 0; rep < REPS(10); ++rep) { if (rep) grid.sync();
    if (ON(10)) norm_rows(p.out, p.g_norm + 2 * D_, ada, 6, 7, H, gw, NGW, lane);
    }
    grid.sync();
    for (int rep = 0; rep < REPS(11); ++rep) { if (rep) grid.sync();
    if (ON(11)) {
        pg8::Gemm g{H, WGU, T_, 2 * FF_, D_}; pg8::StaticOrder S; S.init(T_, 2 * FF_, G, (int)blockIdx.x);
        EpiSwiglu E{ACT};
        pg8::gemm_phase<EpiSwiglu, pg8::StaticOrder, true, true>(lds, g, S, E);
    }
    }
    grid.sync();
    if (ON(12)) {
        pg8::Gemm g{ACT, WD, T_, D_, FF_}; pg8::StaticOrder S; S.init(T_, D_, G, (int)blockIdx.x);
        EpiResid E{p.out, p.out, ada + 8 * D_, 0.5f};
        pg8::gemm_phase<EpiResid, pg8::StaticOrder, true, true>(lds, g, S, E);
    }
#undef ON
#undef ctl
#undef ada
#undef WGU
#undef WD
#undef WIN
#undef WPN
#undef WPR
#undef WO
#undef WC1
#undef WC2
#undef H
#undef ONSA
#undef Y
#undef ACT
#undef MG
#undef ORET
#undef VTS
#undef VTW
#undef VTR
#undef KC
#undef VCT
#undef KS
#undef KW
#undef KR
}

#ifndef PHASE_MASK
#define PHASE_MASK 0x1fff
#endif
extern "C" void kernel_launch(void* const* d_in, const int* in_sizes, int n_in, void* d_out, int out_size, void* d_ws, size_t ws_size, hipStream_t stream) {
    static int grid_blocks = 0;
    if (grid_blocks == 0) {
        if (n_in != 18 || ws_size < WS_END) { fprintf(stderr, "kernel_launch: unexpected n_in %d or workspace %zu < %zu\n", n_in, ws_size, (size_t)WS_END); grid_blocks = -1; return; }
        int dev = 0, cus = 0, per_cu = 0;
        hipGetDevice(&dev);
        hipDeviceGetAttribute(&cus, hipDeviceAttributeMultiprocessorCount, dev);
        if (hipFuncSetAttribute((const void*)fwd_kernel, hipFuncAttributeMaxDynamicSharedMemorySize, LDS_BYTES) != hipSuccess) { fprintf(stderr, "kernel_launch: hipFuncSetAttribute failed\n"); grid_blocks = -1; return; }
        if (hipOccupancyMaxActiveBlocksPerMultiprocessor(&per_cu, (const void*)fwd_kernel, 512, LDS_BYTES) != hipSuccess || per_cu < 1) { fprintf(stderr, "kernel_launch: occupancy query gave %d\n", per_cu); per_cu = 1; }
        (void)hipGetLastError();
        grid_blocks = cus * 1;
    }
    if (grid_blocks < 0) return;
    (void)hipMemsetAsync((char*)d_ws + WS_CTL, 0, 4096, stream);
    Params p{};
    p.x = (const float*)d_in[0]; p.c = (const float*)d_in[1]; p.w_ada = (const float*)d_in[2]; p.b_ada = (const float*)d_in[3]; p.g_norm = (const float*)d_in[4];
    p.w_gate = (const float*)d_in[5]; p.w_up = (const float*)d_in[6]; p.w_down = (const float*)d_in[7]; p.w_in = (const float*)d_in[8]; p.g_qk = (const float*)d_in[9];
    p.cmp_pos = (const float*)d_in[10]; p.cmp_w1 = (const float*)d_in[11]; p.cmp_b1 = (const float*)d_in[12]; p.cmp_w2 = (const float*)d_in[13]; p.gn_gain = (const float*)d_in[14];
    p.w_pn = (const float*)d_in[15]; p.w_pr = (const float*)d_in[16]; p.w_out = (const float*)d_in[17];
    p.out = (float*)d_out; p.ws = (unsigned char*)d_ws; p.mask = PHASE_MASK; p.pad = 0;
    void* args[] = {&p};
    hipError_t e = hipLaunchCooperativeKernel((const void*)fwd_kernel, dim3(grid_blocks), dim3(512), args, LDS_BYTES, stream);
    if (e != hipSuccess) fprintf(stderr, "kernel_launch: cooperative launch failed: %s (grid %d)\n", hipGetErrorString(e), grid_blocks);
}
```

```cpp
#include <hip/hip_runtime.h>
#include <hip/hip_cooperative_groups.h>
#include <cstdio>
#include <cstdint>
namespace cg = cooperative_groups;
namespace pg8 {
#define PG8_LAS __attribute__((address_space(3)))
typedef unsigned short bf16_t;
typedef short bf16x8 __attribute__((ext_vector_type(8)));
typedef float f32x4 __attribute__((ext_vector_type(4)));
typedef unsigned u32x4 __attribute__((ext_vector_type(4)));
constexpr int BM = 256, BK = 64, HALF = 128, HTB = HALF * BK * 2  , STAGE_BYTES = 8 * HTB, NXCD = 8, WGM = 8;

__host__ __device__ __forceinline__ int lds_byte(int r, int c) { const int st = (r >> 4) * 2 + (c >> 5), rr = r & 15, cc = c & 31, ob = rr * 64 + cc * 2; return st * 1024 + (ob ^ (((ob >> 9) & 1) << 5)); }
__host__ __device__ __forceinline__ void stage_rc(int b, int& R, int& C) { const int st = b / 1024, sb = b % 1024, swz = sb ^ (((sb >> 9) & 1) << 5); R = (st >> 1) * 16 + swz / 64; C = (st & 1) * 32 + (swz % 64) / 2; }
__host__ __device__ __forceinline__ int perm32(int rho) { const int n = rho >> 4, i = rho & 15; return 8 * (i >> 2) + 4 * n + (i & 3); }

struct Unit { int pm, pn; };
struct Gemm { const bf16_t* A; const bf16_t* Bt; int M, N, K; };

struct StaticOrder {
    int nM, nN, nwg, G, c;
    __host__ __device__ void init(int M, int N, int G_, int c_) { nM = M / BM; nN = N / BM; nwg = nM * nN; G = G_; c = c_; }
    __host__ __device__ bool next(int i, Unit& u) const {
        const long L = (long)i * G + c; if (L >= nwg) return false;
        int wgid = (int)L; { const int q = nwg / NXCD, r = nwg % NXCD, xcd = wgid % NXCD, off = wgid / NXCD; wgid = (xcd < r ? xcd * (q + 1) : r * (q + 1) + (xcd - r) * q) + off; }
        const int nig = WGM * nN, gid = wgid / nig, fm = gid * WGM, gsz = (nM - fm) < WGM ? (nM - fm) : WGM;
        u.pm = fm + ((wgid % nig) % gsz); u.pn = (wgid % nig) / gsz; return true;
    }
    __device__ __forceinline__ void a_ready(const Unit&) const {}
    __device__ __forceinline__ void done(const Unit&) const {}
};

__device__ __forceinline__ unsigned cvt_pk_bf16(float lo, float hi) { unsigned r; asm volatile("v_cvt_pk_bf16_f32 %0, %1, %2" : "=v"(r) : "v"(lo), "v"(hi)); return r; }
typedef float f32x2 __attribute__((ext_vector_type(2)));
template <class Epi, class Sched, bool ALIGN_EPI = false, bool SP2 = false>
__device__ __forceinline__ void gemm_phase(PG8_LAS unsigned char* lds, const Gemm g, const Sched& S, const Epi& E) {
    int tid_o = threadIdx.x; asm volatile("" : "+v"(tid_o));
    const int tid = tid_o, wid = __builtin_amdgcn_readfirstlane(tid >> 6), lane = tid & 63, wr = wid >> 2, wc = wid & 3, fr = lane & 15, fq = lane >> 4;
    const int K = g.K, nt = K / BK;
    unsigned voffA[2], voffB[2];
#pragma unroll
    for (int i = 0; i < 2; ++i) { int R, C; stage_rc(tid * 16 + i * 8192, R, C); const int Rb = Epi::PERM ? ((R & ~31) + perm32(R & 31)) : R;
        voffA[i] = (unsigned)(R * K + C) * 2u; voffB[i] = (unsigned)(Rb * K + C) * 2u; }
    const size_t kstep = (size_t)(BK * 2);
    const size_t hstep = (size_t)HALF * K * 2;
    const size_t tstep = 2 * hstep;
    const unsigned ldsw = (unsigned)wid * 1024u;
    const int aoff = lds_byte(wr * 64 + fr, fq * 8), boff = lds_byte(wc * 32 + fr, fq * 8);
#define PG8_SA(b, h) (((b) * 2 + (h)) * HTB)
#define PG8_SB(b, h) ((4 + (b) * 2 + (h)) * HTB)
#define PG8_STAGE(bufoff, gbase, voff) do { _Pragma("unroll") for (int _i = 0; _i < 2; ++_i) \
        __builtin_amdgcn_global_load_lds((const unsigned*)((const char*)(gbase) + (voff)[_i]), (PG8_LAS unsigned*)(lds + (bufoff) + ldsw + _i * 8192), 16, 0, 0); } while (0)
#define PG8_LDA(dst, b, h) do { _Pragma("unroll") for (int m = 0; m < 4; ++m) _Pragma("unroll") for (int k = 0; k < 2; ++k) dst[m][k] = *(const PG8_LAS bf16x8*)(lds + PG8_SA(b, h) + aoff + m * 2048 + k * 1024); } while (0)
#define PG8_LDB(dst, b, h) do { _Pragma("unroll") for (int n = 0; n < 2; ++n) _Pragma("unroll") for (int k = 0; k < 2; ++k) dst[n][k] = *(const PG8_LAS bf16x8*)(lds + PG8_SB(b, h) + boff + n * 2048 + k * 1024); } while (0)
#define PG8_MMA(ai, bj, At, Bt) do { __builtin_amdgcn_s_setprio(1); _Pragma("unroll") for (int m = 0; m < 4; ++m) _Pragma("unroll") for (int n = 0; n < 2; ++n) _Pragma("unroll") for (int k = 0; k < 2; ++k) \
        acc[ai][bj][m][n] = __builtin_amdgcn_mfma_f32_16x16x32_bf16(Bt[n][k], At[m][k], acc[ai][bj][m][n], 0, 0, 0); __builtin_amdgcn_s_setprio(0); } while (0)
#define PG8_WAIT_V(n) asm volatile("s_waitcnt vmcnt(" #n ")" ::: "memory")
#define PG8_WAIT_L(n) asm volatile("s_waitcnt lgkmcnt(" #n ")" ::: "memory")
#define PG8_BAR __builtin_amdgcn_s_barrier()
#define PG8_SCHED __builtin_amdgcn_sched_barrier(0)
    Unit cur, nxt; int ui = 0;
    if (!S.next(0, cur)) return;
    f32x4 acc[2][2][4][2];
#pragma unroll
    for (int a = 0; a < 2; ++a)
#pragma unroll
        for (int b = 0; b < 2; ++b)
#pragma unroll
            for (int m = 0; m < 4; ++m)
#pragma unroll
                for (int n = 0; n < 2; ++n) acc[a][b][m][n] = (f32x4){0.f, 0.f, 0.f, 0.f};
    bf16x8 At[4][2], B0[2][2], B1[2][2];
    const char* cA = (const char*)g.A + (size_t)cur.pm * tstep; const char* cB = (const char*)g.Bt + (size_t)cur.pn * tstep;
    S.a_ready(cur);
    if constexpr (SP2) {
        PG8_STAGE(PG8_SB(0, 0), cB, voffB); PG8_STAGE(PG8_SB(0, 1), cB + hstep, voffB); PG8_STAGE(PG8_SA(0, 0), cA, voffA); PG8_STAGE(PG8_SA(0, 1), cA + hstep, voffA);
        if (wr == 1) PG8_BAR;
        PG8_WAIT_V(2); PG8_BAR;
        PG8_STAGE(PG8_SB(1, 0), cB + kstep, voffB); PG8_STAGE(PG8_SA(1, 0), cA + kstep, voffA); PG8_STAGE(PG8_SB(1, 1), cB + hstep + kstep, voffB);
        PG8_WAIT_V(6); PG8_BAR;
    } else {
        PG8_STAGE(PG8_SB(0, 0), cB, voffB); PG8_STAGE(PG8_SA(0, 0), cA, voffA); PG8_STAGE(PG8_SB(0, 1), cB + hstep, voffB); PG8_STAGE(PG8_SA(0, 1), cA + hstep, voffA);
        if (wr == 1) PG8_BAR;
        PG8_WAIT_V(4); PG8_BAR;
        PG8_STAGE(PG8_SB(1, 0), cB + kstep, voffB); PG8_STAGE(PG8_SA(1, 0), cA + kstep, voffA); PG8_STAGE(PG8_SB(1, 1), cB + hstep + kstep, voffB);
        PG8_WAIT_V(6); PG8_BAR;
    }
    for (;;) {
        const bool has_next = S.next(ui + 1, nxt);
        const char* nA = has_next ? (const char*)g.A + (size_t)nxt.pm * tstep : cA; const char* nB = has_next ? (const char*)g.Bt + (size_t)nxt.pn * tstep : cB;
        for (int t = 0; t < nt; t += 2) {
            const bool last = (t == nt - 2);
            const char* a1 = cA + (size_t)(t + 1) * kstep;
            const char* a2 = last ? nA : cA + (size_t)(t + 2) * kstep; const char* b2 = last ? nB : cB + (size_t)(t + 2) * kstep;
            const char* a3 = a2 + kstep; const char* b3 = b2 + kstep;
            if (last && has_next) S.a_ready(nxt);
            if constexpr (SP2) {
            PG8_LDB(B0, 0, 0); PG8_LDB(B1, 0, 1); PG8_SCHED; PG8_LDA(At, 0, 0); PG8_STAGE(PG8_SA(1, 1), a1 + hstep, voffA);
            PG8_WAIT_V(8); PG8_WAIT_L(0); PG8_BAR; PG8_MMA(0, 0, At, B0); PG8_MMA(0, 1, At, B1); PG8_BAR; PG8_SCHED;
            PG8_LDA(At, 0, 1); PG8_STAGE(PG8_SB(0, 0), b2, voffB); PG8_STAGE(PG8_SB(0, 1), b2 + hstep, voffB); PG8_STAGE(PG8_SA(0, 0), a2, voffA);
            PG8_WAIT_V(8); PG8_WAIT_L(0); PG8_BAR; PG8_MMA(1, 0, At, B0); PG8_MMA(1, 1, At, B1); PG8_BAR; PG8_SCHED;
            PG8_LDB(B0, 1, 0); PG8_LDB(B1, 1, 1); PG8_SCHED; PG8_LDA(At, 1, 0); PG8_STAGE(PG8_SA(0, 1), a2 + hstep, voffA);
            PG8_WAIT_V(8); PG8_WAIT_L(0); PG8_BAR; PG8_MMA(0, 0, At, B0); PG8_MMA(0, 1, At, B1); PG8_BAR; PG8_SCHED;
            PG8_LDA(At, 1, 1); PG8_STAGE(PG8_SB(1, 0), b3, voffB); PG8_STAGE(PG8_SB(1, 1), b3 + hstep, voffB); PG8_STAGE(PG8_SA(1, 0), a3, voffA);
            PG8_WAIT_V(8); PG8_WAIT_L(0); PG8_BAR; PG8_MMA(1, 0, At, B0); PG8_MMA(1, 1, At, B1); PG8_BAR; PG8_SCHED;
            } else {
            PG8_LDB(B0, 0, 0); PG8_SCHED; PG8_LDA(At, 0, 0); PG8_STAGE(PG8_SA(1, 1), a1 + hstep, voffA);
            PG8_WAIT_L(8); PG8_BAR; PG8_WAIT_L(0); PG8_MMA(0, 0, At, B0); PG8_BAR; PG8_SCHED;
            PG8_LDB(B1, 0, 1); PG8_STAGE(PG8_SB(0, 0), b2, voffB);
            PG8_BAR; PG8_WAIT_L(0); PG8_MMA(0, 1, At, B1); PG8_BAR;
            PG8_LDA(At, 0, 1); PG8_STAGE(PG8_SA(0, 0), a2, voffA);
            PG8_BAR; PG8_WAIT_L(0); PG8_MMA(1, 0, At, B0); PG8_BAR; PG8_SCHED;
            PG8_STAGE(PG8_SB(0, 1), b2 + hstep, voffB);
            PG8_WAIT_V(6); PG8_BAR; PG8_MMA(1, 1, At, B1); PG8_BAR;
            PG8_LDB(B0, 1, 0); PG8_SCHED; PG8_LDA(At, 1, 0); PG8_STAGE(PG8_SA(0, 1), a2 + hstep, voffA);
            PG8_WAIT_L(8); PG8_BAR; PG8_WAIT_L(0); PG8_MMA(0, 0, At, B0); PG8_BAR; PG8_SCHED;
            PG8_LDB(B1, 1, 1); PG8_STAGE(PG8_SB(1, 0), b3, voffB);
            PG8_BAR; PG8_WAIT_L(0); PG8_MMA(0, 1, At, B1); PG8_BAR;
            PG8_LDA(At, 1, 1); PG8_STAGE(PG8_SA(1, 0), a3, voffA);
            PG8_BAR; PG8_WAIT_L(0); PG8_MMA(1, 0, At, B0); PG8_BAR; PG8_SCHED;
            PG8_STAGE(PG8_SB(1, 1), b3 + hstep, voffB);
            PG8_WAIT_V(6); PG8_BAR; PG8_MMA(1, 1, At, B1); PG8_BAR;
            }
        }
        if constexpr (ALIGN_EPI) { if (wr == 0) PG8_BAR; }
        if constexpr (!Epi::AFTER_DRAIN) { E(acc, cur, wr, wc, fr, fq); S.done(cur); }
        if (!has_next) break;
#pragma unroll
        for (int a = 0; a < 2; ++a)
#pragma unroll
            for (int b = 0; b < 2; ++b)
#pragma unroll
                for (int m = 0; m < 4; ++m)
#pragma unroll
                    for (int n = 0; n < 2; ++n) acc[a][b][m][n] = (f32x4){0.f, 0.f, 0.f, 0.f};
        cur = nxt; cA = nA; cB = nB; ++ui;
        if constexpr (ALIGN_EPI) { if (wr == 1) PG8_BAR; }
    }
    PG8_WAIT_V(0);
    if constexpr (!ALIGN_EPI) { if (wr == 0) PG8_BAR; }
    PG8_BAR;
    if constexpr (Epi::AFTER_DRAIN) { E.fused(acc, cur, wr, wc, fr, fq, lds, wid, lane); S.done(cur); }
#undef PG8_SA
#undef PG8_SB
#undef PG8_STAGE
#undef PG8_LDA
#undef PG8_LDB
#undef PG8_MMA
#undef PG8_WAIT_V
#undef PG8_WAIT_L
#undef PG8_BAR
#undef PG8_SCHED
}
}

#define LAS __attribute__((address_space(3)))
typedef unsigned short bf16_t;
typedef short bf16x8 __attribute__((ext_vector_type(8)));
typedef short s16x4 __attribute__((ext_vector_type(4)));
typedef float f32x4 __attribute__((ext_vector_type(4)));
typedef unsigned u32x4 __attribute__((ext_vector_type(4)));
typedef unsigned u32x2 __attribute__((ext_vector_type(2)));

constexpr int T_ = 8192, D_ = 2048, FF_ = 5632, NIN_ = 15408, LDY = 15616, NADA = 18432;
constexpr int OFF_Q = 0, OFF_KV = 2048, OFF_QR = 5120, OFF_KR = 6144, OFF_VR = 7168, OFF_GR = 9216, OFF_GA = 11264, OFF_GB = 13312, OFF_GL = 15360;
constexpr float LOG2E = 1.4426950408889634f;
constexpr float EPS_ = 1e-6f;

constexpr size_t al256(size_t x) { return (x + 255) & ~(size_t)255; }
constexpr size_t WS_CTL = 0;
constexpr size_t WS_BAR = 8192;
constexpr size_t WS_ADA = 32768;
constexpr size_t WS_WGU = al256(WS_ADA + (size_t)4 * NADA * 4);
constexpr size_t WS_WD  = WS_WGU + (size_t)2 * FF_ * D_ * 2;
constexpr size_t WS_WIN = WS_WD + (size_t)D_ * FF_ * 2;
constexpr size_t WS_WPN = WS_WIN + (size_t)LDY * D_ * 2;
constexpr size_t WS_WPR = WS_WPN + (size_t)D_ * D_ * 2;
constexpr size_t WS_WO  = WS_WPR + (size_t)D_ * D_ * 2;
constexpr size_t WS_WC1 = WS_WO + (size_t)D_ * D_ * 2;
constexpr size_t WS_WC2 = WS_WC1 + (size_t)2 * 128 * 4096 * 2;
constexpr size_t WS_H   = WS_WC2 + (size_t)2 * 128 * 128 * 2;
constexpr size_t WS_Y   = WS_H + (size_t)T_ * D_ * 2;
constexpr size_t WS_MG  = WS_Y + (size_t)T_ * LDY * 2;
constexpr size_t WS_ORET = WS_MG + (size_t)T_ * D_ * 2;
constexpr size_t WS_VTS = WS_ORET + (size_t)T_ * D_ * 2;
constexpr size_t WS_VTW = WS_VTS + (size_t)16 * 128 * 2048 * 2;
constexpr size_t WS_VTR = WS_VTW + (size_t)16 * 128 * 2048 * 2;
constexpr size_t WS_KC  = WS_VTR + (size_t)32 * 256 * 2048 * 2;
constexpr size_t WS_VCT = WS_KC + (size_t)16 * 128 * 128 * 2;
constexpr size_t WS_KS  = WS_VCT + (size_t)16 * 128 * 128 * 2;
constexpr size_t WS_KW  = WS_KS + (size_t)16 * 2048 * 128 * 2;
constexpr size_t WS_KR  = WS_KW + (size_t)16 * 2048 * 128 * 2;
constexpr size_t WS_SM  = WS_KR + (size_t)32 * 2048 * 128 * 2;
constexpr size_t WS_END = WS_SM + (size_t)16 * 2048 * 4;

constexpr int LDS_BYTES = 131072 + 2048;

using pg8::cvt_pk_bf16;
__device__ __forceinline__ float bf_lo(unsigned w) { return __uint_as_float(w << 16); }
__device__ __forceinline__ float bf_hi(unsigned w) { return __uint_as_float(w & 0xffff0000u); }
__device__ __forceinline__ float bf2f(bf16_t h) { return __uint_as_float((unsigned)h << 16); }
__device__ __forceinline__ float ex2(float x) { return __builtin_amdgcn_exp2f(x); }
__device__ __forceinline__ float sigmoid_f(float x) { return __builtin_amdgcn_rcpf(1.0f + ex2(-x * LOG2E)); }
__device__ __forceinline__ float silu_f(float x) { return x * sigmoid_f(x); }
__device__ __forceinline__ float wave_sum(float v) {
#pragma unroll
    for (int o = 1; o < 64; o <<= 1) v += __shfl_xor(v, o);
    return v;
}
#define MFMA16(a, b, c) __builtin_amdgcn_mfma_f32_16x16x32_bf16((a), (b), (c), 0, 0, 0)
__device__ __forceinline__ float rowred_max(float x) {
    auto a = __builtin_amdgcn_permlane16_swap(__float_as_uint(x), __float_as_uint(x), false, false);
    x = fmaxf(__uint_as_float(a[0]), __uint_as_float(a[1]));
    auto b = __builtin_amdgcn_permlane32_swap(__float_as_uint(x), __float_as_uint(x), false, false);
    return fmaxf(__uint_as_float(b[0]), __uint_as_float(b[1]));
}
__device__ __forceinline__ float rowred_sum(float x) {
    auto a = __builtin_amdgcn_permlane16_swap(__float_as_uint(x), __float_as_uint(x), false, false);
    x = __uint_as_float(a[0]) + __uint_as_float(a[1]);
    auto b = __builtin_amdgcn_permlane32_swap(__float_as_uint(x), __float_as_uint(x), false, false);
    return __uint_as_float(b[0]) + __uint_as_float(b[1]);
}

struct EpiSwiglu {
    static constexpr bool PERM = true, AFTER_DRAIN = false;
    bf16_t* O;
    __device__ __forceinline__ void operator()(const f32x4 (&acc)[2][2][4][2], const pg8::Unit& u, int wr, int wc, int fr, int fq) const {
        const int row0 = u.pm * 256 + wr * 64 + fr, col0 = u.pn * 128 + wc * 32 + 8 * fq;
#pragma unroll
        for (int ai = 0; ai < 2; ++ai)
#pragma unroll
            for (int m = 0; m < 4; ++m) {
                bf16_t* rowp = O + (size_t)(row0 + ai * 128 + m * 16) * FF_ + col0;
                const f32x4 g0 = acc[ai][0][m][0], g1 = acc[ai][0][m][1], u0 = acc[ai][1][m][0], u1 = acc[ai][1][m][1];
                u32x4 w;
                w.x = cvt_pk_bf16(silu_f(g0[0]) * u0[0], silu_f(g0[1]) * u0[1]);
                w.y = cvt_pk_bf16(silu_f(g0[2]) * u0[2], silu_f(g0[3]) * u0[3]);
                w.z = cvt_pk_bf16(silu_f(g1[0]) * u1[0], silu_f(g1[1]) * u1[1]);
                w.w = cvt_pk_bf16(silu_f(g1[2]) * u1[2], silu_f(g1[3]) * u1[3]);
                *(u32x4*)rowp = w;
            }
    }
};
struct EpiResid {
    static constexpr bool PERM = false, AFTER_DRAIN = false;
    const float* base; float* out; const float* gate; float coef;
    __device__ __forceinline__ void operator()(const f32x4 (&acc)[2][2][4][2], const pg8::Unit& u, int wr, int wc, int fr, int fq) const {
        const int row0 = u.pm * 256 + wr * 64 + fr, col0 = u.pn * 256 + wc * 32 + 4 * fq, b = u.pm >> 3;
        f32x4 gv[2][2];
#pragma unroll
        for (int bj = 0; bj < 2; ++bj)
#pragma unroll
            for (int n = 0; n < 2; ++n) gv[bj][n] = *(const f32x4*)(gate + (size_t)b * NADA + col0 + bj * 128 + n * 16) * coef;
#pragma unroll
        for (int ai = 0; ai < 2; ++ai)
#pragma unroll
            for (int m = 0; m < 4; ++m) {
                const size_t off = (size_t)(row0 + ai * 128 + m * 16) * D_ + col0;
#pragma unroll
                for (int bj = 0; bj < 2; ++bj)
#pragma unroll
                    for (int n = 0; n < 2; ++n) {
                        const size_t o = off + bj * 128 + n * 16;
                        *(f32x4*)(out + o) = *(const f32x4*)(base + o) + gv[bj][n] * acc[ai][bj][m][n];
                    }
            }
    }
};
struct EpiY {
    static constexpr bool PERM = true, AFTER_DRAIN = false;
    bf16_t* O;
    __device__ __forceinline__ void operator()(const f32x4 (&acc)[2][2][4][2], const pg8::Unit& u, int wr, int wc, int fr, int fq) const {
        const int row0 = u.pm * 256 + wr * 64 + fr, col0 = u.pn * 256 + wc * 32 + 8 * fq;
#pragma unroll
        for (int ai = 0; ai < 2; ++ai)
#pragma unroll
            for (int m = 0; m < 4; ++m) {
                bf16_t* rowp = O + (size_t)(row0 + ai * 128 + m * 16) * LDY + col0;
#pragma unroll
                for (int bj = 0; bj < 2; ++bj) {
                    const f32x4 v0 = acc[ai][bj][m][0], v1 = acc[ai][bj][m][1];
                    u32x4 w; w.x = cvt_pk_bf16(v0[0], v0[1]); w.y = cvt_pk_bf16(v0[2], v0[3]); w.z = cvt_pk_bf16(v1[0], v1[1]); w.w = cvt_pk_bf16(v1[2], v1[3]);
                    *(u32x4*)(rowp + bj * 128) = w;
                }
            }
    }
};
template <bool ADD> struct EpiMerge {
    static constexpr bool PERM = true, AFTER_DRAIN = false;
    bf16_t* O; const bf16_t* Yg; int goff;
    __device__ __forceinline__ void operator()(const f32x4 (&acc)[2][2][4][2], const pg8::Unit& u, int wr, int wc, int fr, int fq) const {
        const int row0 = u.pm * 256 + wr * 64 + fr, col0 = u.pn * 256 + wc * 32 + 8 * fq;
#pragma unroll
        for (int ai = 0; ai < 2; ++ai)
#pragma unroll
            for (int m = 0; m < 4; ++m) {
                const int row = row0 + ai * 128 + m * 16;
#pragma unroll
                for (int bj = 0; bj < 2; ++bj) {
                    const int col = col0 + bj * 128;
                    const u32x4 gw = *(const u32x4*)(Yg + (size_t)row * LDY + goff + col);
                    const f32x4 v0 = acc[ai][bj][m][0], v1 = acc[ai][bj][m][1];
                    float r[8];
                    r[0] = sigmoid_f(bf_lo(gw.x)) * v0[0]; r[1] = sigmoid_f(bf_hi(gw.x)) * v0[1];
                    r[2] = sigmoid_f(bf_lo(gw.y)) * v0[2]; r[3] = sigmoid_f(bf_hi(gw.y)) * v0[3];
                    r[4] = sigmoid_f(bf_lo(gw.z)) * v1[0]; r[5] = sigmoid_f(bf_hi(gw.z)) * v1[1];
                    r[6] = sigmoid_f(bf_lo(gw.w)) * v1[2]; r[7] = sigmoid_f(bf_hi(gw.w)) * v1[3];
                    bf16_t* op = O + (size_t)row * D_ + col;
                    if (ADD) {
                        const u32x4 pw = *(const u32x4*)op;
                        r[0] += bf_lo(pw.x); r[1] += bf_hi(pw.x); r[2] += bf_lo(pw.y); r[3] += bf_hi(pw.y);
                        r[4] += bf_lo(pw.z); r[5] += bf_hi(pw.z); r[6] += bf_lo(pw.w); r[7] += bf_hi(pw.w);
                    }
                    u32x4 w; w.x = cvt_pk_bf16(r[0], r[1]); w.y = cvt_pk_bf16(r[2], r[3]); w.z = cvt_pk_bf16(r[4], r[5]); w.w = cvt_pk_bf16(r[6], r[7]);
                    *(u32x4*)op = w;
                }
            }
    }
};

__device__ __forceinline__ int rowmap(int mode, int n) {
    if (mode == 0) return n;
    if (mode == 1) return ((n >> 7) << 8) + (n & 127);
    if (mode == 2) return ((n >> 7) << 8) + 128 + (n & 127);
    return n < 5120 ? n : (n < 5168 ? OFF_GL + (n - 5120) : n - 48);
}
__device__ __forceinline__ void norm_rows(const float* __restrict__ X, const float* __restrict__ g, const float* __restrict__ ada, int ish, int isc, bf16_t* __restrict__ H, int gw, int NGW, int lane) {
    for (int m = gw; m < T_; m += NGW) {
        const int b = m >> 11;
        const f32x4* xr = (const f32x4*)(X + (size_t)m * D_) + lane;
        f32x4 v[8]; float ss = 0.f;
#pragma unroll
        for (int j = 0; j < 8; ++j) { v[j] = xr[64 * j]; ss += (v[j].x * v[j].x + v[j].y * v[j].y) + (v[j].z * v[j].z + v[j].w * v[j].w); }
        const float r = 1.0f / sqrtf(wave_sum(ss) * (1.0f / D_) + EPS_);
        const f32x4* gp = (const f32x4*)g + lane;
        const f32x4* sh = (const f32x4*)(ada + (size_t)b * NADA + ish * D_) + lane;
        const f32x4* sc = (const f32x4*)(ada + (size_t)b * NADA + isc * D_) + lane;
        u32x2* o = (u32x2*)(H + (size_t)m * D_) + lane;
#pragma unroll
        for (int j = 0; j < 8; ++j) {
            const f32x4 y = v[j] * r * gp[64 * j] * (sc[64 * j] + 1.0f) + sh[64 * j];
            u32x2 w; w.x = cvt_pk_bf16(y.x, y.y); w.y = cvt_pk_bf16(y.z, y.w); o[64 * j] = w;
        }
    }
}

#ifndef VPRE
#define VPRE 4
#endif
__device__ __forceinline__ void att_kdma(const bf16_t* __restrict__ Kf, int k0, int lane8, LAS unsigned char* ring) {
    const bf16_t* kb = Kf + (size_t)(k0 >> 4) * 2048 + lane8;
#pragma unroll
    for (int s8 = 0; s8 < 8; ++s8) __builtin_amdgcn_global_load_lds((const unsigned*)(kb + s8 * 512), (LAS unsigned*)(ring + s8 * 1024), 16, 0, 0);
}
template <int NR, int NDT, int MODE>
__device__ __forceinline__ void att_step(const bf16_t* __restrict__ Kf, const bf16_t* __restrict__ Vf, int k0, int k0n  , int tq  , int lane8  ,
                                         const LAS bf16x8* qs, LAS unsigned char* ring, int lane, f32x4 (&O)[NR][NDT], float (&m)[NR], float (&l)[NR], const float (&coef)[NR], bool vblk, bool full = false) {
    constexpr float SC = 0.08838834764831845f;
    const bf16_t* vb = Vf + (size_t)(k0 >> 5) * (NDT * 512) + lane8;
    const int dq = tq - k0;
    asm volatile("s_waitcnt vmcnt(0)" ::: "memory");
    bf16x8 vfr[NDT];
#pragma unroll
    for (int dt = 0; dt < NDT; ++dt) vfr[dt] = *(const bf16x8*)(vb + dt * 512);
    f32x4 sa[NR][2];
    const LAS bf16x8* kr = (const LAS bf16x8*)ring + lane;
#pragma unroll
    for (int kt = 0; kt < 2; ++kt) {
#pragma unroll
        for (int r = 0; r < NR; ++r) { sa[r][kt] = (f32x4){0.f, 0.f, 0.f, 0.f};
#pragma unroll
            for (int dc = 0; dc < 4; ++dc) sa[r][kt] = MFMA16(kr[(kt * 4 + dc) * 64], qs[(r * 4 + dc) * 64], sa[r][kt]); }
    }
    asm volatile("s_waitcnt lgkmcnt(0)" ::: "memory");
    __builtin_amdgcn_sched_barrier(0);
    if (k0n >= 0) att_kdma(Kf, k0n, lane8, ring);
    __builtin_amdgcn_sched_barrier(0);
    bf16x8 Pb[NR];
    const float dqf = (float)dq;
#pragma unroll
    for (int r = 0; r < NR; ++r) {
        f32x4 s[2]; s[0] = sa[r][0]; s[1] = sa[r][1];
        float p[2][4];
        if (MODE == 2) {
#pragma unroll
            for (int kt = 0; kt < 2; ++kt)
#pragma unroll
                for (int j = 0; j < 4; ++j) { const bool valid = dq >= (16 * kt + j); p[kt][j] = valid ? s[kt][j] * SC * ex2(coef[r] * (dqf - (float)(16 * kt + j))) : 0.f; }
        } else {
            float mx = -INFINITY;
            const float base = -coef[r] * dqf;
            if (full) {
#pragma unroll
                for (int kt = 0; kt < 2; ++kt)
#pragma unroll
                    for (int j = 0; j < 4; ++j) { const float v = fmaf(coef[r], (float)(16 * kt + j), fmaf(s[kt][j], SC * LOG2E, base)); p[kt][j] = v; mx = fmaxf(mx, v); }
            } else {
#pragma unroll
                for (int kt = 0; kt < 2; ++kt)
#pragma unroll
                    for (int j = 0; j < 4; ++j) {
                        const bool valid = (MODE == 0) ? (vblk && dq >= (16 * kt + j)) : (dq >= (16 * kt + j) && dq < 512 + (16 * kt + j));
                        const float v = valid ? fmaf(coef[r], (float)(16 * kt + j), fmaf(s[kt][j], SC * LOG2E, base)) : -INFINITY;
                        p[kt][j] = v; mx = fmaxf(mx, v);
                    }
            }
            mx = rowred_max(mx);
            const float mnew = (mx - m[r] > 8.0f) ? mx : m[r], muse = (mnew == -INFINITY) ? 0.f : mnew;
            float ps = 0.f;
#pragma unroll
            for (int kt = 0; kt < 2; ++kt)
#pragma unroll
                for (int j = 0; j < 4; ++j) { p[kt][j] = ex2(p[kt][j] - muse); ps += p[kt][j]; }
#ifdef ALWAYS_RESCALE
            {
#else
            if (__ballot(mnew != m[r]) != 0ull) {
#endif
                const float alpha = ex2(m[r] - muse);
                l[r] *= alpha;
#pragma unroll
                for (int dt = 0; dt < NDT; ++dt) O[r][dt] *= alpha;
            }
            l[r] += ps; m[r] = mnew;
        }
        u32x4 pw; pw.x = cvt_pk_bf16(p[0][0], p[0][1]); pw.y = cvt_pk_bf16(p[0][2], p[0][3]); pw.z = cvt_pk_bf16(p[1][0], p[1][1]); pw.w = cvt_pk_bf16(p[1][2], p[1][3]);
        Pb[r] = __builtin_bit_cast(bf16x8, pw);
    }
#pragma unroll
    for (int dt = 0; dt < NDT; ++dt) {
#pragma unroll
        for (int r = 0; r < NR; ++r) O[r][dt] = MFMA16(vfr[dt], Pb[r], O[r][dt]);
        if ((dt & 3) == 3) __builtin_amdgcn_sched_barrier(0);
    }
}

template <int VSTEP = 4096>
__device__ __forceinline__ void att_vdma(const bf16_t* __restrict__ Vf, int k0, int lane8, LAS unsigned char* ring) {
    const bf16_t* vb = Vf + (size_t)(k0 >> 5) * VSTEP + lane8;
#pragma unroll
    for (int dt = 0; dt < 8; ++dt) __builtin_amdgcn_global_load_lds((const unsigned*)(vb + dt * 512), (LAS unsigned*)(ring + 8192 + dt * 1024), 16, 0, 0);
}
template <int MODE, int TSTEP = 0  , int VSTEP = 4096>
__device__ __forceinline__ void att_step2(const bf16_t* __restrict__ Kf, const bf16_t* __restrict__ Vf, int k0, int k0n  , int tq  , int lane8,
                                          const bf16x8 (&Qf)[2][4], LAS unsigned char* ring, int lane, f32x4 (&O)[2][8], float (&m)[2], float (&l)[2], const float (&coef)[2], bool vblk, bool full) {
    constexpr float SC = 0.08838834764831845f;
    constexpr int NR = 2, NDT = 8;
    const int dq = tq - k0;
    const LAS bf16x8* kr = (const LAS bf16x8*)ring + lane;
    const LAS bf16x8* vr = (const LAS bf16x8*)(ring + 8192) + lane;
    asm volatile("s_waitcnt vmcnt(8)" ::: "memory");
    f32x4 sa[NR][2];
#pragma unroll
    for (int kt = 0; kt < 2; ++kt) {
#pragma unroll
        for (int r = 0; r < NR; ++r) sa[r][kt] = (f32x4){0.f, 0.f, 0.f, 0.f};
#pragma unroll
        for (int dc = 0; dc < 4; ++dc) { const bf16x8 kf = kr[(kt * 4 + dc) * 64];
#pragma unroll
            for (int r = 0; r < NR; ++r) sa[r][kt] = MFMA16(kf, Qf[r][dc], sa[r][kt]); }
    }
    asm volatile("s_waitcnt lgkmcnt(0)" ::: "memory");
    __builtin_amdgcn_sched_barrier(0);
    if (k0n >= 0) att_kdma(Kf, k0n, lane8, ring);
    __builtin_amdgcn_sched_barrier(0);
    bf16x8 Pb[NR];
    const float dqf = (float)dq;
#pragma unroll
    for (int r = 0; r < NR; ++r) {
        float p[2][4];
        if (MODE == 2) {
            const int dqr = dq + r * TSTEP; const float dqrf = (float)dqr;
#pragma unroll
            for (int kt = 0; kt < 2; ++kt)
#pragma unroll
                for (int j = 0; j < 4; ++j) p[kt][j] = (dqr >= (16 * kt + j)) ? sa[r][kt][j] * SC * ex2(coef[r] * (dqrf - (float)(16 * kt + j))) : 0.f;
        } else {
        float mx = -INFINITY;
        const float base = -coef[r] * dqf;
        if (full) {
#pragma unroll
            for (int kt = 0; kt < 2; ++kt)
#pragma unroll
                for (int j = 0; j < 4; ++j) { const float v = fmaf(coef[r], (float)(16 * kt + j), fmaf(sa[r][kt][j], SC * LOG2E, base)); p[kt][j] = v; mx = fmaxf(mx, v); }
        } else {
#pragma unroll
            for (int kt = 0; kt < 2; ++kt)
#pragma unroll
                for (int j = 0; j < 4; ++j) {
                    const bool valid = (MODE == 0) ? (vblk && dq >= (16 * kt + j)) : (dq >= (16 * kt + j) && dq < 512 + (16 * kt + j));
                    const float v = valid ? fmaf(coef[r], (float)(16 * kt + j), fmaf(sa[r][kt][j], SC * LOG2E, base)) : -INFINITY;
                    p[kt][j] = v; mx = fmaxf(mx, v);
                }
        }
        mx = rowred_max(mx);
        const float mnew = (mx - m[r] > 8.0f) ? mx : m[r], muse = (mnew == -INFINITY) ? 0.f : mnew;
        float ps = 0.f;
#pragma unroll
        for (int kt = 0; kt < 2; ++kt)
#pragma unroll
            for (int j = 0; j < 4; ++j) { p[kt][j] = ex2(p[kt][j] - muse); ps += p[kt][j]; }
        if (__ballot(mnew != m[r]) != 0ull) {
            const float alpha = ex2(m[r] - muse);
            l[r] *= alpha;
#pragma unroll
            for (int dt = 0; dt < NDT; ++dt) O[r][dt] *= alpha;
        }
        l[r] += ps; m[r] = mnew;
        }
        u32x4 pw; pw.x = cvt_pk_bf16(p[0][0], p[0][1]); pw.y = cvt_pk_bf16(p[0][2], p[0][3]); pw.z = cvt_pk_bf16(p[1][0], p[1][1]); pw.w = cvt_pk_bf16(p[1][2], p[1][3]);
        Pb[r] = __builtin_bit_cast(bf16x8, pw);
    }
    __builtin_amdgcn_sched_barrier(0);
    if (k0n >= 0) asm volatile("s_waitcnt vmcnt(8)" ::: "memory"); else asm volatile("s_waitcnt vmcnt(0)" ::: "memory");
#pragma unroll
    for (int dt = 0; dt < NDT; ++dt) { const bf16x8 vf = vr[dt * 64];
#pragma unroll
        for (int r = 0; r < NR; ++r) O[r][dt] = MFMA16(vf, Pb[r], O[r][dt]); }
    asm volatile("s_waitcnt lgkmcnt(0)" ::: "memory");
    __builtin_amdgcn_sched_barrier(0);
    if (k0n >= 0) att_vdma<VSTEP>(Vf, k0n, lane8, ring);
    __builtin_amdgcn_sched_barrier(0);
}

struct MixPtrs { const bf16_t* Y; bf16_t* ONSA; bf16_t* ORET; const bf16_t* VTS; const bf16_t* VTW; const bf16_t* VTR; const bf16_t* KC; const bf16_t* VCT; const float* gn; const bf16_t* KS; const bf16_t* KW; const bf16_t* KR; };

__device__ __forceinline__ void cmp_unit(const MixPtrs& P, unsigned* __restrict__ SM, int bg, int grp, LAS unsigned char* lds, int tid) {
    const int lane = tid & 63, wave = __builtin_amdgcn_readfirstlane(tid >> 6), l15 = lane & 15, fq = lane >> 4;
    const int b = bg >> 2, g = bg & 3, t0 = (grp * 8 + wave) * 16, t = t0 + l15;
#pragma unroll
    for (int i = 0; i < 8; ++i) {
        const int blk = wave * 8 + i;
        const bf16_t* src = (blk < 32 ? P.KC + (size_t)bg * 16384 + blk * 512 : P.VCT + (size_t)bg * 16384 + (blk - 32) * 512) + lane * 8;
        __builtin_amdgcn_global_load_lds((const unsigned*)src, (LAS unsigned*)(lds + blk * 1024), 16, 0, 0);
    }
    const bf16_t* Yt = P.Y + (size_t)(b * 2048 + t) * LDY;
    bf16_t* orow = P.ONSA + (size_t)(b * 2048 + t) * D_;
    constexpr float SC2 = 0.08838834764831845f * LOG2E;
    const int tq64 = t - 64 * fq; const float tq64f = (float)tq64 - 15.5f;
    const LAS bf16x8* kl = (const LAS bf16x8*)lds + lane;
    const LAS bf16x8* vl = (const LAS bf16x8*)(lds + 32768) + lane;
    float pown[8], ptail[8];
#pragma unroll
    for (int kt = 0; kt < 8; ++kt) { pown[kt] = 0.f; ptail[kt] = 0.f; }
    asm volatile("s_waitcnt vmcnt(0)" ::: "memory");
    __syncthreads();
#pragma unroll 1
    for (int hd = 0; hd < 4; ++hd) {
        const int hh = 4 * g + hd;
        bf16x8 Qf[4];
#pragma unroll
        for (int dc = 0; dc < 4; ++dc) Qf[dc] = *(const bf16x8*)(Yt + OFF_Q + hh * 128 + 32 * dc + 8 * fq);
        const float gate = sigmoid_f(bf2f(Yt[OFF_GL + hh]));
        f32x4 s[8];
#pragma unroll
        for (int kt = 0; kt < 8; ++kt) { s[kt] = (f32x4){0.f, 0.f, 0.f, 0.f};
#pragma unroll
            for (int dc = 0; dc < 4; ++dc) s[kt] = MFMA16(kl[(kt * 4 + dc) * 64], Qf[dc], s[kt]); }
        const float slope2 = ex2(-0.5f * (float)(hh + 1)) * LOG2E;
        float mx = -INFINITY;
#pragma unroll
        for (int kt = 0; kt < 8; ++kt)
#pragma unroll
            for (int j = 0; j < 4; ++j) {
                const bool valid = (256 * kt + 16 * j + 31) <= tq64;
                const float v = valid ? s[kt][j] * SC2 - slope2 * (tq64f - (float)(256 * kt + 16 * j)) : -INFINITY;
                s[kt][j] = v; mx = fmaxf(mx, v);
            }
        mx = rowred_max(mx);
        const float muse = (mx == -INFINITY) ? 0.f : mx;
        float ls = 0.f;
#pragma unroll
        for (int kt = 0; kt < 8; ++kt)
#pragma unroll
            for (int j = 0; j < 4; ++j) { const float pv = ex2(s[kt][j] - muse); s[kt][j] = pv; ls += pv; }
        ls = rowred_sum(ls);
        const float inv = 1.0f / fmaxf(ls, 1.17549435e-38f);
#pragma unroll
        for (int kt = 0; kt < 8; ++kt)
#pragma unroll
            for (int j = 0; j < 4; ++j) s[kt][j] *= inv;
#pragma unroll
        for (int kt = 0; kt < 8; ++kt) { const float h3 = 0.5f * s[kt][3]; ptail[kt] += h3; pown[kt] += ((s[kt][0] + s[kt][1]) + s[kt][2]) + h3; }
        f32x4 O[8];
#pragma unroll
        for (int dt = 0; dt < 8; ++dt) O[dt] = (f32x4){0.f, 0.f, 0.f, 0.f};
#pragma unroll
        for (int ks = 0; ks < 4; ++ks) {
            u32x4 pw; pw.x = cvt_pk_bf16(s[2 * ks][0], s[2 * ks][1]); pw.y = cvt_pk_bf16(s[2 * ks][2], s[2 * ks][3]);
            pw.z = cvt_pk_bf16(s[2 * ks + 1][0], s[2 * ks + 1][1]); pw.w = cvt_pk_bf16(s[2 * ks + 1][2], s[2 * ks + 1][3]);
            const bf16x8 Pb = __builtin_bit_cast(bf16x8, pw);
#pragma unroll
            for (int dt = 0; dt < 8; ++dt) O[dt] = MFMA16(vl[(ks * 8 + dt) * 64], Pb, O[dt]);
        }
#pragma unroll
        for (int dt = 0; dt < 8; ++dt) {
            u32x2 w; w.x = cvt_pk_bf16(O[dt][0] * gate, O[dt][1] * gate); w.y = cvt_pk_bf16(O[dt][2] * gate, O[dt][3] * gate);
            *(u32x2*)(orow + hh * 128 + 16 * dt + 4 * fq) = w;
        }
    }
    {
        float val[8], sh[8];
        const int bq = (t >> 6) - fq;
#pragma unroll
        for (int kt = 0; kt < 8; ++kt) sh[kt] = __shfl(ptail[kt], (lane + 48) & 63);
#pragma unroll
        for (int kt = 0; kt < 8; ++kt) {
            const float prev = fq > 0 ? sh[kt] : (kt > 0 ? sh[kt > 0 ? kt - 1 : 0] : 0.f);
            const float imp = pown[kt] + prev;
            const bool forced = (kt == 0 && fq == 0) || (4 * kt == bq) || (4 * kt == bq - 1);
            val[kt] = forced ? 1e4f : (4 * kt <= bq ? imp : -1e4f);
        }
        int cnt[8];
#pragma unroll
        for (int kt = 0; kt < 8; ++kt) cnt[kt] = 0;
#pragma unroll 1
        for (int f2 = 0; f2 < 4; ++f2) {
            const int df = fq - f2;
#pragma unroll
            for (int k2 = 0; k2 < 8; ++k2) {
                const float o = __shfl(val[k2], l15 + 16 * f2);
#pragma unroll
                for (int kt = 0; kt < 8; ++kt) cnt[kt] += ((o > val[kt]) || (o == val[kt] && (4 * (k2 - kt)) < df)) ? 1 : 0;
            }
        }
        unsigned smq = 0;
#pragma unroll
        for (int kt = 0; kt < 8; ++kt) if (cnt[kt] < 16) smq |= 1u << (4 * kt);
        unsigned sm = smq << fq;
        sm |= __shfl_xor(sm, 16); sm |= __shfl_xor(sm, 32);
        if (fq == 0) SM[bg * 2048 + t] = sm;
    }
    __syncthreads();
}

__device__ __forceinline__ void nsa_unit(const MixPtrs& P, const unsigned* __restrict__ SM, int b, int g, int tile, int hp  , int lane, LAS bf16x8* qs  , LAS unsigned char* qbase  ) {
    const int l15 = lane & 15, fq = lane >> 4, t0 = tile * 16, t = t0 + l15, bg = b * 4 + g;
    const bf16_t* Yt = P.Y + (size_t)(b * 2048 + t) * LDY;
    bf16_t* orow = P.ONSA + (size_t)(b * 2048 + t) * D_;
    const int tq = t - 4 * fq, lane8 = lane * 8;
    const unsigned sm = SM[bg * 2048 + t];
    bf16x8 Qf[2][4];
#pragma unroll
    for (int r = 0; r < 2; ++r)
#pragma unroll
        for (int dc = 0; dc < 4; ++dc) Qf[r][dc] = *(const bf16x8*)(Yt + OFF_Q + (4 * g + 2 * hp + r) * 128 + 32 * dc + 8 * fq);
    {
        float coef[2], m[2], l[2]; f32x4 O[2][8];
        LAS unsigned char* ring = qbase;
#pragma unroll
        for (int r = 0; r < 2; ++r) coef[r] = ex2(-0.5f * (float)(4 * g + 2 * hp + r + 1)) * LOG2E;
#pragma unroll 1
        for (int br = 1; br < 3; ++br) {
#pragma unroll
            for (int r = 0; r < 2; ++r) { m[r] = -INFINITY; l[r] = 0.f;
#pragma unroll
                for (int dt = 0; dt < 8; ++dt) O[r][dt] = (f32x4){0.f, 0.f, 0.f, 0.f}; }
            asm volatile("s_waitcnt vmcnt(0) lgkmcnt(0)" ::: "memory");
            if (br == 1) {
                const bf16_t* Kp = P.KS + (size_t)bg * 262144; const bf16_t* Vt = P.VTS + (size_t)bg * 262144;
                const int blkmax = (t0 + 15) >> 6;
                unsigned U = 0;
#pragma unroll 1
                for (int jb = 0; jb <= blkmax; ++jb) if (__ballot((sm >> jb) & 1u) != 0ull) U |= 1u << jb;
                int jb = __builtin_ctz(U), k0 = 64 * jb;
                att_kdma(Kp, k0, lane8, ring); att_vdma(Vt, k0, lane8, ring);
#pragma unroll 1
                for (;;) {
                    int k0n, jbn = jb;
                    if ((k0 & 32) == 0) k0n = k0 + 32;
                    else { const unsigned rest = jb >= 31 ? 0u : (U >> (jb + 1)); if (rest == 0u) k0n = -1; else { jbn = jb + 1 + __builtin_ctz(rest); k0n = 64 * jbn; } }
                    const bool vb = (sm >> jb) & 1u;
                    const bool full = (k0 + 31 <= t0) && (__ballot(vb) == ~0ull);
                    att_step2<0>(Kp, Vt, k0, k0n, tq, lane8, Qf, ring, lane, O, m, l, coef, vb, full);
                    if (k0n < 0) break;
                    k0 = k0n; jb = jbn;
                }
            } else {
                const bf16_t* Kp = P.KW + (size_t)bg * 262144; const bf16_t* Vt = P.VTW + (size_t)bg * 262144;
                int kstart = t0 - 511; kstart = kstart < 0 ? 0 : (kstart & ~31);
                att_kdma(Kp, kstart, lane8, ring); att_vdma(Vt, kstart, lane8, ring);
#pragma unroll 1
                for (int k0 = kstart; k0 <= t0; k0 += 32) att_step2<1>(Kp, Vt, k0, (k0 + 32 <= t0) ? k0 + 32 : -1, tq, lane8, Qf, ring, lane, O, m, l, coef, true, (k0 + 31 <= t0) && (k0 >= t0 - 496));
            }
#pragma unroll
            for (int r = 0; r < 2; ++r) {
                const int hh = 4 * g + 2 * hp + r;
                const float lt = rowred_sum(l[r]);
                const float sc = sigmoid_f(bf2f(Yt[OFF_GL + br * 16 + hh])) / fmaxf(lt, 1.17549435e-38f);
#pragma unroll
                for (int dt = 0; dt < 8; ++dt) {
                    u32x2* op = (u32x2*)(orow + hh * 128 + 16 * dt + 4 * fq);
                    const u32x2 pw = *op;
                    u32x2 w; w.x = cvt_pk_bf16(bf_lo(pw.x) + O[r][dt][0] * sc, bf_hi(pw.x) + O[r][dt][1] * sc);
                    w.y = cvt_pk_bf16(bf_lo(pw.y) + O[r][dt][2] * sc, bf_hi(pw.y) + O[r][dt][3] * sc);
                    *op = w;
                }
            }
        }
    }
}

__device__ __forceinline__ void ret_unit(const MixPtrs& P, int b, int h, int tile, int lane, LAS bf16x8* qs, LAS unsigned char* qbase) {
    const int l15 = lane & 15, fq = lane >> 4, t0 = tile * 16, t = t0 + l15;
    const bf16_t* Yb = P.Y + (size_t)(b * 2048) * LDY;
    const bf16_t* Yt = Yb + (size_t)t * LDY;
    float coef[1], m[1], l[1]; f32x4 O[1][16];
    const LAS bf16x8* Qf = qs;
#pragma unroll
    for (int dc = 0; dc < 4; ++dc) qs[dc * 64] = *(const bf16x8*)(Yt + OFF_QR + h * 128 + 32 * dc + 8 * fq);
    coef[0] = log1pf(-exp2f(-5.0f - (float)h)) * LOG2E; m[0] = 0.f; l[0] = 0.f;
#pragma unroll
    for (int dt = 0; dt < 16; ++dt) O[0][dt] = (f32x4){0.f, 0.f, 0.f, 0.f};
    const bf16_t* Kp = P.KR + (size_t)(b * 8 + h) * 262144; const bf16_t* Vt = P.VTR + (size_t)(b * 8 + h) * 524288;
    LAS unsigned char* ring = qbase + 8192;
    asm volatile("s_waitcnt lgkmcnt(0)" ::: "memory");
    att_kdma(Kp, 0, lane * 8, ring);
#pragma unroll 1
    for (int k0 = 0; k0 <= t0; k0 += 32) att_step<1, 16, 2>(Kp, Vt, k0, (k0 + 32 <= t0) ? k0 + 32 : -1, t - 4 * fq, lane * 8, Qf, ring, lane, O, m, l, coef, true);
    float sum = 0.f;
#pragma unroll
    for (int dt = 0; dt < 16; ++dt) sum += (O[0][dt][0] + O[0][dt][1]) + (O[0][dt][2] + O[0][dt][3]);
    sum = rowred_sum(sum);
    const float mean = sum * (1.0f / 256.0f);
    float var = 0.f;
#pragma unroll
    for (int dt = 0; dt < 16; ++dt) { const f32x4 d = O[0][dt] - mean; var += (d[0] * d[0] + d[1] * d[1]) + (d[2] * d[2] + d[3] * d[3]); }
    var = rowred_sum(var);
    const float rstd = 1.0f / sqrtf(var * (1.0f / 256.0f) + EPS_);
    bf16_t* orow = P.ORET + (size_t)(b * 2048 + t) * D_ + h * 256;
#pragma unroll
    for (int dt = 0; dt < 16; ++dt) {
        const int e = 16 * dt + 4 * fq;
        const f32x4 gain = *(const f32x4*)(P.gn + h * 256 + e);
        const u32x2 gw = *(const u32x2*)(Yt + OFF_GR + h * 256 + e);
        const f32x4 y = (O[0][dt] - mean) * rstd * gain;
        u32x2 w; w.x = cvt_pk_bf16(silu_f(bf_lo(gw.x)) * y[0], silu_f(bf_hi(gw.x)) * y[1]); w.y = cvt_pk_bf16(silu_f(bf_lo(gw.y)) * y[2], silu_f(bf_hi(gw.y)) * y[3]);
        *(u32x2*)(orow + e) = w;
    }
}

__device__ __forceinline__ void ret_unit2(const MixPtrs& P, int b, int h, int tile32, int lane, LAS unsigned char* ring) {
    const int l15 = lane & 15, fq = lane >> 4, t0 = tile32 * 32, lane8 = lane * 8;
    const bf16_t* Yb = P.Y + (size_t)(b * 2048) * LDY;
    bf16x8 Qf[2][4]; float coef[2], m[2], l[2]; f32x4 O[2][8], Oa[2][8];
#pragma unroll
    for (int r = 0; r < 2; ++r)
#pragma unroll
        for (int dc = 0; dc < 4; ++dc) Qf[r][dc] = *(const bf16x8*)(Yb + (size_t)(t0 + 16 * r + l15) * LDY + OFF_QR + h * 128 + 32 * dc + 8 * fq);
    coef[0] = log1pf(-exp2f(-5.0f - (float)h)) * LOG2E; coef[1] = coef[0]; m[0] = m[1] = 0.f; l[0] = l[1] = 0.f;
    const bf16_t* Kp = P.KR + (size_t)(b * 8 + h) * 262144;
    const int tq = t0 + l15 - 4 * fq;
#pragma unroll
    for (int hf = 0; hf < 2; ++hf) {
        const bf16_t* Vt = P.VTR + (size_t)(b * 8 + h) * 524288 + hf * 4096;
#pragma unroll
        for (int r = 0; r < 2; ++r)
#pragma unroll
            for (int dt = 0; dt < 8; ++dt) O[r][dt] = (f32x4){0.f, 0.f, 0.f, 0.f};
        asm volatile("s_waitcnt vmcnt(0) lgkmcnt(0)" ::: "memory");
        att_kdma(Kp, 0, lane8, ring); att_vdma<8192>(Vt, 0, lane8, ring);
#pragma unroll 1
        for (int k0 = 0; k0 <= t0; k0 += 32) att_step2<2, 16, 8192>(Kp, Vt, k0, (k0 + 32 <= t0) ? k0 + 32 : -1, tq, lane8, Qf, ring, lane, O, m, l, coef, true, false);
        if (hf == 0) {
#pragma unroll
            for (int r = 0; r < 2; ++r)
#pragma unroll
                for (int dt = 0; dt < 8; ++dt) Oa[r][dt] = O[r][dt];
        }
    }
#pragma unroll
    for (int r = 0; r < 2; ++r) {
        float sum = 0.f;
#pragma unroll
        for (int dt = 0; dt < 8; ++dt) sum += ((Oa[r][dt][0] + Oa[r][dt][1]) + (Oa[r][dt][2] + Oa[r][dt][3])) + ((O[r][dt][0] + O[r][dt][1]) + (O[r][dt][2] + O[r][dt][3]));
        sum = rowred_sum(sum);
        const float mean = sum * (1.0f / 256.0f);
        float var = 0.f;
#pragma unroll
        for (int dt = 0; dt < 8; ++dt) { const f32x4 d0 = Oa[r][dt] - mean, d1 = O[r][dt] - mean;
            var += ((d0[0] * d0[0] + d0[1] * d0[1]) + (d0[2] * d0[2] + d0[3] * d0[3])) + ((d1[0] * d1[0] + d1[1] * d1[1]) + (d1[2] * d1[2] + d1[3] * d1[3])); }
        var = rowred_sum(var);
        const float rstd = 1.0f / sqrtf(var * (1.0f / 256.0f) + EPS_);
        const int t = t0 + 16 * r + l15;
        const bf16_t* Yt = Yb + (size_t)t * LDY;
        bf16_t* orow = P.ORET + (size_t)(b * 2048 + t) * D_ + h * 256;
#pragma unroll
        for (int hf = 0; hf < 2; ++hf)
#pragma unroll
            for (int dt = 0; dt < 8; ++dt) {
                const int e = 128 * hf + 16 * dt + 4 * fq;
                const f32x4 gain = *(const f32x4*)(P.gn + h * 256 + e);
                const u32x2 gw = *(const u32x2*)(Yt + OFF_GR + h * 256 + e);
                const f32x4 y = ((hf ? O[r][dt] : Oa[r][dt]) - mean) * rstd * gain;
                u32x2 w; w.x = cvt_pk_bf16(silu_f(bf_lo(gw.x)) * y[0], silu_f(bf_hi(gw.x)) * y[1]); w.y = cvt_pk_bf16(silu_f(bf_lo(gw.y)) * y[2], silu_f(bf_hi(gw.y)) * y[3]);
                *(u32x2*)(orow + e) = w;
            }
    }
}

__device__ __forceinline__ void compress_unit(int unit, const bf16_t* __restrict__ Y, const float* __restrict__ cmp_pos, const float* __restrict__ cmp_b1, const float* __restrict__ g_qk,
                                              const bf16_t* __restrict__ WC1, const bf16_t* __restrict__ WC2, bf16_t* __restrict__ KC, bf16_t* __restrict__ VCT, LAS unsigned char* lds, int tid) {
    const int lane = tid & 63, wave = tid >> 6, l15 = lane & 15, fq = lane >> 4;
    const int i = unit >> 7, bg = (unit >> 3) & 15, ct = unit & 7, b = bg >> 2, g = bg & 3;
    const int c = 16 * ct + l15; const bool cvalid = c < 127;
    const bf16_t* Yc = Y + (size_t)(b * 2048 + 16 * (cvalid ? c : 0)) * LDY + OFF_KV + i * 512 + g * 128;
    LAS float* red = (LAS float*)lds;
    LAS bf16_t* hid = (LAS bf16_t*)(lds + 65536);
    f32x4 acc[8];
#pragma unroll
    for (int nt = 0; nt < 8; ++nt) acc[nt] = (f32x4){0.f, 0.f, 0.f, 0.f};
#pragma unroll 1
    for (int ls = 0; ls < 4; ++ls) {
        const int l = 4 * wave + ls;
#pragma unroll
        for (int dc = 0; dc < 4; ++dc) {
            const int d = 32 * dc + 8 * fq;
            u32x4 aw = (u32x4){0u, 0u, 0u, 0u};
            if (cvalid) {
                const u32x4 zw = *(const u32x4*)(Yc + (size_t)l * LDY + d);
                const f32x4 p0 = *(const f32x4*)(cmp_pos + (size_t)(i * 32 + l) * 128 + d), p1 = *(const f32x4*)(cmp_pos + (size_t)(i * 32 + l) * 128 + d + 4);
                aw.x = cvt_pk_bf16(bf_lo(zw.x) + p0[0], bf_hi(zw.x) + p0[1]); aw.y = cvt_pk_bf16(bf_lo(zw.y) + p0[2], bf_hi(zw.y) + p0[3]);
                aw.z = cvt_pk_bf16(bf_lo(zw.z) + p1[0], bf_hi(zw.z) + p1[1]); aw.w = cvt_pk_bf16(bf_lo(zw.w) + p1[2], bf_hi(zw.w) + p1[3]);
            }
            const bf16x8 a = __builtin_bit_cast(bf16x8, aw);
            const int kidx = l * 128 + 32 * dc + 8 * fq;
#pragma unroll
            for (int nt = 0; nt < 8; ++nt) { const bf16x8 bf = *(const bf16x8*)(WC1 + (size_t)i * 524288 + (size_t)(((l * 4 + dc) * 8 + nt) * 64 + lane) * 8); acc[nt] = MFMA16(a, bf, acc[nt]); }
        }
    }
#pragma unroll
    for (int nt = 0; nt < 8; ++nt)
#pragma unroll
        for (int j = 0; j < 4; ++j) red[(wave * 16 + 4 * fq + j) * 128 + 16 * nt + l15] = acc[nt][j];
    __syncthreads();
    {
        const int e = tid * 4, cc = e >> 7, n = e & 127;
        f32x4 s = *(const f32x4*)(cmp_b1 + i * 128 + n);
#pragma unroll
        for (int w = 0; w < 8; ++w) s += *(const LAS f32x4*)(red + (w * 16 + cc) * 128 + n);
        float o[4];
#pragma unroll
        for (int j = 0; j < 4; ++j) { const float x = s[j]; o[j] = 0.5f * x * (1.0f + tanhf(0.7978845608028654f * (x + 0.044715f * x * x * x))); }
        u32x2 w; w.x = cvt_pk_bf16(o[0], o[1]); w.y = cvt_pk_bf16(o[2], o[3]);
        *(LAS u32x2*)(hid + cc * 136 + n) = w;
    }
    __syncthreads();
    f32x4 o2 = (f32x4){0.f, 0.f, 0.f, 0.f};
#pragma unroll
    for (int kc = 0; kc < 4; ++kc) {
        const bf16x8 a = *(const LAS bf16x8*)(hid + l15 * 136 + 32 * kc + 8 * fq);
        const bf16x8 bf = *(const bf16x8*)(WC2 + (size_t)(i * 128 + 16 * wave + l15) * 128 + 32 * kc + 8 * fq);
        o2 = MFMA16(a, bf, o2);
    }
    if (i == 1) {
        const int cbase = 16 * ct + 4 * fq;
        u32x2 w; w.x = cvt_pk_bf16(cbase + 0 < 127 ? o2[0] : 0.f, cbase + 1 < 127 ? o2[1] : 0.f); w.y = cvt_pk_bf16(cbase + 2 < 127 ? o2[2] : 0.f, cbase + 3 < 127 ? o2[3] : 0.f);
        *(u32x2*)(VCT + (size_t)bg * 16384 + (((ct >> 1) * 8 + wave) * 64 + lane) * 8 + 4 * (ct & 1)) = w;
    } else {
#pragma unroll
        for (int j = 0; j < 4; ++j) red[(4 * fq + j) * 128 + 16 * wave + l15] = o2[j];
        __syncthreads();
        const int cc = tid >> 5, part = tid & 31;
        const f32x4 v = *(const LAS f32x4*)(red + cc * 128 + 4 * part);
        float ss = (v[0] * v[0] + v[1] * v[1]) + (v[2] * v[2] + v[3] * v[3]);
#pragma unroll
        for (int o = 1; o < 32; o <<= 1) ss += __shfl_xor(ss, o);
        const float r = 1.0f / sqrtf(ss * (1.0f / 128.0f) + EPS_);
        const f32x4 gq = *(const f32x4*)(g_qk + 128 + 4 * part);
        f32x4 y = v * r * gq;
        if (16 * ct + cc >= 127) y = (f32x4){0.f, 0.f, 0.f, 0.f};
        u32x2 w; w.x = cvt_pk_bf16(y[0], y[1]); w.y = cvt_pk_bf16(y[2], y[3]);
        *(u32x2*)(KC + (size_t)bg * 16384 + (ct * 4 + (part >> 3)) * 512 + ((part >> 1) & 3) * 128 + cc * 8 + 4 * (part & 1)) = w;
    }
    __syncthreads();
}


#define XB_TMO      128
#define XB_XCNT(j)  (256  + 64 * (j))
#define XB_XSUB(j)  (1280 + 64 * (j))
#define XB_XGEN(j)  (2304 + 64 * (j))
#define XB_TOP      3328
#define XB_TOPGEN   3392
#define XCD_BAR_WORDS 3456
#define XB_SPIN_CAP (1u << 18)
__device__ __forceinline__ unsigned xb_ld(unsigned* p)              { return __hip_atomic_load(p, __ATOMIC_RELAXED, __HIP_MEMORY_SCOPE_AGENT); }
__device__ __forceinline__ unsigned xb_add(unsigned* p, unsigned v) { return __hip_atomic_fetch_add(p, v, __ATOMIC_RELAXED, __HIP_MEMORY_SCOPE_AGENT); }
__device__ __forceinline__ unsigned xb_xcc_id() { return (unsigned)__builtin_amdgcn_s_getreg((3 << 11) | 20) & 0xFu; }
#define XB_SPIN(cond, bar) do { unsigned _sp = 0; while (cond) { __builtin_amdgcn_s_sleep(1); \
    if ((++_sp & 255u) == 0u) { if (xb_ld(&(bar)[XB_TMO])) break; if (_sp > XB_SPIN_CAP) { atomicAdd(&(bar)[XB_TMO], 1u); break; } } } } while (0)
struct XcdBarrier { unsigned* bar; unsigned x; volatile LAS unsigned* st; };
__device__ __forceinline__ XcdBarrier xcd_barrier_post(unsigned* bar, volatile LAS unsigned* st) {
    XcdBarrier b; b.bar = bar; b.x = xb_xcc_id(); b.st = st;
    if (threadIdx.x == 0) (void)xb_add(&bar[XB_XCNT(b.x)], 1u);
    return b;
}
__device__ __forceinline__ void xcd_barrier_complete(unsigned* bar, unsigned x, unsigned& nloc, unsigned& nx) {
    const unsigned G = gridDim.x * gridDim.y * gridDim.z;
    unsigned sum, cnt, mine, sp = 0u;
    for (;;) {
        sum = 0u; cnt = 0u; mine = 0u;
#pragma unroll
        for (unsigned j = 0; j < 16; ++j) { const unsigned c = xb_ld(&bar[XB_XCNT(j)]); sum += c; cnt += (c > 0u) ? 1u : 0u; mine = (j == x) ? c : mine; }
        if (sum == G) break;
        __builtin_amdgcn_s_sleep(1);
        if ((++sp & 255u) == 0u) { if (xb_ld(&bar[XB_TMO])) break; if (sp > XB_SPIN_CAP) { atomicAdd(&bar[XB_TMO], 1u); break; } }
    }
    nloc = mine > 0u ? mine : 1u; nx = cnt > 0u ? cnt : 1u;
}
__device__ __forceinline__ void xcd_barrier(const XcdBarrier& b) {
    asm volatile("s_waitcnt vmcnt(0)" ::: "memory");
    __syncthreads();
    if (threadIdx.x == 0) {
        unsigned* bar = b.bar;
        __builtin_amdgcn_s_waitcnt(0);
        unsigned nloc = b.st[0], nx = b.st[1];
        if (nloc == 0u) { xcd_barrier_complete(bar, b.x, nloc, nx); b.st[0] = nloc; b.st[1] = nx; }
        const unsigned old = xb_add(&bar[XB_XSUB(b.x)], 1u);
        const unsigned gen = old / nloc;
        if (old + 1u == (gen + 1u) * nloc) {
            __builtin_amdgcn_fence(__ATOMIC_RELEASE, "agent");
            asm volatile("s_waitcnt vmcnt(0)" ::: "memory");
            const unsigned og = xb_add(&bar[XB_TOP], 1u);
            const unsigned tg = og / nx;
            if (og + 1u == (tg + 1u) * nx) xb_add(&bar[XB_TOPGEN], 1u);
            else XB_SPIN(xb_ld(&bar[XB_TOPGEN]) == tg, bar);
            __builtin_amdgcn_fence(__ATOMIC_ACQUIRE, "agent");
            xb_add(&bar[XB_XGEN(b.x)], 1u);
            asm volatile("s_waitcnt vmcnt(0)" ::: "memory");
        } else {
            XB_SPIN(xb_ld(&bar[XB_XGEN(b.x)]) == gen, bar);
            __builtin_amdgcn_fence(__ATOMIC_ACQUIRE, "agent");
            asm volatile("s_waitcnt vmcnt(0)" ::: "memory");
        }
    }
    __syncthreads();
}

struct Params {
    const float *x, *c, *w_ada, *b_ada, *g_norm, *w_gate, *w_up, *w_down, *w_in, *g_qk, *cmp_pos, *cmp_w1, *cmp_b1, *cmp_w2, *gn_gain, *w_pn, *w_pr, *w_out;
    float* out; unsigned char* ws; int mask; int pad;
};

struct ConvTile { const float* W; bf16_t* WT; int K, N, mode, k0, n0; };
__device__ __forceinline__ ConvTile conv_tile(const Params& p, int set, int idx) {
    ConvTile c; int r = idx, nbn;
    constexpr int T_GU = (D_ / 128) * (FF_ / 128), T_IN = (D_ / 128) * ((NIN_ + 127) / 128), T_P = (D_ / 128) * (D_ / 128), T_C1 = 4096 / 128;
    const int layer = set;
    if (set == 1 || r < 3 * T_GU) {
        if (r < T_GU) { c.W = p.w_gate + (size_t)layer * D_ * FF_; c.WT = (bf16_t*)(p.ws + WS_WGU); c.K = D_; c.N = FF_; c.mode = 1; }
        else if (r < 2 * T_GU) { r -= T_GU; c.W = p.w_up + (size_t)layer * D_ * FF_; c.WT = (bf16_t*)(p.ws + WS_WGU); c.K = D_; c.N = FF_; c.mode = 2; }
        else { r -= 2 * T_GU; c.W = p.w_down + (size_t)layer * D_ * FF_; c.WT = (bf16_t*)(p.ws + WS_WD); c.K = FF_; c.N = D_; c.mode = 0; }
    } else {
        r -= 3 * T_GU;
        if (r < T_IN) { c.W = p.w_in; c.WT = (bf16_t*)(p.ws + WS_WIN); c.K = D_; c.N = NIN_; c.mode = 3; }
        else if (r < T_IN + 3 * T_P) { r -= T_IN; const int w = r / T_P; r -= w * T_P; c.W = w == 0 ? p.w_pn : (w == 1 ? p.w_pr : p.w_out);
            c.WT = (bf16_t*)(p.ws + (w == 0 ? WS_WPN : (w == 1 ? WS_WPR : WS_WO))); c.K = D_; c.N = D_; c.mode = 0; }
        else if (r < T_IN + 3 * T_P + 2 * T_C1) { r -= T_IN + 3 * T_P; const int i = r / T_C1; r -= i * T_C1; c.W = p.cmp_w1 + (size_t)i * 4096 * 128; c.WT = (bf16_t*)(p.ws + WS_WC1) + (size_t)i * 128 * 4096; c.K = 4096; c.N = 128; c.mode = 4; }
        else { r -= T_IN + 3 * T_P + 2 * T_C1; c.W = p.cmp_w2 + (size_t)r * 128 * 128; c.WT = (bf16_t*)(p.ws + WS_WC2) + (size_t)r * 128 * 128; c.K = 128; c.N = 128; c.mode = 0; r = 0; }
    }
    nbn = (c.N + 127) >> 7;
    const int kb = r / nbn, nb = r - kb * nbn; c.k0 = kb * 128; c.n0 = nb * 128;
    return c;
}
__device__ __forceinline__ void conv_load(const ConvTile& c, int tid, f32x4 (&r)[8]) {
    const int c4 = (tid & 31) * 4, r0 = 2 * (tid >> 5);
    const bool ok = (c.n0 + c4) < c.N;
    const float* src = c.W + (size_t)(c.k0 + r0) * c.N + c.n0 + c4;
#pragma unroll
    for (int i = 0; i < 4; ++i)
#pragma unroll
        for (int e = 0; e < 2; ++e) r[2 * i + e] = ok ? *(const f32x4*)(src + (size_t)(32 * i + e) * c.N) : (f32x4){0.f, 0.f, 0.f, 0.f};
}
__device__ __forceinline__ void conv_phase(const Params& p, int set, LAS unsigned char* lds, int tid, int bid, int G) {
    constexpr int T_GU = (D_ / 128) * (FF_ / 128), T_IN = (D_ / 128) * ((NIN_ + 127) / 128), T_P = (D_ / 128) * (D_ / 128), T_C1 = 4096 / 128;
    const int total = set == 0 ? 3 * T_GU + T_IN + 3 * T_P + 2 * T_C1 + 2 : 3 * T_GU;
    f32x4 r[8];
    int idx = bid;
    if (idx < total) { const ConvTile c = conv_tile(p, set, idx); conv_load(c, tid, r); }
    for (int it = 0; idx < total; ++it, idx += G) {
        const ConvTile c = conv_tile(p, set, idx);
        LAS bf16_t* buf = (LAS bf16_t*)(lds + (it & 1) * 34816);
        {
            const int c4 = (tid & 31) * 4, r0 = 2 * (tid >> 5);
#pragma unroll
            for (int i = 0; i < 4; ++i)
#pragma unroll
                for (int j = 0; j < 4; ++j) *(LAS unsigned*)(buf + (c4 + j) * 136 + r0 + 32 * i) = cvt_pk_bf16(r[2 * i][j], r[2 * i + 1][j]);
        }
        if (idx + G < total) { const ConvTile n = conv_tile(p, set, idx + G); conv_load(n, tid, r); }
        __syncthreads();
#pragma unroll
        for (int i = 0; i < 4; ++i) {
            const int q = tid + 512 * i, n = q >> 4, kc = q & 15;
            const u32x4 w = *(const LAS u32x4*)(buf + n * 136 + 8 * kc);
            if (c.mode == 4) {
                const int k = c.k0 + 8 * kc;
                *(u32x4*)(c.WT + (size_t)((((k >> 5) * 8 + (n >> 4)) * 64 + ((k >> 3) & 3) * 16 + (n & 15)) * 8)) = w;
            } else if (c.n0 + n < c.N) *(u32x4*)(c.WT + (size_t)rowmap(c.mode, c.n0 + n) * c.K + c.k0 + 8 * kc) = w;
        }
    }
    __syncthreads();
}

__global__ void __launch_bounds__(512, 2) fwd_kernel(Params p) {
    extern __shared__ __attribute__((aligned(16))) unsigned char lds_raw[];
    cg::grid_group grid = cg::this_grid();
    LAS unsigned char* lds = (LAS unsigned char*)lds_raw;
    const int tid = threadIdx.x, lane = tid & 63, wave = __builtin_amdgcn_readfirstlane(tid >> 6);
    const int G = gridDim.x, gw = blockIdx.x * 8 + wave, NGW = G * 8;
#define ctl ((unsigned*)(p.ws + WS_CTL))
#define ada ((float*)(p.ws + WS_ADA))
#define WGU ((bf16_t*)(p.ws + WS_WGU))
#define WD ((bf16_t*)(p.ws + WS_WD))
#define WIN ((bf16_t*)(p.ws + WS_WIN))
#define WPN ((bf16_t*)(p.ws + WS_WPN))
#define WPR ((bf16_t*)(p.ws + WS_WPR))
#define WO ((bf16_t*)(p.ws + WS_WO))
#define WC1 ((bf16_t*)(p.ws + WS_WC1))
#define WC2 ((bf16_t*)(p.ws + WS_WC2))
#define H ((bf16_t*)(p.ws + WS_H))
#define ONSA ((bf16_t*)(p.ws + WS_H))
#define Y ((bf16_t*)(p.ws + WS_Y))
#define ACT ((bf16_t*)(p.ws + WS_Y))
#define MG ((bf16_t*)(p.ws + WS_MG))
#define ORET ((bf16_t*)(p.ws + WS_ORET))
#define VTS ((bf16_t*)(p.ws + WS_VTS))
#define VTW ((bf16_t*)(p.ws + WS_VTW))
#define VTR ((bf16_t*)(p.ws + WS_VTR))
#define KC ((bf16_t*)(p.ws + WS_KC))
#define VCT ((bf16_t*)(p.ws + WS_VCT))
#define KS ((bf16_t*)(p.ws + WS_KS))
#define KW ((bf16_t*)(p.ws + WS_KW))
#define KR ((bf16_t*)(p.ws + WS_KR))
    const int mask = p.mask;
    { LAS unsigned* xbw = (LAS unsigned*)(lds + 131072); if (tid < 4) xbw[tid] = 0u; }
    __syncthreads();
    const XcdBarrier xbar = xcd_barrier_post((unsigned*)(p.ws + WS_BAR), (volatile LAS unsigned*)(lds + 131072));
#ifdef USE_CG_SYNC
#define GSYNC() grid.sync()
#else
#define GSYNC() xcd_barrier(xbar)
#endif
#ifndef DBL_MASK
#define DBL_MASK 0
#endif
#ifdef PROBE_CMP_FIRST
#define CMP_ONLY_COND (rep == 0)
#else
#define CMP_ONLY_COND false
#endif
#define REPS(k) (1 + ((DBL_MASK >> (k)) & 1))
#ifdef CT_MASK
#define ON(k) ((CT_MASK >> (k)) & 1)
#else
#define ON(k) ((mask >> (k)) & 1)
#endif

    for (int rep = 0; rep < REPS(0); ++rep) { if (rep) grid.sync();
    if (ON(0)) {
        LAS float* cond = (LAS float*)lds;
        LAS float* red = (LAS float*)(lds + 32768);
        for (int i = tid; i < 4 * D_; i += 512) cond[i] = silu_f(p.c[i]);
        __syncthreads();
        for (int it = blockIdx.x; it < NADA / 64; it += G) {
            const int n = it * 64 + lane; float a0 = 0.f, a1 = 0.f, a2 = 0.f, a3 = 0.f;
            const int kb = wave * 256;
#pragma unroll 8
            for (int kk = 0; kk < 256; ++kk) { const int k = kb + kk; const float w = p.w_ada[(size_t)k * NADA + n];
                a0 += cond[k] * w; a1 += cond[D_ + k] * w; a2 += cond[2 * D_ + k] * w; a3 += cond[3 * D_ + k] * w; }
            red[(wave * 4 + 0) * 64 + lane] = a0; red[(wave * 4 + 1) * 64 + lane] = a1; red[(wave * 4 + 2) * 64 + lane] = a2; red[(wave * 4 + 3) * 64 + lane] = a3;
            __syncthreads();
            if (tid < 256) { const int bb = tid >> 6, l = tid & 63; float s = p.b_ada[it * 64 + l];
#pragma unroll
                for (int w = 0; w < 8; ++w) s += red[(w * 4 + bb) * 64 + l];
                ada[(size_t)bb * NADA + it * 64 + l] = s; }
            __syncthreads();
        }
        __syncthreads();
        conv_phase(p, 0, lds, tid, (int)blockIdx.x, G);
        { u32x4* z = (u32x4*)(WIN + (size_t)NIN_ * D_); const int nz = (LDY - NIN_) * D_ * 2 / 16;
          for (int i = blockIdx.x * 512 + tid; i < nz; i += G * 512) z[i] = (u32x4){0u, 0u, 0u, 0u}; }
    }
    }
    grid.sync();
    for (int rep = 0; rep < REPS(1); ++rep) { if (rep) GSYNC();
    if (ON(1)) norm_rows(p.x, p.g_norm, ada, 0, 1, H, gw, NGW, lane);
    }
    GSYNC();
    for (int rep = 0; rep < REPS(2); ++rep) { if (rep) GSYNC();
    if (ON(2)) {
        pg8::Gemm g{H, WGU, T_, 2 * FF_, D_}; pg8::StaticOrder S; S.init(T_, 2 * FF_, G, (int)blockIdx.x);
        EpiSwiglu E{ACT};
        pg8::gemm_phase<EpiSwiglu, pg8::StaticOrder, true, true>(lds, g, S, E);
    }
    }
    GSYNC();
    if (ON(3)) {
        pg8::Gemm g{ACT, WD, T_, D_, FF_}; pg8::StaticOrder S; S.init(T_, D_, G, (int)blockIdx.x);
        EpiResid E{p.x, p.out, ada + 2 * D_, 0.5f};
        pg8::gemm_phase<EpiResid, pg8::StaticOrder, true, true>(lds, g, S, E);
    } else {
        for (size_t i = (size_t)blockIdx.x * 512 + tid; i < (size_t)T_ * D_ / 4; i += (size_t)G * 512) ((f32x4*)p.out)[i] = ((const f32x4*)p.x)[i];
    }
    GSYNC();
    for (int rep = 0; rep < REPS(4); ++rep) { if (rep) GSYNC();
    if (ON(4)) {
        norm_rows(p.out, p.g_norm + D_, ada, 3, 4, H, gw, NGW, lane);
        __syncthreads();
        conv_phase(p, 1, lds, tid, (int)blockIdx.x, G);
    }
    }
    GSYNC();
    for (int rep = 0; rep < REPS(5); ++rep) { if (rep) GSYNC();
    if (ON(5)) {
        pg8::Gemm g{H, WIN, T_, LDY, D_}; pg8::StaticOrder S; S.init(T_, LDY, G, (int)blockIdx.x);
        EpiY E{Y};
        pg8::gemm_phase<EpiY, pg8::StaticOrder, true, true>(lds, g, S, E);
    }
    }
    GSYNC();
    for (int rep = 0; rep < REPS(6); ++rep) { if (rep) GSYNC();
    if (ON(6)) {
        for (int unit = blockIdx.x; unit < 256; unit += G) compress_unit(unit, Y, p.cmp_pos, p.cmp_b1, p.g_qk, WC1, WC2, KC, VCT, lds, tid);
        __syncthreads();
        if (rep == 0) for (int tok = gw; tok < T_; tok += NGW) {
            bf16_t* row = Y + (size_t)tok * LDY;
            const int b = tok >> 11, sidx = tok & 2047, c16 = lane & 15, hsub = lane >> 4;
            const size_t fro = (size_t)((sidx >> 4) * 4 + (c16 >> 2)) * 512 + (c16 & 3) * 128 + (sidx & 15) * 8;
#pragma unroll 1
            for (int seg = 0; seg < 8; ++seg) {
                const int colbase = seg < 4 ? seg * 512 : (seg == 4 ? OFF_KV + 1024 : (seg == 5 ? OFF_KV + 2048 : OFF_KR + (seg - 6) * 512)), gi = seg < 4 ? 0 : (seg == 4 ? 2 : 3);
                const u32x4 w = *(const u32x4*)(row + colbase + lane * 8);
                u32x4 o = w;
                if (seg < 6) {
                    float f[8] = {bf_lo(w.x), bf_hi(w.x), bf_lo(w.y), bf_hi(w.y), bf_lo(w.z), bf_hi(w.z), bf_lo(w.w), bf_hi(w.w)};
                    float ss = 0.f;
#pragma unroll
                    for (int j = 0; j < 8; ++j) ss += f[j] * f[j];
                    ss += __shfl_xor(ss, 1); ss += __shfl_xor(ss, 2); ss += __shfl_xor(ss, 4); ss += __shfl_xor(ss, 8);
                    const float r = 1.0f / sqrtf(ss * (1.0f / 128.0f) + EPS_);
                    const float* gq = p.g_qk + gi * 128 + c16 * 8;
                    const f32x4 g0 = *(const f32x4*)gq, g1 = *(const f32x4*)(gq + 4);
                    o.x = cvt_pk_bf16(f[0] * r * g0[0], f[1] * r * g0[1]); o.y = cvt_pk_bf16(f[2] * r * g0[2], f[3] * r * g0[3]);
                    o.z = cvt_pk_bf16(f[4] * r * g1[0], f[5] * r * g1[1]); o.w = cvt_pk_bf16(f[6] * r * g1[2], f[7] * r * g1[3]);
                }
                bf16_t* dstp;
                if (seg < 4) dstp = row + colbase + lane * 8;
                else if (seg == 4) dstp = KS + (size_t)(b * 4 + hsub) * 262144 + fro;
                else if (seg == 5) dstp = KW + (size_t)(b * 4 + hsub) * 262144 + fro;
                else dstp = KR + (size_t)(b * 8 + (seg - 6) * 4 + hsub) * 262144 + fro;
                *(u32x4*)dstp = o;
            }
        }
        LAS bf16_t* tl = (LAS bf16_t*)(lds + wave * 16384);
        for (int it = gw; it < 48 * 128; it += NGW) {
            const int tt = it / 48, ct = it - tt * 48;
            int srccol, cc, HD; bf16_t* dst;
            if (ct < 8) { srccol = OFF_KV + 3 * 512 + ct * 64; cc = ct * 64; dst = VTS; HD = 128; }
            else if (ct < 16) { srccol = OFF_KV + 5 * 512 + (ct - 8) * 64; cc = (ct - 8) * 64; dst = VTW; HD = 128; }
            else { srccol = OFF_VR + (ct - 16) * 64; cc = (ct - 16) * 64; dst = VTR; HD = 256; }
            const int b = tt >> 5, s0 = (tt & 31) * 64;
            const int head = cc / HD, dt0 = (cc - head * HD) >> 4, NDTh = HD >> 4, nheads = (HD == 128) ? 4 : 8;
#pragma unroll
            for (int i = 0; i < 8; ++i) {
                const int tok = 8 * i + (lane >> 3), ch = lane & 7;
                const u32x4 w = *(const u32x4*)(Y + (size_t)(b * 2048 + s0 + tok) * LDY + srccol + ch * 8);
                LAS bf16_t* d = tl + (ch * 8) * 72 + tok;
                d[0 * 72] = (bf16_t)(w.x & 0xffffu); d[1 * 72] = (bf16_t)(w.x >> 16); d[2 * 72] = (bf16_t)(w.y & 0xffffu); d[3 * 72] = (bf16_t)(w.y >> 16);
                d[4 * 72] = (bf16_t)(w.z & 0xffffu); d[5 * 72] = (bf16_t)(w.z >> 16); d[6 * 72] = (bf16_t)(w.w & 0xffffu); d[7 * 72] = (bf16_t)(w.w >> 16);
            }
            asm volatile("s_waitcnt lgkmcnt(0)" ::: "memory");
            bf16_t* hb = dst + (size_t)(b * nheads + head) * (2048 * HD) + lane * 8;
#pragma unroll
            for (int i = 0; i < 8; ++i) {
                const int ks = i >> 2, dt = i & 3, col = 16 * dt + (lane & 15), fq4 = 4 * (lane >> 4);
                const u32x2 lo = *(const LAS u32x2*)(tl + col * 72 + 32 * ks + fq4), hi = *(const LAS u32x2*)(tl + col * 72 + 32 * ks + 16 + fq4);
                u32x4 w; w.x = lo.x; w.y = lo.y; w.z = hi.x; w.w = hi.y;
                *(u32x4*)(hb + (size_t)(((s0 >> 5) + ks) * NDTh + dt0 + dt) * 512) = w;
            }
            asm volatile("s_waitcnt lgkmcnt(0)" ::: "memory");
        }
    }
    }
    GSYNC();
    for (int rep = 0; rep < REPS(7); ++rep) { if (rep) GSYNC();
    if (ON(7)) {
        MixPtrs MP{Y, ONSA, ORET, VTS, VTW, VTR, KC, VCT, p.gn_gain, KS, KW, KR};
        unsigned* SM = (unsigned*)(p.ws + WS_SM);
#ifndef CMP_REPS
#define CMP_REPS 1
#endif
        for (int z = 0; z < CMP_REPS; ++z) for (int u = blockIdx.x; u < 256; u += G) cmp_unit(MP, SM, u >> 4, u & 15, lds, tid);
    }
    GSYNC();
    if (ON(7)) {
        MixPtrs MP{Y, ONSA, ORET, VTS, VTW, VTR, KC, VCT, p.gn_gain, KS, KW, KR};
        const unsigned* SM = (const unsigned*)(p.ws + WS_SM);
        LAS bf16x8* qs = (LAS bf16x8*)(lds + wave * 16384) + lane;
        if (G == 256) {
            const int x = blockIdx.x & 7, wl = (blockIdx.x >> 3) * 8 + wave;
#pragma unroll 1
            for (int k = 0; k < 2; ++k) {
                const int r = (k & 1) ? 255 - wl : wl, bg = x + 8 * k;
                nsa_unit(MP, SM, bg >> 2, bg & 3, 127 - (r >> 1), r & 1, lane, qs, lds + wave * 16384);
            }
#pragma unroll 1
            for (int qi = 0; qi < 8; ++qi) {
                const int xq = (x + qi) & 7;
                unsigned* qc = ctl + 512 * rep + 32 * xq;
                for (;;) {
                    unsigned id = 0;
                    if (lane == 0) id = atomicAdd(qc, 1u);
                    id = (unsigned)__builtin_amdgcn_readfirstlane((int)id);
                    if (id >= 256u) break;
                    const int bh = xq + 8 * (int)(id >> 6);
                    ret_unit2(MP, bh >> 3, bh & 7, 63 - (int)(id & 63u), lane, lds + wave * 16384);
                }
            }
        } else {
            for (int id = gw; id < 4096 + 2048; id += NGW) {
                if (id < 4096) { const int bg = id >> 8, r = id & 255; nsa_unit(MP, SM, bg >> 2, bg & 3, 127 - (r >> 1), r & 1, lane, qs, lds + wave * 16384); }
                else { const int r = id - 4096, bh = r >> 6; ret_unit2(MP, bh >> 3, bh & 7, 63 - (r & 63), lane, lds + wave * 16384); }
            }
        }
    }
    }
    GSYNC();
    for (int rep = 0; rep < REPS(8); ++rep) { if (rep) GSYNC();
    if (ON(8)) {
        { pg8::Gemm g{ONSA, WPN, T_, D_, D_}; pg8::StaticOrder S; S.init(T_, D_, G, (int)blockIdx.x);
          EpiMerge<false> E{MG, Y, OFF_GA};
          pg8::gemm_phase<EpiMerge<false>, pg8::StaticOrder, true, true>(lds, g, S, E); }
        __syncthreads();
        { pg8::Gemm g{ORET, WPR, T_, D_, D_}; pg8::StaticOrder S; S.init(T_, D_, G, (int)blockIdx.x);
          EpiMerge<true> E{MG, Y, OFF_GB};
          pg8::gemm_phase<EpiMerge<true>, pg8::StaticOrder, true, true>(lds, g, S, E); }
    }
    }
    GSYNC();
    if (ON(9)) {
        pg8::Gemm g{MG, WO, T_, D_, D_}; pg8::StaticOrder S; S.init(T_, D_, G, (int)blockIdx.x);
        EpiResid E{p.out, p.out, ada + 5 * D_, 1.0f};
        pg8::gemm_phase<EpiResid, pg8::StaticOrder, true, true>(lds, g, S, E);
    }
    GSYNC();
    for (int rep = 0; rep < REPS(10); ++rep) { if (rep) GSYNC();
    if (ON(10)) norm_rows(p.out, p.g_norm + 2 * D_, ada, 6, 7, H, gw, NGW, lane);
    }
    GSYNC();
    for (int rep = 0; rep < REPS(11); ++rep) { if (rep) GSYNC();
    if (ON(11)) {
        pg8::Gemm g{H, WGU, T_, 2 * FF_, D_}; pg8::StaticOrder S; S.init(T_, 2 * FF_, G, (int)blockIdx.x);
        EpiSwiglu E{ACT};
        pg8::gemm_phase<EpiSwiglu, pg8::StaticOrder, true, true>(lds, g, S, E);
    }
    }
    GSYNC();
    if (ON(12)) {
        pg8::Gemm g{ACT, WD, T_, D_, FF_}; pg8::StaticOrder S; S.init(T_, D_, G, (int)blockIdx.x);
        EpiResid E{p.out, p.out, ada + 8 * D_, 0.5f};
        pg8::gemm_phase<EpiResid, pg8::StaticOrder, true, true>(lds, g, S, E);
    }
#undef ON
#undef GSYNC
#undef ctl
#undef ada
#undef WGU
#undef WD
#undef WIN
#undef WPN
#undef WPR
#undef WO
#undef WC1
#undef WC2
#undef H
#undef ONSA
#undef Y
#undef ACT
#undef MG
#undef ORET
#undef VTS
#undef VTW
#undef VTR
#undef KC
#undef VCT
#undef KS
#undef KW
#undef KR
}

#ifndef PHASE_MASK
#define PHASE_MASK 0x1fff
#endif
extern "C" void kernel_launch(void* const* d_in, const int* in_sizes, int n_in, void* d_out, int out_size, void* d_ws, size_t ws_size, hipStream_t stream) {
    static int grid_blocks = 0;
    if (grid_blocks == 0) {
        if (n_in != 18 || ws_size < WS_END) { fprintf(stderr, "kernel_launch: unexpected n_in %d or workspace %zu < %zu\n", n_in, ws_size, (size_t)WS_END); grid_blocks = -1; return; }
        int dev = 0, cus = 0, per_cu = 0;
        hipGetDevice(&dev);
        hipDeviceGetAttribute(&cus, hipDeviceAttributeMultiprocessorCount, dev);
        if (hipFuncSetAttribute((const void*)fwd_kernel, hipFuncAttributeMaxDynamicSharedMemorySize, LDS_BYTES) != hipSuccess) { fprintf(stderr, "kernel_launch: hipFuncSetAttribute failed\n"); grid_blocks = -1; return; }
        if (hipOccupancyMaxActiveBlocksPerMultiprocessor(&per_cu, (const void*)fwd_kernel, 512, LDS_BYTES) != hipSuccess || per_cu < 1) { fprintf(stderr, "kernel_launch: occupancy query gave %d\n", per_cu); per_cu = 1; }
        (void)hipGetLastError();
        grid_blocks = cus * 1;
    }
    if (grid_blocks < 0) return;
    (void)hipMemsetAsync((char*)d_ws + WS_CTL, 0, 32768, stream);
    Params p{};
    p.x = (const float*)d_in[0]; p.c = (const float*)d_in[1]; p.w_ada = (const float*)d_in[2]; p.b_ada = (const float*)d_in[3]; p.g_norm = (const float*)d_in[4];
    p.w_gate = (const float*)d_in[5]; p.w_up = (const float*)d_in[6]; p.w_down = (const float*)d_in[7]; p.w_in = (const float*)d_in[8]; p.g_qk = (const float*)d_in[9];
    p.cmp_pos = (const float*)d_in[10]; p.cmp_w1 = (const float*)d_in[11]; p.cmp_b1 = (const float*)d_in[12]; p.cmp_w2 = (const float*)d_in[13]; p.gn_gain = (const float*)d_in[14];
    p.w_pn = (const float*)d_in[15]; p.w_pr = (const float*)d_in[16]; p.w_out = (const float*)d_in[17];
    p.out = (float*)d_out; p.ws = (unsigned char*)d_ws; p.mask = PHASE_MASK; p.pad = 0;
    void* args[] = {&p};
    hipError_t e = hipLaunchCooperativeKernel((const void*)fwd_kernel, dim3(grid_blocks), dim3(512), args, LDS_BYTES, stream);
    if (e != hipSuccess) fprintf(stderr, "kernel_launch: cooperative launch failed: %s (grid %d)\n", hipGetErrorString(e), grid_blocks);
}
```

```cpp
#include <hip/hip_runtime.h>
#include <hip/hip_cooperative_groups.h>
#include <cstdio>
#include <cstdint>
namespace cg = cooperative_groups;
namespace pg8 {
#define PG8_LAS __attribute__((address_space(3)))
typedef unsigned short bf16_t;
typedef short bf16x8 __attribute__((ext_vector_type(8)));
typedef float f32x4 __attribute__((ext_vector_type(4)));
typedef unsigned u32x4 __attribute__((ext_vector_type(4)));
constexpr int BM = 256, BK = 64, HALF = 128, HTB = HALF * BK * 2  , STAGE_BYTES = 8 * HTB, NXCD = 8, WGM = 8;

__host__ __device__ __forceinline__ int lds_byte(int r, int c) { const int st = (r >> 4) * 2 + (c >> 5), rr = r & 15, cc = c & 31, ob = rr * 64 + cc * 2; return st * 1024 + (ob ^ (((ob >> 9) & 1) << 5)); }
__host__ __device__ __forceinline__ void stage_rc(int b, int& R, int& C) { const int st = b / 1024, sb = b % 1024, swz = sb ^ (((sb >> 9) & 1) << 5); R = (st >> 1) * 16 + swz / 64; C = (st & 1) * 32 + (swz % 64) / 2; }
__host__ __device__ __forceinline__ int perm32(int rho) { const int n = rho >> 4, i = rho & 15; return 8 * (i >> 2) + 4 * n + (i & 3); }

struct Unit { int pm, pn; };
struct Gemm { const bf16_t* A; const bf16_t* Bt; int M, N, K; };

struct StaticOrder {
    int nM, nN, nwg, G, c;
    __host__ __device__ void init(int M, int N, int G_, int c_) { nM = M / BM; nN = N / BM; nwg = nM * nN; G = G_; c = c_; }
    __host__ __device__ bool next(int i, Unit& u) const {
        const long L = (long)i * G + c; if (L >= nwg) return false;
        int wgid = (int)L; { const int q = nwg / NXCD, r = nwg % NXCD, xcd = wgid % NXCD, off = wgid / NXCD; wgid = (xcd < r ? xcd * (q + 1) : r * (q + 1) + (xcd - r) * q) + off; }
        const int nig = WGM * nN, gid = wgid / nig, fm = gid * WGM, gsz = (nM - fm) < WGM ? (nM - fm) : WGM;
        u.pm = fm + ((wgid % nig) % gsz); u.pn = (wgid % nig) / gsz; return true;
    }
    __device__ __forceinline__ void a_ready(const Unit&) const {}
    __device__ __forceinline__ void done(const Unit&) const {}
};

__device__ __forceinline__ unsigned cvt_pk_bf16(float lo, float hi) { unsigned r; asm volatile("v_cvt_pk_bf16_f32 %0, %1, %2" : "=v"(r) : "v"(lo), "v"(hi)); return r; }
typedef float f32x2 __attribute__((ext_vector_type(2)));
template <class Epi, class Sched, bool ALIGN_EPI = false, bool SP2 = false>
__device__ __forceinline__ void gemm_phase(PG8_LAS unsigned char* lds, const Gemm g, const Sched& S, const Epi& E) {
    int tid_o = threadIdx.x; asm volatile("" : "+v"(tid_o));
    const int tid = tid_o, wid = __builtin_amdgcn_readfirstlane(tid >> 6), lane = tid & 63, wr = wid >> 2, wc = wid & 3, fr = lane & 15, fq = lane >> 4;
    const int K = g.K, nt = K / BK;
    unsigned voffA[2], voffB[2];
#pragma unroll
    for (int i = 0; i < 2; ++i) { int R, C; stage_rc(tid * 16 + i * 8192, R, C); const int Rb = Epi::PERM ? ((R & ~31) + perm32(R & 31)) : R;
        voffA[i] = (unsigned)(R * K + C) * 2u; voffB[i] = (unsigned)(Rb * K + C) * 2u; }
    const size_t kstep = (size_t)(BK * 2);
    const size_t hstep = (size_t)HALF * K * 2;
    const size_t tstep = 2 * hstep;
    const unsigned ldsw = (unsigned)wid * 1024u;
    const int aoff = lds_byte(wr * 64 + fr, fq * 8), boff = lds_byte(wc * 32 + fr, fq * 8);
#define PG8_SA(b, h) (((b) * 2 + (h)) * HTB)
#define PG8_SB(b, h) ((4 + (b) * 2 + (h)) * HTB)
#define PG8_STAGE(bufoff, gbase, voff) do { _Pragma("unroll") for (int _i = 0; _i < 2; ++_i) \
        __builtin_amdgcn_global_load_lds((const unsigned*)((const char*)(gbase) + (voff)[_i]), (PG8_LAS unsigned*)(lds + (bufoff) + ldsw + _i * 8192), 16, 0, 0); } while (0)
#define PG8_LDA(dst, b, h) do { _Pragma("unroll") for (int m = 0; m < 4; ++m) _Pragma("unroll") for (int k = 0; k < 2; ++k) dst[m][k] = *(const PG8_LAS bf16x8*)(lds + PG8_SA(b, h) + aoff + m * 2048 + k * 1024); } while (0)
#define PG8_LDB(dst, b, h) do { _Pragma("unroll") for (int n = 0; n < 2; ++n) _Pragma("unroll") for (int k = 0; k < 2; ++k) dst[n][k] = *(const PG8_LAS bf16x8*)(lds + PG8_SB(b, h) + boff + n * 2048 + k * 1024); } while (0)
#define PG8_MMA(ai, bj, At, Bt) do { __builtin_amdgcn_s_setprio(1); _Pragma("unroll") for (int m = 0; m < 4; ++m) _Pragma("unroll") for (int n = 0; n < 2; ++n) _Pragma("unroll") for (int k = 0; k < 2; ++k) \
        acc[ai][bj][m][n] = __builtin_amdgcn_mfma_f32_16x16x32_bf16(Bt[n][k], At[m][k], acc[ai][bj][m][n], 0, 0, 0); __builtin_amdgcn_s_setprio(0); } while (0)
#define PG8_WAIT_V(n) asm volatile("s_waitcnt vmcnt(" #n ")" ::: "memory")
#define PG8_WAIT_L(n) asm volatile("s_waitcnt lgkmcnt(" #n ")" ::: "memory")
#define PG8_BAR __builtin_amdgcn_s_barrier()
#define PG8_SCHED __builtin_amdgcn_sched_barrier(0)
    Unit cur, nxt; int ui = 0;
    if (!S.next(0, cur)) return;
    f32x4 acc[2][2][4][2];
#pragma unroll
    for (int a = 0; a < 2; ++a)
#pragma unroll
        for (int b = 0; b < 2; ++b)
#pragma unroll
            for (int m = 0; m < 4; ++m)
#pragma unroll
                for (int n = 0; n < 2; ++n) acc[a][b][m][n] = (f32x4){0.f, 0.f, 0.f, 0.f};
    bf16x8 At[4][2], B0[2][2], B1[2][2];
    const char* cA = (const char*)g.A + (size_t)cur.pm * tstep; const char* cB = (const char*)g.Bt + (size_t)cur.pn * tstep;
    S.a_ready(cur);
    if constexpr (SP2) {
        PG8_STAGE(PG8_SB(0, 0), cB, voffB); PG8_STAGE(PG8_SB(0, 1), cB + hstep, voffB); PG8_STAGE(PG8_SA(0, 0), cA, voffA); PG8_STAGE(PG8_SA(0, 1), cA + hstep, voffA);
        if (wr == 1) PG8_BAR;
        PG8_WAIT_V(2); PG8_BAR;
        PG8_STAGE(PG8_SB(1, 0), cB + kstep, voffB); PG8_STAGE(PG8_SA(1, 0), cA + kstep, voffA); PG8_STAGE(PG8_SB(1, 1), cB + hstep + kstep, voffB);
        PG8_WAIT_V(6); PG8_BAR;
    } else {
        PG8_STAGE(PG8_SB(0, 0), cB, voffB); PG8_STAGE(PG8_SA(0, 0), cA, voffA); PG8_STAGE(PG8_SB(0, 1), cB + hstep, voffB); PG8_STAGE(PG8_SA(0, 1), cA + hstep, voffA);
        if (wr == 1) PG8_BAR;
        PG8_WAIT_V(4); PG8_BAR;
        PG8_STAGE(PG8_SB(1, 0), cB + kstep, voffB); PG8_STAGE(PG8_SA(1, 0), cA + kstep, voffA); PG8_STAGE(PG8_SB(1, 1), cB + hstep + kstep, voffB);
        PG8_WAIT_V(6); PG8_BAR;
    }
    for (;;) {
        const bool has_next = S.next(ui + 1, nxt);
        const char* nA = has_next ? (const char*)g.A + (size_t)nxt.pm * tstep : cA; const char* nB = has_next ? (const char*)g.Bt + (size_t)nxt.pn * tstep : cB;
        for (int t = 0; t < nt; t += 2) {
            const bool last = (t == nt - 2);
            const char* a1 = cA + (size_t)(t + 1) * kstep;
            const char* a2 = last ? nA : cA + (size_t)(t + 2) * kstep; const char* b2 = last ? nB : cB + (size_t)(t + 2) * kstep;
            const char* a3 = a2 + kstep; const char* b3 = b2 + kstep;
            if (last && has_next) S.a_ready(nxt);
            if constexpr (SP2) {
            PG8_LDB(B0, 0, 0); PG8_LDB(B1, 0, 1); PG8_SCHED; PG8_LDA(At, 0, 0); PG8_STAGE(PG8_SA(1, 1), a1 + hstep, voffA);
            PG8_WAIT_V(8); PG8_WAIT_L(0); PG8_BAR; PG8_MMA(0, 0, At, B0); PG8_MMA(0, 1, At, B1); PG8_BAR; PG8_SCHED;
            PG8_LDA(At, 0, 1); PG8_STAGE(PG8_SB(0, 0), b2, voffB); PG8_STAGE(PG8_SB(0, 1), b2 + hstep, voffB); PG8_STAGE(PG8_SA(0, 0), a2, voffA);
            PG8_WAIT_V(8); PG8_WAIT_L(0); PG8_BAR; PG8_MMA(1, 0, At, B0); PG8_MMA(1, 1, At, B1); PG8_BAR; PG8_SCHED;
            PG8_LDB(B0, 1, 0); PG8_LDB(B1, 1, 1); PG8_SCHED; PG8_LDA(At, 1, 0); PG8_STAGE(PG8_SA(0, 1), a2 + hstep, voffA);
            PG8_WAIT_V(8); PG8_WAIT_L(0); PG8_BAR; PG8_MMA(0, 0, At, B0); PG8_MMA(0, 1, At, B1); PG8_BAR; PG8_SCHED;
            PG8_LDA(At, 1, 1); PG8_STAGE(PG8_SB(1, 0), b3, voffB); PG8_STAGE(PG8_SB(1, 1), b3 + hstep, voffB); PG8_STAGE(PG8_SA(1, 0), a3, voffA);
            PG8_WAIT_V(8); PG8_WAIT_L(0); PG8_BAR; PG8_MMA(1, 0, At, B0); PG8_MMA(1, 1, At, B1); PG8_BAR; PG8_SCHED;
            } else {
            PG8_LDB(B0, 0, 0); PG8_SCHED; PG8_LDA(At, 0, 0); PG8_STAGE(PG8_SA(1, 1), a1 + hstep, voffA);
            PG8_WAIT_L(8); PG8_BAR; PG8_WAIT_L(0); PG8_MMA(0, 0, At, B0); PG8_BAR; PG8_SCHED;
            PG8_LDB(B1, 0, 1); PG8_STAGE(PG8_SB(0, 0), b2, voffB);
            PG8_BAR; PG8_WAIT_L(0); PG8_MMA(0, 1, At, B1); PG8_BAR;
            PG8_LDA(At, 0, 1); PG8_STAGE(PG8_SA(0, 0), a2, voffA);
            PG8_BAR; PG8_WAIT_L(0); PG8_MMA(1, 0, At, B0); PG8_BAR; PG8_SCHED;
            PG8_STAGE(PG8_SB(0, 1), b2 + hstep, voffB);
            PG8_WAIT_V(6); PG8_BAR; PG8_MMA(1, 1, At, B1); PG8_BAR;
            PG8_LDB(B0, 1, 0); PG8_SCHED; PG8_LDA(At, 1, 0); PG8_STAGE(PG8_SA(0, 1), a2 + hstep, voffA);
            PG8_WAIT_L(8); PG8_BAR; PG8_WAIT_L(0); PG8_MMA(0, 0, At, B0); PG8_BAR; PG8_SCHED;
            PG8_LDB(B1, 1, 1); PG8_STAGE(PG8_SB(1, 0), b3, voffB);
            PG8_BAR; PG8_WAIT_L(0); PG8_MMA(0, 1, At, B1); PG8_BAR;
            PG8_LDA(At, 1, 1); PG8_STAGE(PG8_SA(1, 0), a3, voffA);
            PG8_BAR; PG8_WAIT_L(0); PG8_MMA(1, 0, At, B0); PG8_BAR; PG8_SCHED;
            PG8_STAGE(PG8_SB(1, 1), b3 + hstep, voffB);
            PG8_WAIT_V(6); PG8_BAR; PG8_MMA(1, 1, At, B1); PG8_BAR;
            }
        }
        if constexpr (ALIGN_EPI) { if (wr == 0) PG8_BAR; }
        if constexpr (!Epi::AFTER_DRAIN) { E(acc, cur, wr, wc, fr, fq); S.done(cur); }
        if (!has_next) break;
#pragma unroll
        for (int a = 0; a < 2; ++a)
#pragma unroll
            for (int b = 0; b < 2; ++b)
#pragma unroll
                for (int m = 0; m < 4; ++m)
#pragma unroll
                    for (int n = 0; n < 2; ++n) acc[a][b][m][n] = (f32x4){0.f, 0.f, 0.f, 0.f};
        cur = nxt; cA = nA; cB = nB; ++ui;
        if constexpr (ALIGN_EPI) { if (wr == 1) PG8_BAR; }
    }
    PG8_WAIT_V(0);
    if constexpr (!ALIGN_EPI) { if (wr == 0) PG8_BAR; }
    PG8_BAR;
    if constexpr (Epi::AFTER_DRAIN) { E.fused(acc, cur, wr, wc, fr, fq, lds, wid, lane); S.done(cur); }
#undef PG8_SA
#undef PG8_SB
#undef PG8_STAGE
#undef PG8_LDA
#undef PG8_LDB
#undef PG8_MMA
#undef PG8_WAIT_V
#undef PG8_WAIT_L
#undef PG8_BAR
#undef PG8_SCHED
}
}

#define LAS __attribute__((address_space(3)))
typedef unsigned short bf16_t;
typedef short bf16x8 __attribute__((ext_vector_type(8)));
typedef short s16x4 __attribute__((ext_vector_type(4)));
typedef float f32x4 __attribute__((ext_vector_type(4)));
typedef unsigned u32x4 __attribute__((ext_vector_type(4)));
typedef unsigned u32x2 __attribute__((ext_vector_type(2)));

constexpr int T_ = 8192, D_ = 2048, FF_ = 5632, NIN_ = 15408, LDY = 15616, NADA = 18432;
constexpr int OFF_Q = 0, OFF_KV = 2048, OFF_QR = 5120, OFF_KR = 6144, OFF_VR = 7168, OFF_GR = 9216, OFF_GA = 11264, OFF_GB = 13312, OFF_GL = 15360;
constexpr float LOG2E = 1.4426950408889634f;
constexpr float EPS_ = 1e-6f;

constexpr size_t al256(size_t x) { return (x + 255) & ~(size_t)255; }
constexpr size_t WS_CTL = 0;
constexpr size_t WS_BAR = 8192;
constexpr size_t WS_ADA = 32768;
constexpr size_t WS_WGU = al256(WS_ADA + (size_t)4 * NADA * 4);
constexpr size_t WS_WD  = WS_WGU + (size_t)2 * FF_ * D_ * 2;
constexpr size_t WS_WIN = WS_WD + (size_t)D_ * FF_ * 2;
constexpr size_t WS_WPN = WS_WIN + (size_t)LDY * D_ * 2;
constexpr size_t WS_WPR = WS_WPN + (size_t)D_ * D_ * 2;
constexpr size_t WS_WO  = WS_WPR + (size_t)D_ * D_ * 2;
constexpr size_t WS_WC1 = WS_WO + (size_t)D_ * D_ * 2;
constexpr size_t WS_WC2 = WS_WC1 + (size_t)2 * 128 * 4096 * 2;
constexpr size_t WS_H   = WS_WC2 + (size_t)2 * 128 * 128 * 2;
constexpr size_t WS_Y   = WS_H + (size_t)T_ * D_ * 2;
constexpr size_t WS_MG  = WS_Y + (size_t)T_ * LDY * 2;
constexpr size_t WS_ORET = WS_MG + (size_t)T_ * D_ * 2;
constexpr size_t WS_VTS = WS_ORET + (size_t)T_ * D_ * 2;
constexpr size_t WS_VTW = WS_VTS + (size_t)16 * 128 * 2048 * 2;
constexpr size_t WS_VTR = WS_VTW + (size_t)16 * 128 * 2048 * 2;
constexpr size_t WS_KC  = WS_VTR + (size_t)32 * 256 * 2048 * 2;
constexpr size_t WS_VCT = WS_KC + (size_t)16 * 128 * 128 * 2;
constexpr size_t WS_KS  = WS_VCT + (size_t)16 * 128 * 128 * 2;
constexpr size_t WS_KW  = WS_KS + (size_t)16 * 2048 * 128 * 2;
constexpr size_t WS_KR  = WS_KW + (size_t)16 * 2048 * 128 * 2;
constexpr size_t WS_SM  = WS_KR + (size_t)32 * 2048 * 128 * 2;
constexpr size_t WS_WGU2 = al256(WS_SM + (size_t)16 * 2048 * 4);
constexpr size_t WS_WD2 = WS_WGU2 + (size_t)2 * FF_ * D_ * 2;
constexpr size_t WS_END = WS_WD2 + (size_t)D_ * FF_ * 2;

constexpr int LDS_BYTES = 131072 + 2048;

using pg8::cvt_pk_bf16;
__device__ __forceinline__ float bf_lo(unsigned w) { return __uint_as_float(w << 16); }
__device__ __forceinline__ float bf_hi(unsigned w) { return __uint_as_float(w & 0xffff0000u); }
__device__ __forceinline__ float bf2f(bf16_t h) { return __uint_as_float((unsigned)h << 16); }
__device__ __forceinline__ float ex2(float x) { return __builtin_amdgcn_exp2f(x); }
__device__ __forceinline__ float sigmoid_f(float x) { return __builtin_amdgcn_rcpf(1.0f + ex2(-x * LOG2E)); }
__device__ __forceinline__ float silu_f(float x) { return x * sigmoid_f(x); }
__device__ __forceinline__ float wave_sum(float v) {
#pragma unroll
    for (int o = 1; o < 64; o <<= 1) v += __shfl_xor(v, o);
    return v;
}
#define MFMA16(a, b, c) __builtin_amdgcn_mfma_f32_16x16x32_bf16((a), (b), (c), 0, 0, 0)
__device__ __forceinline__ float rowred_max(float x) {
    auto a = __builtin_amdgcn_permlane16_swap(__float_as_uint(x), __float_as_uint(x), false, false);
    x = fmaxf(__uint_as_float(a[0]), __uint_as_float(a[1]));
    auto b = __builtin_amdgcn_permlane32_swap(__float_as_uint(x), __float_as_uint(x), false, false);
    return fmaxf(__uint_as_float(b[0]), __uint_as_float(b[1]));
}
__device__ __forceinline__ float rowred_sum(float x) {
    auto a = __builtin_amdgcn_permlane16_swap(__float_as_uint(x), __float_as_uint(x), false, false);
    x = __uint_as_float(a[0]) + __uint_as_float(a[1]);
    auto b = __builtin_amdgcn_permlane32_swap(__float_as_uint(x), __float_as_uint(x), false, false);
    return __uint_as_float(b[0]) + __uint_as_float(b[1]);
}

struct EpiSwiglu {
    static constexpr bool PERM = true, AFTER_DRAIN = false;
    bf16_t* O;
    __device__ __forceinline__ void operator()(const f32x4 (&acc)[2][2][4][2], const pg8::Unit& u, int wr, int wc, int fr, int fq) const {
        const int row0 = u.pm * 256 + wr * 64 + fr, col0 = u.pn * 128 + wc * 32 + 8 * fq;
#pragma unroll
        for (int ai = 0; ai < 2; ++ai)
#pragma unroll
            for (int m = 0; m < 4; ++m) {
                bf16_t* rowp = O + (size_t)(row0 + ai * 128 + m * 16) * FF_ + col0;
                const f32x4 g0 = acc[ai][0][m][0], g1 = acc[ai][0][m][1], u0 = acc[ai][1][m][0], u1 = acc[ai][1][m][1];
                u32x4 w;
                w.x = cvt_pk_bf16(silu_f(g0[0]) * u0[0], silu_f(g0[1]) * u0[1]);
                w.y = cvt_pk_bf16(silu_f(g0[2]) * u0[2], silu_f(g0[3]) * u0[3]);
                w.z = cvt_pk_bf16(silu_f(g1[0]) * u1[0], silu_f(g1[1]) * u1[1]);
                w.w = cvt_pk_bf16(silu_f(g1[2]) * u1[2], silu_f(g1[3]) * u1[3]);
                *(u32x4*)rowp = w;
            }
    }
};
struct EpiResid {
    static constexpr bool PERM = false, AFTER_DRAIN = false;
    const float* base; float* out; const float* gate; float coef;
    __device__ __forceinline__ void operator()(const f32x4 (&acc)[2][2][4][2], const pg8::Unit& u, int wr, int wc, int fr, int fq) const {
        const int row0 = u.pm * 256 + wr * 64 + fr, col0 = u.pn * 256 + wc * 32 + 4 * fq, b = u.pm >> 3;
        f32x4 gv[2][2];
#pragma unroll
        for (int bj = 0; bj < 2; ++bj)
#pragma unroll
            for (int n = 0; n < 2; ++n) gv[bj][n] = *(const f32x4*)(gate + (size_t)b * NADA + col0 + bj * 128 + n * 16) * coef;
#pragma unroll
        for (int ai = 0; ai < 2; ++ai)
#pragma unroll
            for (int m = 0; m < 4; ++m) {
                const size_t off = (size_t)(row0 + ai * 128 + m * 16) * D_ + col0;
#pragma unroll
                for (int bj = 0; bj < 2; ++bj)
#pragma unroll
                    for (int n = 0; n < 2; ++n) {
                        const size_t o = off + bj * 128 + n * 16;
                        *(f32x4*)(out + o) = *(const f32x4*)(base + o) + gv[bj][n] * acc[ai][bj][m][n];
                    }
            }
    }
};
struct EpiY {
    static constexpr bool PERM = true, AFTER_DRAIN = false;
    bf16_t* O;
    __device__ __forceinline__ void operator()(const f32x4 (&acc)[2][2][4][2], const pg8::Unit& u, int wr, int wc, int fr, int fq) const {
        const int row0 = u.pm * 256 + wr * 64 + fr, col0 = u.pn * 256 + wc * 32 + 8 * fq;
#pragma unroll
        for (int ai = 0; ai < 2; ++ai)
#pragma unroll
            for (int m = 0; m < 4; ++m) {
                bf16_t* rowp = O + (size_t)(row0 + ai * 128 + m * 16) * LDY + col0;
#pragma unroll
                for (int bj = 0; bj < 2; ++bj) {
                    const f32x4 v0 = acc[ai][bj][m][0], v1 = acc[ai][bj][m][1];
                    u32x4 w; w.x = cvt_pk_bf16(v0[0], v0[1]); w.y = cvt_pk_bf16(v0[2], v0[3]); w.z = cvt_pk_bf16(v1[0], v1[1]); w.w = cvt_pk_bf16(v1[2], v1[3]);
                    *(u32x4*)(rowp + bj * 128) = w;
                }
            }
    }
};
template <bool ADD> struct EpiMerge {
    static constexpr bool PERM = true, AFTER_DRAIN = false;
    bf16_t* O; const bf16_t* Yg; int goff;
    __device__ __forceinline__ void operator()(const f32x4 (&acc)[2][2][4][2], const pg8::Unit& u, int wr, int wc, int fr, int fq) const {
        const int row0 = u.pm * 256 + wr * 64 + fr, col0 = u.pn * 256 + wc * 32 + 8 * fq;
#pragma unroll
        for (int ai = 0; ai < 2; ++ai)
#pragma unroll
            for (int m = 0; m < 4; ++m) {
                const int row = row0 + ai * 128 + m * 16;
#pragma unroll
                for (int bj = 0; bj < 2; ++bj) {
                    const int col = col0 + bj * 128;
                    const u32x4 gw = *(const u32x4*)(Yg + (size_t)row * LDY + goff + col);
                    const f32x4 v0 = acc[ai][bj][m][0], v1 = acc[ai][bj][m][1];
                    float r[8];
                    r[0] = sigmoid_f(bf_lo(gw.x)) * v0[0]; r[1] = sigmoid_f(bf_hi(gw.x)) * v0[1];
                    r[2] = sigmoid_f(bf_lo(gw.y)) * v0[2]; r[3] = sigmoid_f(bf_hi(gw.y)) * v0[3];
                    r[4] = sigmoid_f(bf_lo(gw.z)) * v1[0]; r[5] = sigmoid_f(bf_hi(gw.z)) * v1[1];
                    r[6] = sigmoid_f(bf_lo(gw.w)) * v1[2]; r[7] = sigmoid_f(bf_hi(gw.w)) * v1[3];
                    bf16_t* op = O + (size_t)row * D_ + col;
                    if (ADD) {
                        const u32x4 pw = *(const u32x4*)op;
                        r[0] += bf_lo(pw.x); r[1] += bf_hi(pw.x); r[2] += bf_lo(pw.y); r[3] += bf_hi(pw.y);
                        r[4] += bf_lo(pw.z); r[5] += bf_hi(pw.z); r[6] += bf_lo(pw.w); r[7] += bf_hi(pw.w);
                    }
                    u32x4 w; w.x = cvt_pk_bf16(r[0], r[1]); w.y = cvt_pk_bf16(r[2], r[3]); w.z = cvt_pk_bf16(r[4], r[5]); w.w = cvt_pk_bf16(r[6], r[7]);
                    *(u32x4*)op = w;
                }
            }
    }
};

__device__ __forceinline__ int rowmap(int mode, int n) {
    if (mode == 0) return n;
    if (mode == 1) return ((n >> 7) << 8) + (n & 127);
    if (mode == 2) return ((n >> 7) << 8) + 128 + (n & 127);
    return n < 5120 ? n : (n < 5168 ? OFF_GL + (n - 5120) : n - 48);
}
__device__ __forceinline__ void norm_rows(const float* __restrict__ X, const float* __restrict__ g, const float* __restrict__ ada, int ish, int isc, bf16_t* __restrict__ H, int gw, int NGW, int lane) {
    for (int m = gw; m < T_; m += NGW) {
        const int b = m >> 11;
        const f32x4* xr = (const f32x4*)(X + (size_t)m * D_) + lane;
        f32x4 v[8]; float ss = 0.f;
#pragma unroll
        for (int j = 0; j < 8; ++j) { v[j] = xr[64 * j]; ss += (v[j].x * v[j].x + v[j].y * v[j].y) + (v[j].z * v[j].z + v[j].w * v[j].w); }
        const float r = 1.0f / sqrtf(wave_sum(ss) * (1.0f / D_) + EPS_);
        const f32x4* gp = (const f32x4*)g + lane;
        const f32x4* sh = (const f32x4*)(ada + (size_t)b * NADA + ish * D_) + lane;
        const f32x4* sc = (const f32x4*)(ada + (size_t)b * NADA + isc * D_) + lane;
        u32x2* o = (u32x2*)(H + (size_t)m * D_) + lane;
#pragma unroll
        for (int j = 0; j < 8; ++j) {
            const f32x4 y = v[j] * r * gp[64 * j] * (sc[64 * j] + 1.0f) + sh[64 * j];
            u32x2 w; w.x = cvt_pk_bf16(y.x, y.y); w.y = cvt_pk_bf16(y.z, y.w); o[64 * j] = w;
        }
    }
}

#ifndef VPRE
#define VPRE 4
#endif
__device__ __forceinline__ void att_kdma(const bf16_t* __restrict__ Kf, int k0, int lane8, LAS unsigned char* ring) {
    const bf16_t* kb = Kf + (size_t)(k0 >> 4) * 2048 + lane8;
#pragma unroll
    for (int s8 = 0; s8 < 8; ++s8) __builtin_amdgcn_global_load_lds((const unsigned*)(kb + s8 * 512), (LAS unsigned*)(ring + s8 * 1024), 16, 0, 0);
}
template <int NR, int NDT, int MODE>
__device__ __forceinline__ void att_step(const bf16_t* __restrict__ Kf, const bf16_t* __restrict__ Vf, int k0, int k0n  , int tq  , int lane8  ,
                                         const LAS bf16x8* qs, LAS unsigned char* ring, int lane, f32x4 (&O)[NR][NDT], float (&m)[NR], float (&l)[NR], const float (&coef)[NR], bool vblk, bool full = false) {
    constexpr float SC = 0.08838834764831845f;
    const bf16_t* vb = Vf + (size_t)(k0 >> 5) * (NDT * 512) + lane8;
    const int dq = tq - k0;
    asm volatile("s_waitcnt vmcnt(0)" ::: "memory");
    bf16x8 vfr[NDT];
#pragma unroll
    for (int dt = 0; dt < NDT; ++dt) vfr[dt] = *(const bf16x8*)(vb + dt * 512);
    f32x4 sa[NR][2];
    const LAS bf16x8* kr = (const LAS bf16x8*)ring + lane;
#pragma unroll
    for (int kt = 0; kt < 2; ++kt) {
#pragma unroll
        for (int r = 0; r < NR; ++r) { sa[r][kt] = (f32x4){0.f, 0.f, 0.f, 0.f};
#pragma unroll
            for (int dc = 0; dc < 4; ++dc) sa[r][kt] = MFMA16(kr[(kt * 4 + dc) * 64], qs[(r * 4 + dc) * 64], sa[r][kt]); }
    }
    asm volatile("s_waitcnt lgkmcnt(0)" ::: "memory");
    __builtin_amdgcn_sched_barrier(0);
    if (k0n >= 0) att_kdma(Kf, k0n, lane8, ring);
    __builtin_amdgcn_sched_barrier(0);
    bf16x8 Pb[NR];
    const float dqf = (float)dq;
#pragma unroll
    for (int r = 0; r < NR; ++r) {
        f32x4 s[2]; s[0] = sa[r][0]; s[1] = sa[r][1];
        float p[2][4];
        if (MODE == 2) {
#pragma unroll
            for (int kt = 0; kt < 2; ++kt)
#pragma unroll
                for (int j = 0; j < 4; ++j) { const bool valid = dq >= (16 * kt + j); p[kt][j] = valid ? s[kt][j] * SC * ex2(coef[r] * (dqf - (float)(16 * kt + j))) : 0.f; }
        } else {
            float mx = -INFINITY;
            const float base = -coef[r] * dqf;
            if (full) {
#pragma unroll
                for (int kt = 0; kt < 2; ++kt)
#pragma unroll
                    for (int j = 0; j < 4; ++j) { const float v = fmaf(coef[r], (float)(16 * kt + j), fmaf(s[kt][j], SC * LOG2E, base)); p[kt][j] = v; mx = fmaxf(mx, v); }
            } else {
#pragma unroll
                for (int kt = 0; kt < 2; ++kt)
#pragma unroll
                    for (int j = 0; j < 4; ++j) {
                        const bool valid = (MODE == 0) ? (vblk && dq >= (16 * kt + j)) : (dq >= (16 * kt + j) && dq < 512 + (16 * kt + j));
                        const float v = valid ? fmaf(coef[r], (float)(16 * kt + j), fmaf(s[kt][j], SC * LOG2E, base)) : -INFINITY;
                        p[kt][j] = v; mx = fmaxf(mx, v);
                    }
            }
            mx = rowred_max(mx);
            const float mnew = (mx - m[r] > 8.0f) ? mx : m[r], muse = (mnew == -INFINITY) ? 0.f : mnew;
            float ps = 0.f;
#pragma unroll
            for (int kt = 0; kt < 2; ++kt)
#pragma unroll
                for (int j = 0; j < 4; ++j) { p[kt][j] = ex2(p[kt][j] - muse); ps += p[kt][j]; }
#ifdef ALWAYS_RESCALE
            {
#else
            if (__ballot(mnew != m[r]) != 0ull) {
#endif
                const float alpha = ex2(m[r] - muse);
                l[r] *= alpha;
#pragma unroll
                for (int dt = 0; dt < NDT; ++dt) O[r][dt] *= alpha;
            }
            l[r] += ps; m[r] = mnew;
        }
        u32x4 pw; pw.x = cvt_pk_bf16(p[0][0], p[0][1]); pw.y = cvt_pk_bf16(p[0][2], p[0][3]); pw.z = cvt_pk_bf16(p[1][0], p[1][1]); pw.w = cvt_pk_bf16(p[1][2], p[1][3]);
        Pb[r] = __builtin_bit_cast(bf16x8, pw);
    }
#pragma unroll
    for (int dt = 0; dt < NDT; ++dt) {
#pragma unroll
        for (int r = 0; r < NR; ++r) O[r][dt] = MFMA16(vfr[dt], Pb[r], O[r][dt]);
        if ((dt & 3) == 3) __builtin_amdgcn_sched_barrier(0);
    }
}

template <int VSTEP = 4096>
__device__ __forceinline__ void att_vdma(const bf16_t* __restrict__ Vf, int k0, int lane8, LAS unsigned char* ring) {
    const bf16_t* vb = Vf + (size_t)(k0 >> 5) * VSTEP + lane8;
#pragma unroll
    for (int dt = 0; dt < 8; ++dt) __builtin_amdgcn_global_load_lds((const unsigned*)(vb + dt * 512), (LAS unsigned*)(ring + 8192 + dt * 1024), 16, 0, 0);
}
template <int MODE, int TSTEP = 0  , int VSTEP = 4096>
__device__ __forceinline__ void att_step2(const bf16_t* __restrict__ Kf, const bf16_t* __restrict__ Vf, int k0, int k0n  , int tq  , int lane8,
                                          const bf16x8 (&Qf)[2][4], LAS unsigned char* ring, int lane, f32x4 (&O)[2][8], float (&m)[2], float (&l)[2], const float (&coef)[2], bool vblk, bool full) {
    constexpr float SC = 0.08838834764831845f;
    constexpr int NR = 2, NDT = 8;
    const int dq = tq - k0;
    const LAS bf16x8* kr = (const LAS bf16x8*)ring + lane;
    const LAS bf16x8* vr = (const LAS bf16x8*)(ring + 8192) + lane;
    asm volatile("s_waitcnt vmcnt(8)" ::: "memory");
    f32x4 sa[NR][2];
#pragma unroll
    for (int kt = 0; kt < 2; ++kt) {
#pragma unroll
        for (int r = 0; r < NR; ++r) sa[r][kt] = (f32x4){0.f, 0.f, 0.f, 0.f};
#pragma unroll
        for (int dc = 0; dc < 4; ++dc) { const bf16x8 kf = kr[(kt * 4 + dc) * 64];
#pragma unroll
            for (int r = 0; r < NR; ++r) sa[r][kt] = MFMA16(kf, Qf[r][dc], sa[r][kt]); }
    }
    asm volatile("s_waitcnt lgkmcnt(0)" ::: "memory");
    __builtin_amdgcn_sched_barrier(0);
    if (k0n >= 0) att_kdma(Kf, k0n, lane8, ring);
    __builtin_amdgcn_sched_barrier(0);
    bf16x8 Pb[NR];
    const float dqf = (float)dq;
#pragma unroll
    for (int r = 0; r < NR; ++r) {
        float p[2][4];
        if (MODE == 2) {
            const int dqr = dq + r * TSTEP; const float dqrf = (float)dqr;
#pragma unroll
            for (int kt = 0; kt < 2; ++kt)
#pragma unroll
                for (int j = 0; j < 4; ++j) p[kt][j] = (dqr >= (16 * kt + j)) ? sa[r][kt][j] * SC * ex2(coef[r] * (dqrf - (float)(16 * kt + j))) : 0.f;
        } else {
        float mx = -INFINITY;
        const float base = -coef[r] * dqf;
        if (full) {
#pragma unroll
            for (int kt = 0; kt < 2; ++kt)
#pragma unroll
                for (int j = 0; j < 4; ++j) { const float v = fmaf(coef[r], (float)(16 * kt + j), fmaf(sa[r][kt][j], SC * LOG2E, base)); p[kt][j] = v; mx = fmaxf(mx, v); }
        } else {
#pragma unroll
            for (int kt = 0; kt < 2; ++kt)
#pragma unroll
                for (int j = 0; j < 4; ++j) {
                    const bool valid = (MODE == 0) ? (vblk && dq >= (16 * kt + j)) : (dq >= (16 * kt + j) && dq < 512 + (16 * kt + j));
                    const float v = valid ? fmaf(coef[r], (float)(16 * kt + j), fmaf(sa[r][kt][j], SC * LOG2E, base)) : -INFINITY;
                    p[kt][j] = v; mx = fmaxf(mx, v);
                }
        }
        mx = rowred_max(mx);
        const float mnew = (mx - m[r] > 8.0f) ? mx : m[r], muse = (mnew == -INFINITY) ? 0.f : mnew;
        float ps = 0.f;
#pragma unroll
        for (int kt = 0; kt < 2; ++kt)
#pragma unroll
            for (int j = 0; j < 4; ++j) { p[kt][j] = ex2(p[kt][j] - muse); ps += p[kt][j]; }
        if (__ballot(mnew != m[r]) != 0ull) {
            const float alpha = ex2(m[r] - muse);
            l[r] *= alpha;
#pragma unroll
            for (int dt = 0; dt < NDT; ++dt) O[r][dt] *= alpha;
        }
        l[r] += ps; m[r] = mnew;
        }
        u32x4 pw; pw.x = cvt_pk_bf16(p[0][0], p[0][1]); pw.y = cvt_pk_bf16(p[0][2], p[0][3]); pw.z = cvt_pk_bf16(p[1][0], p[1][1]); pw.w = cvt_pk_bf16(p[1][2], p[1][3]);
        Pb[r] = __builtin_bit_cast(bf16x8, pw);
    }
    __builtin_amdgcn_sched_barrier(0);
    if (k0n >= 0) asm volatile("s_waitcnt vmcnt(8)" ::: "memory"); else asm volatile("s_waitcnt vmcnt(0)" ::: "memory");
#pragma unroll
    for (int dt = 0; dt < NDT; ++dt) { const bf16x8 vf = vr[dt * 64];
#pragma unroll
        for (int r = 0; r < NR; ++r) O[r][dt] = MFMA16(vf, Pb[r], O[r][dt]); }
    asm volatile("s_waitcnt lgkmcnt(0)" ::: "memory");
    __builtin_amdgcn_sched_barrier(0);
    if (k0n >= 0) att_vdma<VSTEP>(Vf, k0n, lane8, ring);
    __builtin_amdgcn_sched_barrier(0);
}

struct MixPtrs { const bf16_t* Y; bf16_t* ONSA; bf16_t* ORET; const bf16_t* VTS; const bf16_t* VTW; const bf16_t* VTR; const bf16_t* KC; const bf16_t* VCT; const float* gn; const bf16_t* KS; const bf16_t* KW; const bf16_t* KR; };

__device__ __forceinline__ void cmp_unit(const MixPtrs& P, unsigned* __restrict__ SM, int bg, int grp, LAS unsigned char* lds, int tid) {
    const int lane = tid & 63, wave = __builtin_amdgcn_readfirstlane(tid >> 6), l15 = lane & 15, fq = lane >> 4;
    const int b = bg >> 2, g = bg & 3, t0 = (grp * 8 + wave) * 16, t = t0 + l15;
#pragma unroll
    for (int i = 0; i < 8; ++i) {
        const int blk = wave * 8 + i;
        const bf16_t* src = (blk < 32 ? P.KC + (size_t)bg * 16384 + blk * 512 : P.VCT + (size_t)bg * 16384 + (blk - 32) * 512) + lane * 8;
        __builtin_amdgcn_global_load_lds((const unsigned*)src, (LAS unsigned*)(lds + blk * 1024), 16, 0, 0);
    }
    const bf16_t* Yt = P.Y + (size_t)(b * 2048 + t) * LDY;
    bf16_t* orow = P.ONSA + (size_t)(b * 2048 + t) * D_;
    constexpr float SC2 = 0.08838834764831845f * LOG2E;
    const int tq64 = t - 64 * fq; const float tq64f = (float)tq64 - 15.5f;
    const LAS bf16x8* kl = (const LAS bf16x8*)lds + lane;
    const LAS bf16x8* vl = (const LAS bf16x8*)(lds + 32768) + lane;
    float pown[8], ptail[8];
#pragma unroll
    for (int kt = 0; kt < 8; ++kt) { pown[kt] = 0.f; ptail[kt] = 0.f; }
    asm volatile("s_waitcnt vmcnt(0)" ::: "memory");
    __syncthreads();
#pragma unroll 1
    for (int hd = 0; hd < 4; ++hd) {
        const int hh = 4 * g + hd;
        bf16x8 Qf[4];
#pragma unroll
        for (int dc = 0; dc < 4; ++dc) Qf[dc] = *(const bf16x8*)(Yt + OFF_Q + hh * 128 + 32 * dc + 8 * fq);
        const float gate = sigmoid_f(bf2f(Yt[OFF_GL + hh]));
        f32x4 s[8];
#pragma unroll
        for (int kt = 0; kt < 8; ++kt) { s[kt] = (f32x4){0.f, 0.f, 0.f, 0.f};
#pragma unroll
            for (int dc = 0; dc < 4; ++dc) s[kt] = MFMA16(kl[(kt * 4 + dc) * 64], Qf[dc], s[kt]); }
        const float slope2 = ex2(-0.5f * (float)(hh + 1)) * LOG2E;
        float mx = -INFINITY;
#pragma unroll
        for (int kt = 0; kt < 8; ++kt)
#pragma unroll
            for (int j = 0; j < 4; ++j) {
                const bool valid = (256 * kt + 16 * j + 31) <= tq64;
                const float v = valid ? s[kt][j] * SC2 - slope2 * (tq64f - (float)(256 * kt + 16 * j)) : -INFINITY;
                s[kt][j] = v; mx = fmaxf(mx, v);
            }
        mx = rowred_max(mx);
        const float muse = (mx == -INFINITY) ? 0.f : mx;
        float ls = 0.f;
#pragma unroll
        for (int kt = 0; kt < 8; ++kt)
#pragma unroll
            for (int j = 0; j < 4; ++j) { const float pv = ex2(s[kt][j] - muse); s[kt][j] = pv; ls += pv; }
        ls = rowred_sum(ls);
        const float inv = 1.0f / fmaxf(ls, 1.17549435e-38f);
#pragma unroll
        for (int kt = 0; kt < 8; ++kt)
#pragma unroll
            for (int j = 0; j < 4; ++j) s[kt][j] *= inv;
#pragma unroll
        for (int kt = 0; kt < 8; ++kt) { const float h3 = 0.5f * s[kt][3]; ptail[kt] += h3; pown[kt] += ((s[kt][0] + s[kt][1]) + s[kt][2]) + h3; }
        f32x4 O[8];
#pragma unroll
        for (int dt = 0; dt < 8; ++dt) O[dt] = (f32x4){0.f, 0.f, 0.f, 0.f};
#pragma unroll
        for (int ks = 0; ks < 4; ++ks) {
            u32x4 pw; pw.x = cvt_pk_bf16(s[2 * ks][0], s[2 * ks][1]); pw.y = cvt_pk_bf16(s[2 * ks][2], s[2 * ks][3]);
            pw.z = cvt_pk_bf16(s[2 * ks + 1][0], s[2 * ks + 1][1]); pw.w = cvt_pk_bf16(s[2 * ks + 1][2], s[2 * ks + 1][3]);
            const bf16x8 Pb = __builtin_bit_cast(bf16x8, pw);
#pragma unroll
            for (int dt = 0; dt < 8; ++dt) O[dt] = MFMA16(vl[(ks * 8 + dt) * 64], Pb, O[dt]);
        }
#pragma unroll
        for (int dt = 0; dt < 8; ++dt) {
            u32x2 w; w.x = cvt_pk_bf16(O[dt][0] * gate, O[dt][1] * gate); w.y = cvt_pk_bf16(O[dt][2] * gate, O[dt][3] * gate);
            *(u32x2*)(orow + hh * 128 + 16 * dt + 4 * fq) = w;
        }
    }
    {
        float val[8], sh[8];
        const int bq = (t >> 6) - fq;
#pragma unroll
        for (int kt = 0; kt < 8; ++kt) sh[kt] = __shfl(ptail[kt], (lane + 48) & 63);
#pragma unroll
        for (int kt = 0; kt < 8; ++kt) {
            const float prev = fq > 0 ? sh[kt] : (kt > 0 ? sh[kt > 0 ? kt - 1 : 0] : 0.f);
            const float imp = pown[kt] + prev;
            const bool forced = (kt == 0 && fq == 0) || (4 * kt == bq) || (4 * kt == bq - 1);
            val[kt] = forced ? 1e4f : (4 * kt <= bq ? imp : -1e4f);
        }
        int cnt[8];
#pragma unroll
        for (int kt = 0; kt < 8; ++kt) cnt[kt] = 0;
#pragma unroll 1
        for (int f2 = 0; f2 < 4; ++f2) {
            const int df = fq - f2;
#pragma unroll
            for (int k2 = 0; k2 < 8; ++k2) {
                const float o = __shfl(val[k2], l15 + 16 * f2);
#pragma unroll
                for (int kt = 0; kt < 8; ++kt) cnt[kt] += ((o > val[kt]) || (o == val[kt] && (4 * (k2 - kt)) < df)) ? 1 : 0;
            }
        }
        unsigned smq = 0;
#pragma unroll
        for (int kt = 0; kt < 8; ++kt) if (cnt[kt] < 16) smq |= 1u << (4 * kt);
        unsigned sm = smq << fq;
        sm |= __shfl_xor(sm, 16); sm |= __shfl_xor(sm, 32);
        if (fq == 0) SM[bg * 2048 + t] = sm;
    }
    __syncthreads();
}

__device__ __forceinline__ void nsa_unit(const MixPtrs& P, const unsigned* __restrict__ SM, int b, int g, int tile, int hp  , int lane, LAS bf16x8* qs  , LAS unsigned char* qbase  ) {
    const int l15 = lane & 15, fq = lane >> 4, t0 = tile * 16, t = t0 + l15, bg = b * 4 + g;
    const bf16_t* Yt = P.Y + (size_t)(b * 2048 + t) * LDY;
    bf16_t* orow = P.ONSA + (size_t)(b * 2048 + t) * D_;
    const int tq = t - 4 * fq, lane8 = lane * 8;
    const unsigned sm = SM[bg * 2048 + t];
    bf16x8 Qf[2][4];
#pragma unroll
    for (int r = 0; r < 2; ++r)
#pragma unroll
        for (int dc = 0; dc < 4; ++dc) Qf[r][dc] = *(const bf16x8*)(Yt + OFF_Q + (4 * g + 2 * hp + r) * 128 + 32 * dc + 8 * fq);
    {
        float coef[2], m[2], l[2]; f32x4 O[2][8];
        LAS unsigned char* ring = qbase;
#pragma unroll
        for (int r = 0; r < 2; ++r) coef[r] = ex2(-0.5f * (float)(4 * g + 2 * hp + r + 1)) * LOG2E;
#pragma unroll 1
        for (int br = 1; br < 3; ++br) {
#pragma unroll
            for (int r = 0; r < 2; ++r) { m[r] = -INFINITY; l[r] = 0.f;
#pragma unroll
                for (int dt = 0; dt < 8; ++dt) O[r][dt] = (f32x4){0.f, 0.f, 0.f, 0.f}; }
            asm volatile("s_waitcnt vmcnt(0) lgkmcnt(0)" ::: "memory");
            if (br == 1) {
                const bf16_t* Kp = P.KS + (size_t)bg * 262144; const bf16_t* Vt = P.VTS + (size_t)bg * 262144;
                const int blkmax = (t0 + 15) >> 6;
                unsigned U = 0;
#pragma unroll 1
                for (int jb = 0; jb <= blkmax; ++jb) if (__ballot((sm >> jb) & 1u) != 0ull) U |= 1u << jb;
                int jb = __builtin_ctz(U), k0 = 64 * jb;
                att_kdma(Kp, k0, lane8, ring); att_vdma(Vt, k0, lane8, ring);
#pragma unroll 1
                for (;;) {
                    int k0n, jbn = jb;
                    if ((k0 & 32) == 0) k0n = k0 + 32;
                    else { const unsigned rest = jb >= 31 ? 0u : (U >> (jb + 1)); if (rest == 0u) k0n = -1; else { jbn = jb + 1 + __builtin_ctz(rest); k0n = 64 * jbn; } }
                    const bool vb = (sm >> jb) & 1u;
                    const bool full = (k0 + 31 <= t0) && (__ballot(vb) == ~0ull);
                    att_step2<0>(Kp, Vt, k0, k0n, tq, lane8, Qf, ring, lane, O, m, l, coef, vb, full);
                    if (k0n < 0) break;
                    k0 = k0n; jb = jbn;
                }
            } else {
                const bf16_t* Kp = P.KW + (size_t)bg * 262144; const bf16_t* Vt = P.VTW + (size_t)bg * 262144;
                int kstart = t0 - 511; kstart = kstart < 0 ? 0 : (kstart & ~31);
                att_kdma(Kp, kstart, lane8, ring); att_vdma(Vt, kstart, lane8, ring);
#pragma unroll 1
                for (int k0 = kstart; k0 <= t0; k0 += 32) att_step2<1>(Kp, Vt, k0, (k0 + 32 <= t0) ? k0 + 32 : -1, tq, lane8, Qf, ring, lane, O, m, l, coef, true, (k0 + 31 <= t0) && (k0 >= t0 - 496));
            }
#pragma unroll
            for (int r = 0; r < 2; ++r) {
                const int hh = 4 * g + 2 * hp + r;
                const float lt = rowred_sum(l[r]);
                const float sc = sigmoid_f(bf2f(Yt[OFF_GL + br * 16 + hh])) / fmaxf(lt, 1.17549435e-38f);
#pragma unroll
                for (int dt = 0; dt < 8; ++dt) {
                    u32x2* op = (u32x2*)(orow + hh * 128 + 16 * dt + 4 * fq);
                    const u32x2 pw = *op;
                    u32x2 w; w.x = cvt_pk_bf16(bf_lo(pw.x) + O[r][dt][0] * sc, bf_hi(pw.x) + O[r][dt][1] * sc);
                    w.y = cvt_pk_bf16(bf_lo(pw.y) + O[r][dt][2] * sc, bf_hi(pw.y) + O[r][dt][3] * sc);
                    *op = w;
                }
            }
        }
    }
}

__device__ __forceinline__ void ret_unit(const MixPtrs& P, int b, int h, int tile, int lane, LAS bf16x8* qs, LAS unsigned char* qbase) {
    const int l15 = lane & 15, fq = lane >> 4, t0 = tile * 16, t = t0 + l15;
    const bf16_t* Yb = P.Y + (size_t)(b * 2048) * LDY;
    const bf16_t* Yt = Yb + (size_t)t * LDY;
    float coef[1], m[1], l[1]; f32x4 O[1][16];
    const LAS bf16x8* Qf = qs;
#pragma unroll
    for (int dc = 0; dc < 4; ++dc) qs[dc * 64] = *(const bf16x8*)(Yt + OFF_QR + h * 128 + 32 * dc + 8 * fq);
    coef[0] = log1pf(-exp2f(-5.0f - (float)h)) * LOG2E; m[0] = 0.f; l[0] = 0.f;
#pragma unroll
    for (int dt = 0; dt < 16; ++dt) O[0][dt] = (f32x4){0.f, 0.f, 0.f, 0.f};
    const bf16_t* Kp = P.KR + (size_t)(b * 8 + h) * 262144; const bf16_t* Vt = P.VTR + (size_t)(b * 8 + h) * 524288;
    LAS unsigned char* ring = qbase + 8192;
    asm volatile("s_waitcnt lgkmcnt(0)" ::: "memory");
    att_kdma(Kp, 0, lane * 8, ring);
#pragma unroll 1
    for (int k0 = 0; k0 <= t0; k0 += 32) att_step<1, 16, 2>(Kp, Vt, k0, (k0 + 32 <= t0) ? k0 + 32 : -1, t - 4 * fq, lane * 8, Qf, ring, lane, O, m, l, coef, true);
    float sum = 0.f;
#pragma unroll
    for (int dt = 0; dt < 16; ++dt) sum += (O[0][dt][0] + O[0][dt][1]) + (O[0][dt][2] + O[0][dt][3]);
    sum = rowred_sum(sum);
    const float mean = sum * (1.0f / 256.0f);
    float var = 0.f;
#pragma unroll
    for (int dt = 0; dt < 16; ++dt) { const f32x4 d = O[0][dt] - mean; var += (d[0] * d[0] + d[1] * d[1]) + (d[2] * d[2] + d[3] * d[3]); }
    var = rowred_sum(var);
    const float rstd = 1.0f / sqrtf(var * (1.0f / 256.0f) + EPS_);
    bf16_t* orow = P.ORET + (size_t)(b * 2048 + t) * D_ + h * 256;
#pragma unroll
    for (int dt = 0; dt < 16; ++dt) {
        const int e = 16 * dt + 4 * fq;
        const f32x4 gain = *(const f32x4*)(P.gn + h * 256 + e);
        const u32x2 gw = *(const u32x2*)(Yt + OFF_GR + h * 256 + e);
        const f32x4 y = (O[0][dt] - mean) * rstd * gain;
        u32x2 w; w.x = cvt_pk_bf16(silu_f(bf_lo(gw.x)) * y[0], silu_f(bf_hi(gw.x)) * y[1]); w.y = cvt_pk_bf16(silu_f(bf_lo(gw.y)) * y[2], silu_f(bf_hi(gw.y)) * y[3]);
        *(u32x2*)(orow + e) = w;
    }
}

__device__ __forceinline__ void ret_unit2(const MixPtrs& P, int b, int h, int tile32, int lane, LAS unsigned char* ring) {
    const int l15 = lane & 15, fq = lane >> 4, t0 = tile32 * 32, lane8 = lane * 8;
    const bf16_t* Yb = P.Y + (size_t)(b * 2048) * LDY;
    bf16x8 Qf[2][4]; float coef[2], m[2], l[2]; f32x4 O[2][8], Oa[2][8];
#pragma unroll
    for (int r = 0; r < 2; ++r)
#pragma unroll
        for (int dc = 0; dc < 4; ++dc) Qf[r][dc] = *(const bf16x8*)(Yb + (size_t)(t0 + 16 * r + l15) * LDY + OFF_QR + h * 128 + 32 * dc + 8 * fq);
    coef[0] = log1pf(-exp2f(-5.0f - (float)h)) * LOG2E; coef[1] = coef[0]; m[0] = m[1] = 0.f; l[0] = l[1] = 0.f;
    const bf16_t* Kp = P.KR + (size_t)(b * 8 + h) * 262144;
    const int tq = t0 + l15 - 4 * fq;
#pragma unroll
    for (int hf = 0; hf < 2; ++hf) {
        const bf16_t* Vt = P.VTR + (size_t)(b * 8 + h) * 524288 + hf * 4096;
#pragma unroll
        for (int r = 0; r < 2; ++r)
#pragma unroll
            for (int dt = 0; dt < 8; ++dt) O[r][dt] = (f32x4){0.f, 0.f, 0.f, 0.f};
        asm volatile("s_waitcnt vmcnt(0) lgkmcnt(0)" ::: "memory");
        att_kdma(Kp, 0, lane8, ring); att_vdma<8192>(Vt, 0, lane8, ring);
#pragma unroll 1
        for (int k0 = 0; k0 <= t0; k0 += 32) att_step2<2, 16, 8192>(Kp, Vt, k0, (k0 + 32 <= t0) ? k0 + 32 : -1, tq, lane8, Qf, ring, lane, O, m, l, coef, true, false);
        if (hf == 0) {
#pragma unroll
            for (int r = 0; r < 2; ++r)
#pragma unroll
                for (int dt = 0; dt < 8; ++dt) Oa[r][dt] = O[r][dt];
        }
    }
#pragma unroll
    for (int r = 0; r < 2; ++r) {
        float sum = 0.f;
#pragma unroll
        for (int dt = 0; dt < 8; ++dt) sum += ((Oa[r][dt][0] + Oa[r][dt][1]) + (Oa[r][dt][2] + Oa[r][dt][3])) + ((O[r][dt][0] + O[r][dt][1]) + (O[r][dt][2] + O[r][dt][3]));
        sum = rowred_sum(sum);
        const float mean = sum * (1.0f / 256.0f);
        float var = 0.f;
#pragma unroll
        for (int dt = 0; dt < 8; ++dt) { const f32x4 d0 = Oa[r][dt] - mean, d1 = O[r][dt] - mean;
            var += ((d0[0] * d0[0] + d0[1] * d0[1]) + (d0[2] * d0[2] + d0[3] * d0[3])) + ((d1[0] * d1[0] + d1[1] * d1[1]) + (d1[2] * d1[2] + d1[3] * d1[3])); }
        var = rowred_sum(var);
        const float rstd = 1.0f / sqrtf(var * (1.0f / 256.0f) + EPS_);
        const int t = t0 + 16 * r + l15;
        const bf16_t* Yt = Yb + (size_t)t * LDY;
        bf16_t* orow = P.ORET + (size_t)(b * 2048 + t) * D_ + h * 256;
#pragma unroll
        for (int hf = 0; hf < 2; ++hf)
#pragma unroll
            for (int dt = 0; dt < 8; ++dt) {
                const int e = 128 * hf + 16 * dt + 4 * fq;
                const f32x4 gain = *(const f32x4*)(P.gn + h * 256 + e);
                const u32x2 gw = *(const u32x2*)(Yt + OFF_GR + h * 256 + e);
                const f32x4 y = ((hf ? O[r][dt] : Oa[r][dt]) - mean) * rstd * gain;
                u32x2 w; w.x = cvt_pk_bf16(silu_f(bf_lo(gw.x)) * y[0], silu_f(bf_hi(gw.x)) * y[1]); w.y = cvt_pk_bf16(silu_f(bf_lo(gw.y)) * y[2], silu_f(bf_hi(gw.y)) * y[3]);
                *(u32x2*)(orow + e) = w;
            }
    }
}

__device__ __forceinline__ void compress_unit(int unit, const bf16_t* __restrict__ Y, const float* __restrict__ cmp_pos, const float* __restrict__ cmp_b1, const float* __restrict__ g_qk,
                                              const bf16_t* __restrict__ WC1, const bf16_t* __restrict__ WC2, bf16_t* __restrict__ KC, bf16_t* __restrict__ VCT, LAS unsigned char* lds, int tid) {
    const int lane = tid & 63, wave = tid >> 6, l15 = lane & 15, fq = lane >> 4;
    const int i = unit >> 7, bg = (unit >> 3) & 15, ct = unit & 7, b = bg >> 2, g = bg & 3;
    const int c = 16 * ct + l15; const bool cvalid = c < 127;
    const bf16_t* Yc = Y + (size_t)(b * 2048 + 16 * (cvalid ? c : 0)) * LDY + OFF_KV + i * 512 + g * 128;
    LAS float* red = (LAS float*)lds;
    LAS bf16_t* hid = (LAS bf16_t*)(lds + 65536);
    f32x4 acc[8];
#pragma unroll
    for (int nt = 0; nt < 8; ++nt) acc[nt] = (f32x4){0.f, 0.f, 0.f, 0.f};
#pragma unroll 1
    for (int ls = 0; ls < 4; ++ls) {
        const int l = 4 * wave + ls;
#pragma unroll
        for (int dc = 0; dc < 4; ++dc) {
            const int d = 32 * dc + 8 * fq;
            u32x4 aw = (u32x4){0u, 0u, 0u, 0u};
            if (cvalid) {
                const u32x4 zw = *(const u32x4*)(Yc + (size_t)l * LDY + d);
                const f32x4 p0 = *(const f32x4*)(cmp_pos + (size_t)(i * 32 + l) * 128 + d), p1 = *(const f32x4*)(cmp_pos + (size_t)(i * 32 + l) * 128 + d + 4);
                aw.x = cvt_pk_bf16(bf_lo(zw.x) + p0[0], bf_hi(zw.x) + p0[1]); aw.y = cvt_pk_bf16(bf_lo(zw.y) + p0[2], bf_hi(zw.y) + p0[3]);
                aw.z = cvt_pk_bf16(bf_lo(zw.z) + p1[0], bf_hi(zw.z) + p1[1]); aw.w = cvt_pk_bf16(bf_lo(zw.w) + p1[2], bf_hi(zw.w) + p1[3]);
            }
            const bf16x8 a = __builtin_bit_cast(bf16x8, aw);
            const int kidx = l * 128 + 32 * dc + 8 * fq;
#pragma unroll
            for (int nt = 0; nt < 8; ++nt) { const bf16x8 bf = *(const bf16x8*)(WC1 + (size_t)i * 524288 + (size_t)(((l * 4 + dc) * 8 + nt) * 64 + lane) * 8); acc[nt] = MFMA16(a, bf, acc[nt]); }
        }
    }
#pragma unroll
    for (int nt = 0; nt < 8; ++nt)
#pragma unroll
        for (int j = 0; j < 4; ++j) red[(wave * 16 + 4 * fq + j) * 128 + 16 * nt + l15] = acc[nt][j];
    __syncthreads();
    {
        const int e = tid * 4, cc = e >> 7, n = e & 127;
        f32x4 s = *(const f32x4*)(cmp_b1 + i * 128 + n);
#pragma unroll
        for (int w = 0; w < 8; ++w) s += *(const LAS f32x4*)(red + (w * 16 + cc) * 128 + n);
        float o[4];
#pragma unroll
        for (int j = 0; j < 4; ++j) { const float x = s[j]; o[j] = 0.5f * x * (1.0f + tanhf(0.7978845608028654f * (x + 0.044715f * x * x * x))); }
        u32x2 w; w.x = cvt_pk_bf16(o[0], o[1]); w.y = cvt_pk_bf16(o[2], o[3]);
        *(LAS u32x2*)(hid + cc * 136 + n) = w;
    }
    __syncthreads();
    f32x4 o2 = (f32x4){0.f, 0.f, 0.f, 0.f};
#pragma unroll
    for (int kc = 0; kc < 4; ++kc) {
        const bf16x8 a = *(const LAS bf16x8*)(hid + l15 * 136 + 32 * kc + 8 * fq);
        const bf16x8 bf = *(const bf16x8*)(WC2 + (size_t)(i * 128 + 16 * wave + l15) * 128 + 32 * kc + 8 * fq);
        o2 = MFMA16(a, bf, o2);
    }
    if (i == 1) {
        const int cbase = 16 * ct + 4 * fq;
        u32x2 w; w.x = cvt_pk_bf16(cbase + 0 < 127 ? o2[0] : 0.f, cbase + 1 < 127 ? o2[1] : 0.f); w.y = cvt_pk_bf16(cbase + 2 < 127 ? o2[2] : 0.f, cbase + 3 < 127 ? o2[3] : 0.f);
        *(u32x2*)(VCT + (size_t)bg * 16384 + (((ct >> 1) * 8 + wave) * 64 + lane) * 8 + 4 * (ct & 1)) = w;
    } else {
#pragma unroll
        for (int j = 0; j < 4; ++j) red[(4 * fq + j) * 128 + 16 * wave + l15] = o2[j];
        __syncthreads();
        const int cc = tid >> 5, part = tid & 31;
        const f32x4 v = *(const LAS f32x4*)(red + cc * 128 + 4 * part);
        float ss = (v[0] * v[0] + v[1] * v[1]) + (v[2] * v[2] + v[3] * v[3]);
#pragma unroll
        for (int o = 1; o < 32; o <<= 1) ss += __shfl_xor(ss, o);
        const float r = 1.0f / sqrtf(ss * (1.0f / 128.0f) + EPS_);
        const f32x4 gq = *(const f32x4*)(g_qk + 128 + 4 * part);
        f32x4 y = v * r * gq;
        if (16 * ct + cc >= 127) y = (f32x4){0.f, 0.f, 0.f, 0.f};
        u32x2 w; w.x = cvt_pk_bf16(y[0], y[1]); w.y = cvt_pk_bf16(y[2], y[3]);
        *(u32x2*)(KC + (size_t)bg * 16384 + (ct * 4 + (part >> 3)) * 512 + ((part >> 1) & 3) * 128 + cc * 8 + 4 * (part & 1)) = w;
    }
    __syncthreads();
}


#define XB_TMO      128
#define XB_XCNT(j)  (256  + 64 * (j))
#define XB_XSUB(j)  (1280 + 64 * (j))
#define XB_XGEN(j)  (2304 + 64 * (j))
#define XB_TOP      3328
#define XB_TOPGEN   3392
#define XCD_BAR_WORDS 3456
#define XB_SPIN_CAP (1u << 18)
__device__ __forceinline__ unsigned xb_ld(unsigned* p)              { return __hip_atomic_load(p, __ATOMIC_RELAXED, __HIP_MEMORY_SCOPE_AGENT); }
__device__ __forceinline__ unsigned xb_add(unsigned* p, unsigned v) { return __hip_atomic_fetch_add(p, v, __ATOMIC_RELAXED, __HIP_MEMORY_SCOPE_AGENT); }
__device__ __forceinline__ unsigned xb_xcc_id() { return (unsigned)__builtin_amdgcn_s_getreg((3 << 11) | 20) & 0xFu; }
#define XB_SPIN(cond, bar) do { unsigned _sp = 0; while (cond) { __builtin_amdgcn_s_sleep(1); \
    if ((++_sp & 255u) == 0u) { if (xb_ld(&(bar)[XB_TMO])) break; if (_sp > XB_SPIN_CAP) { atomicAdd(&(bar)[XB_TMO], 1u); break; } } } } while (0)
struct XcdBarrier { unsigned* bar; unsigned x; volatile LAS unsigned* st; };
__device__ __forceinline__ XcdBarrier xcd_barrier_post(unsigned* bar, volatile LAS unsigned* st) {
    XcdBarrier b; b.bar = bar; b.x = xb_xcc_id(); b.st = st;
    if (threadIdx.x == 0) (void)xb_add(&bar[XB_XCNT(b.x)], 1u);
    return b;
}
__device__ __forceinline__ void xcd_barrier_complete(unsigned* bar, unsigned x, unsigned& nloc, unsigned& nx) {
    const unsigned G = gridDim.x * gridDim.y * gridDim.z;
    unsigned sum, cnt, mine, sp = 0u;
    for (;;) {
        sum = 0u; cnt = 0u; mine = 0u;
#pragma unroll
        for (unsigned j = 0; j < 16; ++j) { const unsigned c = xb_ld(&bar[XB_XCNT(j)]); sum += c; cnt += (c > 0u) ? 1u : 0u; mine = (j == x) ? c : mine; }
        if (sum == G) break;
        __builtin_amdgcn_s_sleep(1);
        if ((++sp & 255u) == 0u) { if (xb_ld(&bar[XB_TMO])) break; if (sp > XB_SPIN_CAP) { atomicAdd(&bar[XB_TMO], 1u); break; } }
    }
    nloc = mine > 0u ? mine : 1u; nx = cnt > 0u ? cnt : 1u;
}
__device__ __forceinline__ void xcd_barrier(const XcdBarrier& b) {
    asm volatile("s_waitcnt vmcnt(0)" ::: "memory");
    __syncthreads();
    if (threadIdx.x == 0) {
        unsigned* bar = b.bar;
        __builtin_amdgcn_s_waitcnt(0);
        unsigned nloc = b.st[0], nx = b.st[1];
        if (nloc == 0u) { xcd_barrier_complete(bar, b.x, nloc, nx); b.st[0] = nloc; b.st[1] = nx; }
        const unsigned old = xb_add(&bar[XB_XSUB(b.x)], 1u);
        const unsigned gen = old / nloc;
        if (old + 1u == (gen + 1u) * nloc) {
            __builtin_amdgcn_fence(__ATOMIC_RELEASE, "agent");
            asm volatile("s_waitcnt vmcnt(0)" ::: "memory");
            const unsigned og = xb_add(&bar[XB_TOP], 1u);
            const unsigned tg = og / nx;
            if (og + 1u == (tg + 1u) * nx) xb_add(&bar[XB_TOPGEN], 1u);
            else XB_SPIN(xb_ld(&bar[XB_TOPGEN]) == tg, bar);
            __builtin_amdgcn_fence(__ATOMIC_ACQUIRE, "agent");
            xb_add(&bar[XB_XGEN(b.x)], 1u);
            asm volatile("s_waitcnt vmcnt(0)" ::: "memory");
        } else {
            XB_SPIN(xb_ld(&bar[XB_XGEN(b.x)]) == gen, bar);
            __builtin_amdgcn_fence(__ATOMIC_ACQUIRE, "agent");
            asm volatile("s_waitcnt vmcnt(0)" ::: "memory");
        }
    }
    __syncthreads();
}

struct Params {
    const float *x, *c, *w_ada, *b_ada, *g_norm, *w_gate, *w_up, *w_down, *w_in, *g_qk, *cmp_pos, *cmp_w1, *cmp_b1, *cmp_w2, *gn_gain, *w_pn, *w_pr, *w_out;
    float* out; unsigned char* ws; int mask; int pad;
};

struct ConvTile { const float* W; bf16_t* WT; int K, N, mode, k0, n0; };
__device__ __forceinline__ ConvTile conv_tile(const Params& p, int set, int idx) {
    ConvTile c; int r = idx, nbn;
    constexpr int T_GU = (D_ / 128) * (FF_ / 128), T_IN = (D_ / 128) * ((NIN_ + 127) / 128), T_P = (D_ / 128) * (D_ / 128), T_C1 = 4096 / 128;
    const int layer = set;
    if (set == 1 || r < 3 * T_GU) {
        bf16_t* gu = (bf16_t*)(p.ws + (layer ? WS_WGU2 : WS_WGU)); bf16_t* dn = (bf16_t*)(p.ws + (layer ? WS_WD2 : WS_WD));
        if (r < T_GU) { c.W = p.w_gate + (size_t)layer * D_ * FF_; c.WT = gu; c.K = D_; c.N = FF_; c.mode = 1; }
        else if (r < 2 * T_GU) { r -= T_GU; c.W = p.w_up + (size_t)layer * D_ * FF_; c.WT = gu; c.K = D_; c.N = FF_; c.mode = 2; }
        else { r -= 2 * T_GU; c.W = p.w_down + (size_t)layer * D_ * FF_; c.WT = dn; c.K = FF_; c.N = D_; c.mode = 0; }
    } else {
        r -= 3 * T_GU;
        if (r < T_IN) { c.W = p.w_in; c.WT = (bf16_t*)(p.ws + WS_WIN); c.K = D_; c.N = NIN_; c.mode = 3; }
        else if (r < T_IN + 3 * T_P) { r -= T_IN; const int w = r / T_P; r -= w * T_P; c.W = w == 0 ? p.w_pn : (w == 1 ? p.w_pr : p.w_out);
            c.WT = (bf16_t*)(p.ws + (w == 0 ? WS_WPN : (w == 1 ? WS_WPR : WS_WO))); c.K = D_; c.N = D_; c.mode = 0; }
        else if (r < T_IN + 3 * T_P + 2 * T_C1) { r -= T_IN + 3 * T_P; const int i = r / T_C1; r -= i * T_C1; c.W = p.cmp_w1 + (size_t)i * 4096 * 128; c.WT = (bf16_t*)(p.ws + WS_WC1) + (size_t)i * 128 * 4096; c.K = 4096; c.N = 128; c.mode = 4; }
        else { r -= T_IN + 3 * T_P + 2 * T_C1; c.W = p.cmp_w2 + (size_t)r * 128 * 128; c.WT = (bf16_t*)(p.ws + WS_WC2) + (size_t)r * 128 * 128; c.K = 128; c.N = 128; c.mode = 0; r = 0; }
    }
    nbn = (c.N + 127) >> 7;
    const int kb = r / nbn, nb = r - kb * nbn; c.k0 = kb * 128; c.n0 = nb * 128;
    return c;
}
__device__ __forceinline__ void conv_load(const ConvTile& c, int tid, f32x4 (&r)[8]) {
    const int c4 = (tid & 31) * 4, r0 = 2 * (tid >> 5);
    const bool ok = (c.n0 + c4) < c.N;
    const float* src = c.W + (size_t)(c.k0 + r0) * c.N + c.n0 + c4;
#pragma unroll
    for (int i = 0; i < 4; ++i)
#pragma unroll
        for (int e = 0; e < 2; ++e) r[2 * i + e] = ok ? *(const f32x4*)(src + (size_t)(32 * i + e) * c.N) : (f32x4){0.f, 0.f, 0.f, 0.f};
}
constexpr int CONV_SPLIT = 1500;
constexpr int CONV_T0 = 3 * ((D_ / 128) * (FF_ / 128)) + (D_ / 128) * ((NIN_ + 127) / 128) + 3 * (D_ / 128) * (D_ / 128) + 2 * (4096 / 128) + 2, CONV_T1 = 3 * ((D_ / 128) * (FF_ / 128));
__device__ __forceinline__ void conv_phase(const Params& p, int set, LAS unsigned char* lds, int tid, int bid, int G, int first, int total) {
    f32x4 r[8];
    int idx = first + bid;
    if (idx < total) { const ConvTile c = conv_tile(p, set, idx); conv_load(c, tid, r); }
    for (int it = 0; idx < total; ++it, idx += G) {
        const ConvTile c = conv_tile(p, set, idx);
        LAS bf16_t* buf = (LAS bf16_t*)(lds + (it & 1) * 34816);
        {
            const int c4 = (tid & 31) * 4, r0 = 2 * (tid >> 5);
#pragma unroll
            for (int i = 0; i < 4; ++i)
#pragma unroll
                for (int j = 0; j < 4; ++j) *(LAS unsigned*)(buf + (c4 + j) * 136 + r0 + 32 * i) = cvt_pk_bf16(r[2 * i][j], r[2 * i + 1][j]);
        }
        if (idx + G < total) { const ConvTile n = conv_tile(p, set, idx + G); conv_load(n, tid, r); }
        __syncthreads();
#pragma unroll
        for (int i = 0; i < 4; ++i) {
            const int q = tid + 512 * i, n = q >> 4, kc = q & 15;
            const u32x4 w = *(const LAS u32x4*)(buf + n * 136 + 8 * kc);
            if (c.mode == 4) {
                const int k = c.k0 + 8 * kc;
                *(u32x4*)(c.WT + (size_t)((((k >> 5) * 8 + (n >> 4)) * 64 + ((k >> 3) & 3) * 16 + (n & 15)) * 8)) = w;
            } else if (c.n0 + n < c.N) *(u32x4*)(c.WT + (size_t)rowmap(c.mode, c.n0 + n) * c.K + c.k0 + 8 * kc) = w;
        }
    }
    __syncthreads();
}

__global__ void __launch_bounds__(512, 2) fwd_kernel(Params p) {
    extern __shared__ __attribute__((aligned(16))) unsigned char lds_raw[];
    cg::grid_group grid = cg::this_grid();
    LAS unsigned char* lds = (LAS unsigned char*)lds_raw;
    const int tid = threadIdx.x, lane = tid & 63, wave = __builtin_amdgcn_readfirstlane(tid >> 6);
    const int G = gridDim.x, gw = blockIdx.x * 8 + wave, NGW = G * 8;
#define ctl ((unsigned*)(p.ws + WS_CTL))
#define ada ((float*)(p.ws + WS_ADA))
#define WGU ((bf16_t*)(p.ws + WS_WGU))
#define WD ((bf16_t*)(p.ws + WS_WD))
#define WIN ((bf16_t*)(p.ws + WS_WIN))
#define WPN ((bf16_t*)(p.ws + WS_WPN))
#define WPR ((bf16_t*)(p.ws + WS_WPR))
#define WO ((bf16_t*)(p.ws + WS_WO))
#define WC1 ((bf16_t*)(p.ws + WS_WC1))
#define WC2 ((bf16_t*)(p.ws + WS_WC2))
#define H ((bf16_t*)(p.ws + WS_H))
#define ONSA ((bf16_t*)(p.ws + WS_H))
#define Y ((bf16_t*)(p.ws + WS_Y))
#define ACT ((bf16_t*)(p.ws + WS_Y))
#define MG ((bf16_t*)(p.ws + WS_MG))
#define ORET ((bf16_t*)(p.ws + WS_ORET))
#define VTS ((bf16_t*)(p.ws + WS_VTS))
#define VTW ((bf16_t*)(p.ws + WS_VTW))
#define VTR ((bf16_t*)(p.ws + WS_VTR))
#define KC ((bf16_t*)(p.ws + WS_KC))
#define VCT ((bf16_t*)(p.ws + WS_VCT))
#define KS ((bf16_t*)(p.ws + WS_KS))
#define KW ((bf16_t*)(p.ws + WS_KW))
#define KR ((bf16_t*)(p.ws + WS_KR))
    const int mask = p.mask;
    { LAS unsigned* xbw = (LAS unsigned*)(lds + 131072); if (tid < 4) xbw[tid] = 0u; }
    if (blockIdx.x == 0) { u32x4* z = (u32x4*)(p.ws + WS_CTL); for (int i = tid; i < 32768 / 16; i += 512) z[i] = (u32x4){0u, 0u, 0u, 0u}; }
    __syncthreads();
#ifdef USE_CG_SYNC
#define GSYNC() grid.sync()
#else
#define GSYNC() xcd_barrier(xbar)
#endif
#ifndef DBL_MASK
#define DBL_MASK 0
#endif
#ifdef PROBE_CMP_FIRST
#define CMP_ONLY_COND (rep == 0)
#else
#define CMP_ONLY_COND false
#endif
#define REPS(k) (1 + ((DBL_MASK >> (k)) & 1))
#ifdef CT_MASK
#define ON(k) ((CT_MASK >> (k)) & 1)
#else
#define ON(k) ((mask >> (k)) & 1)
#endif

    for (int rep = 0; rep < REPS(0); ++rep) { if (rep) grid.sync();
    if (ON(0)) {
        LAS float* cond = (LAS float*)lds;
        LAS float* red = (LAS float*)(lds + 32768);
        for (int i = tid; i < 4 * D_; i += 512) cond[i] = silu_f(p.c[i]);
        __syncthreads();
        for (int it = blockIdx.x; it < NADA / 64; it += G) {
            const int n = it * 64 + lane; float a0 = 0.f, a1 = 0.f, a2 = 0.f, a3 = 0.f;
            const int kb = wave * 256;
#pragma unroll 8
            for (int kk = 0; kk < 256; ++kk) { const int k = kb + kk; const float w = p.w_ada[(size_t)k * NADA + n];
                a0 += cond[k] * w; a1 += cond[D_ + k] * w; a2 += cond[2 * D_ + k] * w; a3 += cond[3 * D_ + k] * w; }
            red[(wave * 4 + 0) * 64 + lane] = a0; red[(wave * 4 + 1) * 64 + lane] = a1; red[(wave * 4 + 2) * 64 + lane] = a2; red[(wave * 4 + 3) * 64 + lane] = a3;
            __syncthreads();
            if (tid < 256) { const int bb = tid >> 6, l = tid & 63; float s = p.b_ada[it * 64 + l];
#pragma unroll
                for (int w = 0; w < 8; ++w) s += red[(w * 4 + bb) * 64 + l];
                ada[(size_t)bb * NADA + it * 64 + l] = s; }
            __syncthreads();
        }
        __syncthreads();
        conv_phase(p, 0, lds, tid, (int)blockIdx.x, G, 0, CONV_T0);
        { u32x4* z = (u32x4*)(WIN + (size_t)NIN_ * D_); const int nz = (LDY - NIN_) * D_ * 2 / 16;
          for (int i = blockIdx.x * 512 + tid; i < nz; i += G * 512) z[i] = (u32x4){0u, 0u, 0u, 0u}; }
    }
    }
    grid.sync();
    const XcdBarrier xbar = xcd_barrier_post((unsigned*)(p.ws + WS_BAR), (volatile LAS unsigned*)(lds + 131072));
    for (int rep = 0; rep < REPS(1); ++rep) { if (rep) GSYNC();
    if (ON(1)) norm_rows(p.x, p.g_norm, ada, 0, 1, H, gw, NGW, lane);
    }
    GSYNC();
    for (int rep = 0; rep < REPS(2); ++rep) { if (rep) GSYNC();
    if (ON(2)) {
        pg8::Gemm g{H, WGU, T_, 2 * FF_, D_}; pg8::StaticOrder S; S.init(T_, 2 * FF_, G, (int)blockIdx.x);
        EpiSwiglu E{ACT};
        pg8::gemm_phase<EpiSwiglu, pg8::StaticOrder, true, true>(lds, g, S, E);
        { const int rem = ((T_ / 256) * (2 * FF_ / 256)) % G;
          if (rep == 0 && rem && (int)blockIdx.x >= rem) { __syncthreads(); conv_phase(p, 1, lds, tid, (int)blockIdx.x - rem, G - rem, 0, CONV_SPLIT); } }
    }
    }
    GSYNC();
    if (ON(3)) {
        pg8::Gemm g{ACT, WD, T_, D_, FF_}; pg8::StaticOrder S; S.init(T_, D_, G, (int)blockIdx.x);
        EpiResid E{p.x, p.out, ada + 2 * D_, 0.5f};
        pg8::gemm_phase<EpiResid, pg8::StaticOrder, true, true>(lds, g, S, E);
    } else {
        for (size_t i = (size_t)blockIdx.x * 512 + tid; i < (size_t)T_ * D_ / 4; i += (size_t)G * 512) ((f32x4*)p.out)[i] = ((const f32x4*)p.x)[i];
    }
    GSYNC();
    for (int rep = 0; rep < REPS(4); ++rep) { if (rep) GSYNC();
    if (ON(4)) {
        norm_rows(p.out, p.g_norm + D_, ada, 3, 4, H, gw, NGW, lane);
        __syncthreads();
        { const int rem2 = ((T_ / 256) * (2 * FF_ / 256)) % G, rem5 = ((T_ / 256) * (LDY / 256)) % G;
          const int lo = rem2 ? CONV_SPLIT : 0, hi = rem5 ? CONV_SPLIT : CONV_T1;
          if (!rem2) conv_phase(p, 1, lds, tid, (int)blockIdx.x, G, 0, CONV_SPLIT);
          if (!rem5) conv_phase(p, 1, lds, tid, (int)blockIdx.x, G, CONV_SPLIT, CONV_T1);
          (void)lo; (void)hi; }
    }
    }
    GSYNC();
    for (int rep = 0; rep < REPS(5); ++rep) { if (rep) GSYNC();
    if (ON(5)) {
        pg8::Gemm g{H, WIN, T_, LDY, D_}; pg8::StaticOrder S; S.init(T_, LDY, G, (int)blockIdx.x);
        EpiY E{Y};
        pg8::gemm_phase<EpiY, pg8::StaticOrder, true, true>(lds, g, S, E);
        { const int rem = ((T_ / 256) * (LDY / 256)) % G;
          if (rep == 0 && rem && (int)blockIdx.x >= rem) { __syncthreads(); conv_phase(p, 1, lds, tid, (int)blockIdx.x - rem, G - rem, CONV_SPLIT, CONV_T1); } }
    }
    }
    GSYNC();
    for (int rep = 0; rep < REPS(6); ++rep) { if (rep) GSYNC();
    if (ON(6)) {
        for (int unit = blockIdx.x; unit < 256; unit += G) compress_unit(unit, Y, p.cmp_pos, p.cmp_b1, p.g_qk, WC1, WC2, KC, VCT, lds, tid);
        __syncthreads();
        if (rep == 0) for (int tok = gw; tok < T_; tok += NGW) {
            bf16_t* row = Y + (size_t)tok * LDY;
            const int b = tok >> 11, sidx = tok & 2047, c16 = lane & 15, hsub = lane >> 4;
            const size_t fro = (size_t)((sidx >> 4) * 4 + (c16 >> 2)) * 512 + (c16 & 3) * 128 + (sidx & 15) * 8;
#pragma unroll 1
            for (int seg = 0; seg < 8; ++seg) {
                const int colbase = seg < 4 ? seg * 512 : (seg == 4 ? OFF_KV + 1024 : (seg == 5 ? OFF_KV + 2048 : OFF_KR + (seg - 6) * 512)), gi = seg < 4 ? 0 : (seg == 4 ? 2 : 3);
                const u32x4 w = *(const u32x4*)(row + colbase + lane * 8);
                u32x4 o = w;
                if (seg < 6) {
                    float f[8] = {bf_lo(w.x), bf_hi(w.x), bf_lo(w.y), bf_hi(w.y), bf_lo(w.z), bf_hi(w.z), bf_lo(w.w), bf_hi(w.w)};
                    float ss = 0.f;
#pragma unroll
                    for (int j = 0; j < 8; ++j) ss += f[j] * f[j];
                    ss += __shfl_xor(ss, 1); ss += __shfl_xor(ss, 2); ss += __shfl_xor(ss, 4); ss += __shfl_xor(ss, 8);
                    const float r = 1.0f / sqrtf(ss * (1.0f / 128.0f) + EPS_);
                    const float* gq = p.g_qk + gi * 128 + c16 * 8;
                    const f32x4 g0 = *(const f32x4*)gq, g1 = *(const f32x4*)(gq + 4);
                    o.x = cvt_pk_bf16(f[0] * r * g0[0], f[1] * r * g0[1]); o.y = cvt_pk_bf16(f[2] * r * g0[2], f[3] * r * g0[3]);
                    o.z = cvt_pk_bf16(f[4] * r * g1[0], f[5] * r * g1[1]); o.w = cvt_pk_bf16(f[6] * r * g1[2], f[7] * r * g1[3]);
                }
                bf16_t* dstp;
                if (seg < 4) dstp = row + colbase + lane * 8;
                else if (seg == 4) dstp = KS + (size_t)(b * 4 + hsub) * 262144 + fro;
                else if (seg == 5) dstp = KW + (size_t)(b * 4 + hsub) * 262144 + fro;
                else dstp = KR + (size_t)(b * 8 + (seg - 6) * 4 + hsub) * 262144 + fro;
                *(u32x4*)dstp = o;
            }
        }
        LAS bf16_t* tl = (LAS bf16_t*)(lds + wave * 16384);
        for (int it = gw; it < 48 * 128; it += NGW) {
            const int tt = it / 48, ct = it - tt * 48;
            int srccol, cc, HD; bf16_t* dst;
            if (ct < 8) { srccol = OFF_KV + 3 * 512 + ct * 64; cc = ct * 64; dst = VTS; HD = 128; }
            else if (ct < 16) { srccol = OFF_KV + 5 * 512 + (ct - 8) * 64; cc = (ct - 8) * 64; dst = VTW; HD = 128; }
            else { srccol = OFF_VR + (ct - 16) * 64; cc = (ct - 16) * 64; dst = VTR; HD = 256; }
            const int b = tt >> 5, s0 = (tt & 31) * 64;
            const int head = cc / HD, dt0 = (cc - head * HD) >> 4, NDTh = HD >> 4, nheads = (HD == 128) ? 4 : 8;
#pragma unroll
            for (int i = 0; i < 8; ++i) {
                const int tok = 8 * i + (lane >> 3), ch = lane & 7;
                const u32x4 w = *(const u32x4*)(Y + (size_t)(b * 2048 + s0 + tok) * LDY + srccol + ch * 8);
                LAS bf16_t* d = tl + (ch * 8) * 72 + tok;
                d[0 * 72] = (bf16_t)(w.x & 0xffffu); d[1 * 72] = (bf16_t)(w.x >> 16); d[2 * 72] = (bf16_t)(w.y & 0xffffu); d[3 * 72] = (bf16_t)(w.y >> 16);
                d[4 * 72] = (bf16_t)(w.z & 0xffffu); d[5 * 72] = (bf16_t)(w.z >> 16); d[6 * 72] = (bf16_t)(w.w & 0xffffu); d[7 * 72] = (bf16_t)(w.w >> 16);
            }
            asm volatile("s_waitcnt lgkmcnt(0)" ::: "memory");
            bf16_t* hb = dst + (size_t)(b * nheads + head) * (2048 * HD) + lane * 8;
#pragma unroll
            for (int i = 0; i < 8; ++i) {
                const int ks = i >> 2, dt = i & 3, col = 16 * dt + (lane & 15), fq4 = 4 * (lane >> 4);
                const u32x2 lo = *(const LAS u32x2*)(tl + col * 72 + 32 * ks + fq4), hi = *(const LAS u32x2*)(tl + col * 72 + 32 * ks + 16 + fq4);
                u32x4 w; w.x = lo.x; w.y = lo.y; w.z = hi.x; w.w = hi.y;
                *(u32x4*)(hb + (size_t)(((s0 >> 5) + ks) * NDTh + dt0 + dt) * 512) = w;
            }
            asm volatile("s_waitcnt lgkmcnt(0)" ::: "memory");
        }
    }
    }
    GSYNC();
    for (int rep = 0; rep < REPS(7); ++rep) { if (rep) GSYNC();
    if (ON(7)) {
        MixPtrs MP{Y, ONSA, ORET, VTS, VTW, VTR, KC, VCT, p.gn_gain, KS, KW, KR};
        unsigned* SM = (unsigned*)(p.ws + WS_SM);
#ifndef CMP_REPS
#define CMP_REPS 1
#endif
        for (int z = 0; z < CMP_REPS; ++z) for (int u = blockIdx.x; u < 256; u += G) cmp_unit(MP, SM, u >> 4, u & 15, lds, tid);
    }
    GSYNC();
    if (ON(7)) {
        MixPtrs MP{Y, ONSA, ORET, VTS, VTW, VTR, KC, VCT, p.gn_gain, KS, KW, KR};
        const unsigned* SM = (const unsigned*)(p.ws + WS_SM);
        LAS bf16x8* qs = (LAS bf16x8*)(lds + wave * 16384) + lane;
        if (G == 256) {
            const int x = blockIdx.x & 7, wl = (blockIdx.x >> 3) * 8 + wave;
#pragma unroll 1
            for (int k = 0; k < 2; ++k) {
                const int r = (k & 1) ? 255 - wl : wl, bg = x + 8 * k;
                nsa_unit(MP, SM, bg >> 2, bg & 3, 127 - (r >> 1), r & 1, lane, qs, lds + wave * 16384);
            }
#pragma unroll 1
            for (int qi = 0; qi < 8; ++qi) {
                const int xq = (x + qi) & 7;
                unsigned* qc = ctl + 512 * rep + 32 * xq;
                for (;;) {
                    unsigned id = 0;
                    if (lane == 0) id = atomicAdd(qc, 1u);
                    id = (unsigned)__builtin_amdgcn_readfirstlane((int)id);
                    if (id >= 256u) break;
                    const int bh = xq + 8 * (int)(id >> 6);
                    ret_unit2(MP, bh >> 3, bh & 7, 63 - (int)(id & 63u), lane, lds + wave * 16384);
                }
            }
        } else {
            for (int id = gw; id < 4096 + 2048; id += NGW) {
                if (id < 4096) { const int bg = id >> 8, r = id & 255; nsa_unit(MP, SM, bg >> 2, bg & 3, 127 - (r >> 1), r & 1, lane, qs, lds + wave * 16384); }
                else { const int r = id - 4096, bh = r >> 6; ret_unit2(MP, bh >> 3, bh & 7, 63 - (r & 63), lane, lds + wave * 16384); }
            }
        }
    }
    }
    GSYNC();
    for (int rep = 0; rep < REPS(8); ++rep) { if (rep) GSYNC();
    if (ON(8)) {
        { pg8::Gemm g{ONSA, WPN, T_, D_, D_}; pg8::StaticOrder S; S.init(T_, D_, G, (int)blockIdx.x);
          EpiMerge<false> E{MG, Y, OFF_GA};
          pg8::gemm_phase<EpiMerge<false>, pg8::StaticOrder, true, true>(lds, g, S, E); }
        __syncthreads();
        { pg8::Gemm g{ORET, WPR, T_, D_, D_}; pg8::StaticOrder S; S.init(T_, D_, G, (int)blockIdx.x);
          EpiMerge<true> E{MG, Y, OFF_GB};
          pg8::gemm_phase<EpiMerge<true>, pg8::StaticOrder, true, true>(lds, g, S, E); }
    }
    }
    GSYNC();
    if (ON(9)) {
        pg8::Gemm g{MG, WO, T_, D_, D_}; pg8::StaticOrder S; S.init(T_, D_, G, (int)blockIdx.x);
        EpiResid E{p.out, p.out, ada + 5 * D_, 1.0f};
        pg8::gemm_phase<EpiResid, pg8::StaticOrder, true, true>(lds, g, S, E);
    }
    GSYNC();
    for (int rep = 0; rep < REPS(10); ++rep) { if (rep) GSYNC();
    if (ON(10)) norm_rows(p.out, p.g_norm + 2 * D_, ada, 6, 7, H, gw, NGW, lane);
    }
    GSYNC();
    for (int rep = 0; rep < REPS(11); ++rep) { if (rep) GSYNC();
    if (ON(11)) {
        pg8::Gemm g{H, (const bf16_t*)(p.ws + WS_WGU2), T_, 2 * FF_, D_}; pg8::StaticOrder S; S.init(T_, 2 * FF_, G, (int)blockIdx.x);
        EpiSwiglu E{ACT};
        pg8::gemm_phase<EpiSwiglu, pg8::StaticOrder, true, true>(lds, g, S, E);
    }
    }
    GSYNC();
    if (ON(12)) {
        pg8::Gemm g{ACT, (const bf16_t*)(p.ws + WS_WD2), T_, D_, FF_}; pg8::StaticOrder S; S.init(T_, D_, G, (int)blockIdx.x);
        EpiResid E{p.out, p.out, ada + 8 * D_, 0.5f};
        pg8::gemm_phase<EpiResid, pg8::StaticOrder, true, true>(lds, g, S, E);
    }
#undef ON
#undef GSYNC
#undef ctl
#undef ada
#undef WGU
#undef WD
#undef WIN
#undef WPN
#undef WPR
#undef WO
#undef WC1
#undef WC2
#undef H
#undef ONSA
#undef Y
#undef ACT
#undef MG
#undef ORET
#undef VTS
#undef VTW
#undef VTR
#undef KC
#undef VCT
#undef KS
#undef KW
#undef KR
}

#ifndef PHASE_MASK
#define PHASE_MASK 0x1fff
#endif
extern "C" void kernel_launch(void* const* d_in, const int* in_sizes, int n_in, void* d_out, int out_size, void* d_ws, size_t ws_size, hipStream_t stream) {
    static int grid_blocks = 0;
    if (grid_blocks == 0) {
        if (n_in != 18 || ws_size < WS_END) { fprintf(stderr, "kernel_launch: unexpected n_in %d or workspace %zu < %zu\n", n_in, ws_size, (size_t)WS_END); grid_blocks = -1; return; }
        int dev = 0, cus = 0, per_cu = 0;
        hipGetDevice(&dev);
        hipDeviceGetAttribute(&cus, hipDeviceAttributeMultiprocessorCount, dev);
        if (hipFuncSetAttribute((const void*)fwd_kernel, hipFuncAttributeMaxDynamicSharedMemorySize, LDS_BYTES) != hipSuccess) { fprintf(stderr, "kernel_launch: hipFuncSetAttribute failed\n"); grid_blocks = -1; return; }
        if (hipOccupancyMaxActiveBlocksPerMultiprocessor(&per_cu, (const void*)fwd_kernel, 512, LDS_BYTES) != hipSuccess || per_cu < 1) { fprintf(stderr, "kernel_launch: occupancy query gave %d\n", per_cu); per_cu = 1; }
        (void)hipGetLastError();
        grid_blocks = cus * 1;
    }
    if (grid_blocks < 0) return;
    Params p{};
    p.x = (const float*)d_in[0]; p.c = (const float*)d_in[1]; p.w_ada = (const float*)d_in[2]; p.b_ada = (const float*)d_in[3]; p.g_norm = (const float*)d_in[4];
    p.w_gate = (const float*)d_in[5]; p.w_up = (const float*)d_in[6]; p.w_down = (const float*)d_in[7]; p.w_in = (const float*)d_in[8]; p.g_qk = (const float*)d_in[9];
    p.cmp_pos = (const float*)d_in[10]; p.cmp_w1 = (const float*)d_in[11]; p.cmp_b1 = (const float*)d_in[12]; p.cmp_w2 = (const float*)d_in[13]; p.gn_gain = (const float*)d_in[14];
    p.w_pn = (const float*)d_in[15]; p.w_pr = (const float*)d_in[16]; p.w_out = (const float*)d_in[17];
    p.out = (float*)d_out; p.ws = (unsigned char*)d_ws; p.mask = PHASE_MASK; p.pad = 0;
    void* args[] = {&p};
    hipError_t e = hipLaunchCooperativeKernel((const void*)fwd_kernel, dim3(grid_blocks), dim3(512), args, LDS_BYTES, stream);
    if (e != hipSuccess) fprintf(stderr, "kernel_launch: cooperative launch failed: %s (grid %d)\n", hipGetErrorString(e), grid_blocks);
}
```

```cpp
#include <hip/hip_runtime.h>
#include <hip/hip_cooperative_groups.h>
#include <cstdio>
#include <cstdint>
namespace cg = cooperative_groups;
namespace pg8 {
#define PG8_LAS __attribute__((address_space(3)))
typedef unsigned short bf16_t;
typedef short bf16x8 __attribute__((ext_vector_type(8)));
typedef float f32x4 __attribute__((ext_vector_type(4)));
typedef unsigned u32x4 __attribute__((ext_vector_type(4)));
constexpr int BM = 256, BK = 64, HALF = 128, HTB = HALF * BK * 2  , STAGE_BYTES = 8 * HTB, NXCD = 8, WGM = 8;

__host__ __device__ __forceinline__ int lds_byte(int r, int c) { const int st = (r >> 4) * 2 + (c >> 5), rr = r & 15, cc = c & 31, ob = rr * 64 + cc * 2; return st * 1024 + (ob ^ (((ob >> 9) & 1) << 5)); }
__host__ __device__ __forceinline__ void stage_rc(int b, int& R, int& C) { const int st = b / 1024, sb = b % 1024, swz = sb ^ (((sb >> 9) & 1) << 5); R = (st >> 1) * 16 + swz / 64; C = (st & 1) * 32 + (swz % 64) / 2; }
__host__ __device__ __forceinline__ int perm32(int rho) { const int n = rho >> 4, i = rho & 15; return 8 * (i >> 2) + 4 * n + (i & 3); }

struct Unit { int pm, pn; };
struct Gemm { const bf16_t* A; const bf16_t* Bt; int M, N, K; };

struct StaticOrder {
    int nM, nN, nwg, G, c;
    __host__ __device__ void init(int M, int N, int G_, int c_) { nM = M / BM; nN = N / BM; nwg = nM * nN; G = G_; c = c_; }
    __host__ __device__ bool next(int i, Unit& u) const {
        const long L = (long)i * G + c; if (L >= nwg) return false;
        int wgid = (int)L; { const int q = nwg / NXCD, r = nwg % NXCD, xcd = wgid % NXCD, off = wgid / NXCD; wgid = (xcd < r ? xcd * (q + 1) : r * (q + 1) + (xcd - r) * q) + off; }
        const int nig = WGM * nN, gid = wgid / nig, fm = gid * WGM, gsz = (nM - fm) < WGM ? (nM - fm) : WGM;
        u.pm = fm + ((wgid % nig) % gsz); u.pn = (wgid % nig) / gsz; return true;
    }
    __device__ __forceinline__ void a_ready(const Unit&) const {}
    __device__ __forceinline__ void done(const Unit&) const {}
};

__device__ __forceinline__ unsigned cvt_pk_bf16(float lo, float hi) { unsigned r; asm volatile("v_cvt_pk_bf16_f32 %0, %1, %2" : "=v"(r) : "v"(lo), "v"(hi)); return r; }
typedef float f32x2 __attribute__((ext_vector_type(2)));
template <class Epi, class Sched, bool ALIGN_EPI = false, bool SP2 = false>
__device__ __forceinline__ void gemm_phase(PG8_LAS unsigned char* lds, const Gemm g, const Sched& S, const Epi& E) {
    int tid_o = threadIdx.x; asm volatile("" : "+v"(tid_o));
    const int tid = tid_o, wid = __builtin_amdgcn_readfirstlane(tid >> 6), lane = tid & 63, wr = wid >> 2, wc = wid & 3, fr = lane & 15, fq = lane >> 4;
    const int K = g.K, nt = K / BK;
    unsigned voffA[2], voffB[2];
#pragma unroll
    for (int i = 0; i < 2; ++i) { int R, C; stage_rc(tid * 16 + i * 8192, R, C); const int Rb = Epi::PERM ? ((R & ~31) + perm32(R & 31)) : R;
        voffA[i] = (unsigned)(R * K + C) * 2u; voffB[i] = (unsigned)(Rb * K + C) * 2u; }
    const size_t kstep = (size_t)(BK * 2);
    const size_t hstep = (size_t)HALF * K * 2;
    const size_t tstep = 2 * hstep;
    const unsigned ldsw = (unsigned)wid * 1024u;
    const int aoff = lds_byte(wr * 64 + fr, fq * 8), boff = lds_byte(wc * 32 + fr, fq * 8);
#define PG8_SA(b, h) (((b) * 2 + (h)) * HTB)
#define PG8_SB(b, h) ((4 + (b) * 2 + (h)) * HTB)
#define PG8_STAGE(bufoff, gbase, voff) do { _Pragma("unroll") for (int _i = 0; _i < 2; ++_i) \
        __builtin_amdgcn_global_load_lds((const unsigned*)((const char*)(gbase) + (voff)[_i]), (PG8_LAS unsigned*)(lds + (bufoff) + ldsw + _i * 8192), 16, 0, 0); } while (0)
#define PG8_LDA(dst, b, h) do { _Pragma("unroll") for (int m = 0; m < 4; ++m) _Pragma("unroll") for (int k = 0; k < 2; ++k) dst[m][k] = *(const PG8_LAS bf16x8*)(lds + PG8_SA(b, h) + aoff + m * 2048 + k * 1024); } while (0)
#define PG8_LDB(dst, b, h) do { _Pragma("unroll") for (int n = 0; n < 2; ++n) _Pragma("unroll") for (int k = 0; k < 2; ++k) dst[n][k] = *(const PG8_LAS bf16x8*)(lds + PG8_SB(b, h) + boff + n * 2048 + k * 1024); } while (0)
#define PG8_MMA(ai, bj, At, Bt) do { __builtin_amdgcn_s_setprio(1); _Pragma("unroll") for (int m = 0; m < 4; ++m) _Pragma("unroll") for (int n = 0; n < 2; ++n) _Pragma("unroll") for (int k = 0; k < 2; ++k) \
        acc[ai][bj][m][n] = __builtin_amdgcn_mfma_f32_16x16x32_bf16(Bt[n][k], At[m][k], acc[ai][bj][m][n], 0, 0, 0); __builtin_amdgcn_s_setprio(0); } while (0)
#define PG8_WAIT_V(n) asm volatile("s_waitcnt vmcnt(" #n ")" ::: "memory")
#define PG8_WAIT_L(n) asm volatile("s_waitcnt lgkmcnt(" #n ")" ::: "memory")
#define PG8_BAR __builtin_amdgcn_s_barrier()
#define PG8_SCHED __builtin_amdgcn_sched_barrier(0)
    Unit cur, nxt; int ui = 0;
    if (!S.next(0, cur)) return;
    f32x4 acc[2][2][4][2];
#pragma unroll
    for (int a = 0; a < 2; ++a)
#pragma unroll
        for (int b = 0; b < 2; ++b)
#pragma unroll
            for (int m = 0; m < 4; ++m)
#pragma unroll
                for (int n = 0; n < 2; ++n) acc[a][b][m][n] = (f32x4){0.f, 0.f, 0.f, 0.f};
    bf16x8 At[4][2], B0[2][2], B1[2][2];
    const char* cA = (const char*)g.A + (size_t)cur.pm * tstep; const char* cB = (const char*)g.Bt + (size_t)cur.pn * tstep;
    S.a_ready(cur);
    if constexpr (SP2) {
        PG8_STAGE(PG8_SB(0, 0), cB, voffB); PG8_STAGE(PG8_SB(0, 1), cB + hstep, voffB); PG8_STAGE(PG8_SA(0, 0), cA, voffA); PG8_STAGE(PG8_SA(0, 1), cA + hstep, voffA);
        if (wr == 1) PG8_BAR;
        PG8_WAIT_V(2); PG8_BAR;
        PG8_STAGE(PG8_SB(1, 0), cB + kstep, voffB); PG8_STAGE(PG8_SA(1, 0), cA + kstep, voffA); PG8_STAGE(PG8_SB(1, 1), cB + hstep + kstep, voffB);
        PG8_WAIT_V(6); PG8_BAR;
    } else {
        PG8_STAGE(PG8_SB(0, 0), cB, voffB); PG8_STAGE(PG8_SA(0, 0), cA, voffA); PG8_STAGE(PG8_SB(0, 1), cB + hstep, voffB); PG8_STAGE(PG8_SA(0, 1), cA + hstep, voffA);
        if (wr == 1) PG8_BAR;
        PG8_WAIT_V(4); PG8_BAR;
        PG8_STAGE(PG8_SB(1, 0), cB + kstep, voffB); PG8_STAGE(PG8_SA(1, 0), cA + kstep, voffA); PG8_STAGE(PG8_SB(1, 1), cB + hstep + kstep, voffB);
        PG8_WAIT_V(6); PG8_BAR;
    }
    for (;;) {
        const bool has_next = S.next(ui + 1, nxt);
        const char* nA = has_next ? (const char*)g.A + (size_t)nxt.pm * tstep : cA; const char* nB = has_next ? (const char*)g.Bt + (size_t)nxt.pn * tstep : cB;
        for (int t = 0; t < nt; t += 2) {
            const bool last = (t == nt - 2);
            const char* a1 = cA + (size_t)(t + 1) * kstep;
            const char* a2 = last ? nA : cA + (size_t)(t + 2) * kstep; const char* b2 = last ? nB : cB + (size_t)(t + 2) * kstep;
            const char* a3 = a2 + kstep; const char* b3 = b2 + kstep;
            if (last && has_next) S.a_ready(nxt);
            if constexpr (SP2) {
            PG8_LDB(B0, 0, 0); PG8_LDB(B1, 0, 1); PG8_SCHED; PG8_LDA(At, 0, 0); PG8_STAGE(PG8_SA(1, 1), a1 + hstep, voffA);
            PG8_WAIT_V(8); PG8_WAIT_L(0); PG8_BAR; PG8_MMA(0, 0, At, B0); PG8_MMA(0, 1, At, B1); PG8_BAR; PG8_SCHED;
            PG8_LDA(At, 0, 1); PG8_STAGE(PG8_SB(0, 0), b2, voffB); PG8_STAGE(PG8_SB(0, 1), b2 + hstep, voffB); PG8_STAGE(PG8_SA(0, 0), a2, voffA);
            PG8_WAIT_V(8); PG8_WAIT_L(0); PG8_BAR; PG8_MMA(1, 0, At, B0); PG8_MMA(1, 1, At, B1); PG8_BAR; PG8_SCHED;
            PG8_LDB(B0, 1, 0); PG8_LDB(B1, 1, 1); PG8_SCHED; PG8_LDA(At, 1, 0); PG8_STAGE(PG8_SA(0, 1), a2 + hstep, voffA);
            PG8_WAIT_V(8); PG8_WAIT_L(0); PG8_BAR; PG8_MMA(0, 0, At, B0); PG8_MMA(0, 1, At, B1); PG8_BAR; PG8_SCHED;
            PG8_LDA(At, 1, 1); PG8_STAGE(PG8_SB(1, 0), b3, voffB); PG8_STAGE(PG8_SB(1, 1), b3 + hstep, voffB); PG8_STAGE(PG8_SA(1, 0), a3, voffA);
            PG8_WAIT_V(8); PG8_WAIT_L(0); PG8_BAR; PG8_MMA(1, 0, At, B0); PG8_MMA(1, 1, At, B1); PG8_BAR; PG8_SCHED;
            } else {
            PG8_LDB(B0, 0, 0); PG8_SCHED; PG8_LDA(At, 0, 0); PG8_STAGE(PG8_SA(1, 1), a1 + hstep, voffA);
            PG8_WAIT_L(8); PG8_BAR; PG8_WAIT_L(0); PG8_MMA(0, 0, At, B0); PG8_BAR; PG8_SCHED;
            PG8_LDB(B1, 0, 1); PG8_STAGE(PG8_SB(0, 0), b2, voffB);
            PG8_BAR; PG8_WAIT_L(0); PG8_MMA(0, 1, At, B1); PG8_BAR;
            PG8_LDA(At, 0, 1); PG8_STAGE(PG8_SA(0, 0), a2, voffA);
            PG8_BAR; PG8_WAIT_L(0); PG8_MMA(1, 0, At, B0); PG8_BAR; PG8_SCHED;
            PG8_STAGE(PG8_SB(0, 1), b2 + hstep, voffB);
            PG8_WAIT_V(6); PG8_BAR; PG8_MMA(1, 1, At, B1); PG8_BAR;
            PG8_LDB(B0, 1, 0); PG8_SCHED; PG8_LDA(At, 1, 0); PG8_STAGE(PG8_SA(0, 1), a2 + hstep, voffA);
            PG8_WAIT_L(8); PG8_BAR; PG8_WAIT_L(0); PG8_MMA(0, 0, At, B0); PG8_BAR; PG8_SCHED;
            PG8_LDB(B1, 1, 1); PG8_STAGE(PG8_SB(1, 0), b3, voffB);
            PG8_BAR; PG8_WAIT_L(0); PG8_MMA(0, 1, At, B1); PG8_BAR;
            PG8_LDA(At, 1, 1); PG8_STAGE(PG8_SA(1, 0), a3, voffA);
            PG8_BAR; PG8_WAIT_L(0); PG8_MMA(1, 0, At, B0); PG8_BAR; PG8_SCHED;
            PG8_STAGE(PG8_SB(1, 1), b3 + hstep, voffB);
            PG8_WAIT_V(6); PG8_BAR; PG8_MMA(1, 1, At, B1); PG8_BAR;
            }
        }
        if constexpr (ALIGN_EPI) { if (wr == 0) PG8_BAR; }
        if constexpr (!Epi::AFTER_DRAIN) { E(acc, cur, wr, wc, fr, fq); S.done(cur); }
        if (!has_next) break;
#pragma unroll
        for (int a = 0; a < 2; ++a)
#pragma unroll
            for (int b = 0; b < 2; ++b)
#pragma unroll
                for (int m = 0; m < 4; ++m)
#pragma unroll
                    for (int n = 0; n < 2; ++n) acc[a][b][m][n] = (f32x4){0.f, 0.f, 0.f, 0.f};
        cur = nxt; cA = nA; cB = nB; ++ui;
        if constexpr (ALIGN_EPI) { if (wr == 1) PG8_BAR; }
    }
    PG8_WAIT_V(0);
    if constexpr (!ALIGN_EPI) { if (wr == 0) PG8_BAR; }
    PG8_BAR;
    if constexpr (Epi::AFTER_DRAIN) { E.fused(acc, cur, wr, wc, fr, fq, lds, wid, lane); S.done(cur); }
#undef PG8_SA
#undef PG8_SB
#undef PG8_STAGE
#undef PG8_LDA
#undef PG8_LDB
#undef PG8_MMA
#undef PG8_WAIT_V
#undef PG8_WAIT_L
#undef PG8_BAR
#undef PG8_SCHED
}
}

#define LAS __attribute__((address_space(3)))
typedef unsigned short bf16_t;
typedef short bf16x8 __attribute__((ext_vector_type(8)));
typedef short s16x4 __attribute__((ext_vector_type(4)));
typedef float f32x4 __attribute__((ext_vector_type(4)));
typedef unsigned u32x4 __attribute__((ext_vector_type(4)));
typedef unsigned u32x2 __attribute__((ext_vector_type(2)));

constexpr int T_ = 8192, D_ = 2048, FF_ = 5632, NIN_ = 15408, LDY = 15616, NADA = 18432;
constexpr int OFF_Q = 0, OFF_KV = 2048, OFF_QR = 5120, OFF_KR = 6144, OFF_VR = 7168, OFF_GR = 9216, OFF_GA = 11264, OFF_GB = 13312, OFF_GL = 15360;
constexpr float LOG2E = 1.4426950408889634f;
constexpr float EPS_ = 1e-6f;

constexpr size_t al256(size_t x) { return (x + 255) & ~(size_t)255; }
constexpr size_t WS_CTL = 0;
constexpr size_t WS_BAR = 8192;
constexpr size_t WS_ADA = 32768;
constexpr size_t WS_WGU = al256(WS_ADA + (size_t)4 * NADA * 4);
constexpr size_t WS_WD  = WS_WGU + (size_t)2 * FF_ * D_ * 2;
constexpr size_t WS_WIN = WS_WD + (size_t)D_ * FF_ * 2;
constexpr size_t WS_WPN = WS_WIN + (size_t)LDY * D_ * 2;
constexpr size_t WS_WPR = WS_WPN + (size_t)D_ * D_ * 2;
constexpr size_t WS_WO  = WS_WPR + (size_t)D_ * D_ * 2;
constexpr size_t WS_WC1 = WS_WO + (size_t)D_ * D_ * 2;
constexpr size_t WS_WC2 = WS_WC1 + (size_t)2 * 128 * 4096 * 2;
constexpr size_t WS_H   = WS_WC2 + (size_t)2 * 128 * 128 * 2;
constexpr size_t WS_Y   = WS_H + (size_t)T_ * D_ * 2;
constexpr size_t WS_MG  = WS_Y + (size_t)T_ * LDY * 2;
constexpr size_t WS_ORET = WS_MG + (size_t)T_ * D_ * 2;
constexpr size_t WS_VTS = WS_ORET + (size_t)T_ * D_ * 2;
constexpr size_t WS_VTW = WS_VTS + (size_t)16 * 128 * 2048 * 2;
constexpr size_t WS_VTR = WS_VTW + (size_t)16 * 128 * 2048 * 2;
constexpr size_t WS_KC  = WS_VTR + (size_t)32 * 256 * 2048 * 2;
constexpr size_t WS_VCT = WS_KC + (size_t)16 * 128 * 128 * 2;
constexpr size_t WS_KS  = WS_VCT + (size_t)16 * 128 * 128 * 2;
constexpr size_t WS_KW  = WS_KS + (size_t)16 * 2048 * 128 * 2;
constexpr size_t WS_KR  = WS_KW + (size_t)16 * 2048 * 128 * 2;
constexpr size_t WS_SM  = WS_KR + (size_t)32 * 2048 * 128 * 2;
constexpr size_t WS_KRT = WS_WIN;
constexpr size_t WS_ST  = WS_WIN + (size_t)32 * 2048 * 128 * 2;
static_assert((size_t)32 * 2048 * 128 * 2 + (size_t)32 * 16 * 16 * 4 * 512 * 2 <= (size_t)NIN_ * D_ * 2, "KRT + ST must fit below the zero pad rows of the w_in copy");
constexpr size_t WS_WGU2 = al256(WS_SM + (size_t)16 * 2048 * 4);
constexpr size_t WS_WD2 = WS_WGU2 + (size_t)2 * FF_ * D_ * 2;
constexpr size_t WS_END = WS_WD2 + (size_t)D_ * FF_ * 2;

constexpr int LDS_BYTES = 131072 + 2048;

using pg8::cvt_pk_bf16;
__device__ __forceinline__ float bf_lo(unsigned w) { return __uint_as_float(w << 16); }
__device__ __forceinline__ float bf_hi(unsigned w) { return __uint_as_float(w & 0xffff0000u); }
__device__ __forceinline__ float bf2f(bf16_t h) { return __uint_as_float((unsigned)h << 16); }
__device__ __forceinline__ float ex2(float x) { return __builtin_amdgcn_exp2f(x); }
__device__ __forceinline__ float sigmoid_f(float x) { return __builtin_amdgcn_rcpf(1.0f + ex2(-x * LOG2E)); }
__device__ __forceinline__ float silu_f(float x) { return x * sigmoid_f(x); }
__device__ __forceinline__ float wave_sum(float v) {
#pragma unroll
    for (int o = 1; o < 64; o <<= 1) v += __shfl_xor(v, o);
    return v;
}
#define MFMA16(a, b, c) __builtin_amdgcn_mfma_f32_16x16x32_bf16((a), (b), (c), 0, 0, 0)
__device__ __forceinline__ float rowred_max(float x) {
    auto a = __builtin_amdgcn_permlane16_swap(__float_as_uint(x), __float_as_uint(x), false, false);
    x = fmaxf(__uint_as_float(a[0]), __uint_as_float(a[1]));
    auto b = __builtin_amdgcn_permlane32_swap(__float_as_uint(x), __float_as_uint(x), false, false);
    return fmaxf(__uint_as_float(b[0]), __uint_as_float(b[1]));
}
__device__ __forceinline__ float rowred_sum(float x) {
    auto a = __builtin_amdgcn_permlane16_swap(__float_as_uint(x), __float_as_uint(x), false, false);
    x = __uint_as_float(a[0]) + __uint_as_float(a[1]);
    auto b = __builtin_amdgcn_permlane32_swap(__float_as_uint(x), __float_as_uint(x), false, false);
    return __uint_as_float(b[0]) + __uint_as_float(b[1]);
}

struct EpiSwiglu {
    static constexpr bool PERM = true, AFTER_DRAIN = false;
    bf16_t* O;
    __device__ __forceinline__ void operator()(const f32x4 (&acc)[2][2][4][2], const pg8::Unit& u, int wr, int wc, int fr, int fq) const {
        const int row0 = u.pm * 256 + wr * 64 + fr, col0 = u.pn * 128 + wc * 32 + 8 * fq;
#pragma unroll
        for (int ai = 0; ai < 2; ++ai)
#pragma unroll
            for (int m = 0; m < 4; ++m) {
                bf16_t* rowp = O + (size_t)(row0 + ai * 128 + m * 16) * FF_ + col0;
                const f32x4 g0 = acc[ai][0][m][0], g1 = acc[ai][0][m][1], u0 = acc[ai][1][m][0], u1 = acc[ai][1][m][1];
                u32x4 w;
                w.x = cvt_pk_bf16(silu_f(g0[0]) * u0[0], silu_f(g0[1]) * u0[1]);
                w.y = cvt_pk_bf16(silu_f(g0[2]) * u0[2], silu_f(g0[3]) * u0[3]);
                w.z = cvt_pk_bf16(silu_f(g1[0]) * u1[0], silu_f(g1[1]) * u1[1]);
                w.w = cvt_pk_bf16(silu_f(g1[2]) * u1[2], silu_f(g1[3]) * u1[3]);
                *(u32x4*)rowp = w;
            }
    }
};
struct EpiResid {
    static constexpr bool PERM = false, AFTER_DRAIN = false;
    const float* base; float* out; const float* gate; float coef;
    __device__ __forceinline__ void operator()(const f32x4 (&acc)[2][2][4][2], const pg8::Unit& u, int wr, int wc, int fr, int fq) const {
        const int row0 = u.pm * 256 + wr * 64 + fr, col0 = u.pn * 256 + wc * 32 + 4 * fq, b = u.pm >> 3;
        f32x4 gv[2][2];
#pragma unroll
        for (int bj = 0; bj < 2; ++bj)
#pragma unroll
            for (int n = 0; n < 2; ++n) gv[bj][n] = *(const f32x4*)(gate + (size_t)b * NADA + col0 + bj * 128 + n * 16) * coef;
#pragma unroll
        for (int ai = 0; ai < 2; ++ai)
#pragma unroll
            for (int m = 0; m < 4; ++m) {
                const size_t off = (size_t)(row0 + ai * 128 + m * 16) * D_ + col0;
#pragma unroll
                for (int bj = 0; bj < 2; ++bj)
#pragma unroll
                    for (int n = 0; n < 2; ++n) {
                        const size_t o = off + bj * 128 + n * 16;
                        *(f32x4*)(out + o) = *(const f32x4*)(base + o) + gv[bj][n] * acc[ai][bj][m][n];
                    }
            }
    }
};
struct EpiY {
    static constexpr bool PERM = true, AFTER_DRAIN = false;
    bf16_t* O;
    __device__ __forceinline__ void operator()(const f32x4 (&acc)[2][2][4][2], const pg8::Unit& u, int wr, int wc, int fr, int fq) const {
        const int row0 = u.pm * 256 + wr * 64 + fr, col0 = u.pn * 256 + wc * 32 + 8 * fq;
#pragma unroll
        for (int ai = 0; ai < 2; ++ai)
#pragma unroll
            for (int m = 0; m < 4; ++m) {
                bf16_t* rowp = O + (size_t)(row0 + ai * 128 + m * 16) * LDY + col0;
#pragma unroll
                for (int bj = 0; bj < 2; ++bj) {
                    const f32x4 v0 = acc[ai][bj][m][0], v1 = acc[ai][bj][m][1];
                    u32x4 w; w.x = cvt_pk_bf16(v0[0], v0[1]); w.y = cvt_pk_bf16(v0[2], v0[3]); w.z = cvt_pk_bf16(v1[0], v1[1]); w.w = cvt_pk_bf16(v1[2], v1[3]);
                    *(u32x4*)(rowp + bj * 128) = w;
                }
            }
    }
};
template <bool ADD> struct EpiMerge {
    static constexpr bool PERM = true, AFTER_DRAIN = false;
    bf16_t* O; const bf16_t* Yg; int goff;
    __device__ __forceinline__ void operator()(const f32x4 (&acc)[2][2][4][2], const pg8::Unit& u, int wr, int wc, int fr, int fq) const {
        const int row0 = u.pm * 256 + wr * 64 + fr, col0 = u.pn * 256 + wc * 32 + 8 * fq;
#pragma unroll
        for (int ai = 0; ai < 2; ++ai)
#pragma unroll
            for (int m = 0; m < 4; ++m) {
                const int row = row0 + ai * 128 + m * 16;
#pragma unroll
                for (int bj = 0; bj < 2; ++bj) {
                    const int col = col0 + bj * 128;
                    const u32x4 gw = *(const u32x4*)(Yg + (size_t)row * LDY + goff + col);
                    const f32x4 v0 = acc[ai][bj][m][0], v1 = acc[ai][bj][m][1];
                    float r[8];
                    r[0] = sigmoid_f(bf_lo(gw.x)) * v0[0]; r[1] = sigmoid_f(bf_hi(gw.x)) * v0[1];
                    r[2] = sigmoid_f(bf_lo(gw.y)) * v0[2]; r[3] = sigmoid_f(bf_hi(gw.y)) * v0[3];
                    r[4] = sigmoid_f(bf_lo(gw.z)) * v1[0]; r[5] = sigmoid_f(bf_hi(gw.z)) * v1[1];
                    r[6] = sigmoid_f(bf_lo(gw.w)) * v1[2]; r[7] = sigmoid_f(bf_hi(gw.w)) * v1[3];
                    bf16_t* op = O + (size_t)row * D_ + col;
                    if (ADD) {
                        const u32x4 pw = *(const u32x4*)op;
                        r[0] += bf_lo(pw.x); r[1] += bf_hi(pw.x); r[2] += bf_lo(pw.y); r[3] += bf_hi(pw.y);
                        r[4] += bf_lo(pw.z); r[5] += bf_hi(pw.z); r[6] += bf_lo(pw.w); r[7] += bf_hi(pw.w);
                    }
                    u32x4 w; w.x = cvt_pk_bf16(r[0], r[1]); w.y = cvt_pk_bf16(r[2], r[3]); w.z = cvt_pk_bf16(r[4], r[5]); w.w = cvt_pk_bf16(r[6], r[7]);
                    *(u32x4*)op = w;
                }
            }
    }
};

__device__ __forceinline__ int rowmap(int mode, int n) {
    if (mode == 0) return n;
    if (mode == 1) return ((n >> 7) << 8) + (n & 127);
    if (mode == 2) return ((n >> 7) << 8) + 128 + (n & 127);
    return n < 5120 ? n : (n < 5168 ? OFF_GL + (n - 5120) : n - 48);
}
__device__ __forceinline__ void norm_rows(const float* __restrict__ X, const float* __restrict__ g, const float* __restrict__ ada, int ish, int isc, bf16_t* __restrict__ H, int gw, int NGW, int lane) {
    for (int m = gw; m < T_; m += NGW) {
        const int b = m >> 11;
        const f32x4* xr = (const f32x4*)(X + (size_t)m * D_) + lane;
        f32x4 v[8]; float ss = 0.f;
#pragma unroll
        for (int j = 0; j < 8; ++j) { v[j] = xr[64 * j]; ss += (v[j].x * v[j].x + v[j].y * v[j].y) + (v[j].z * v[j].z + v[j].w * v[j].w); }
        const float r = 1.0f / sqrtf(wave_sum(ss) * (1.0f / D_) + EPS_);
        const f32x4* gp = (const f32x4*)g + lane;
        const f32x4* sh = (const f32x4*)(ada + (size_t)b * NADA + ish * D_) + lane;
        const f32x4* sc = (const f32x4*)(ada + (size_t)b * NADA + isc * D_) + lane;
        u32x2* o = (u32x2*)(H + (size_t)m * D_) + lane;
#pragma unroll
        for (int j = 0; j < 8; ++j) {
            const f32x4 y = v[j] * r * gp[64 * j] * (sc[64 * j] + 1.0f) + sh[64 * j];
            u32x2 w; w.x = cvt_pk_bf16(y.x, y.y); w.y = cvt_pk_bf16(y.z, y.w); o[64 * j] = w;
        }
    }
}

#ifndef VPRE
#define VPRE 4
#endif
__device__ __forceinline__ void att_kdma(const bf16_t* __restrict__ Kf, int k0, int lane8, LAS unsigned char* ring) {
    const bf16_t* kb = Kf + (size_t)(k0 >> 4) * 2048 + lane8;
#pragma unroll
    for (int s8 = 0; s8 < 8; ++s8) __builtin_amdgcn_global_load_lds((const unsigned*)(kb + s8 * 512), (LAS unsigned*)(ring + s8 * 1024), 16, 0, 0);
}
template <int NR, int NDT, int MODE>
__device__ __forceinline__ void att_step(const bf16_t* __restrict__ Kf, const bf16_t* __restrict__ Vf, int k0, int k0n  , int tq  , int lane8  ,
                                         const LAS bf16x8* qs, LAS unsigned char* ring, int lane, f32x4 (&O)[NR][NDT], float (&m)[NR], float (&l)[NR], const float (&coef)[NR], bool vblk, bool full = false) {
    constexpr float SC = 0.08838834764831845f;
    const bf16_t* vb = Vf + (size_t)(k0 >> 5) * (NDT * 512) + lane8;
    const int dq = tq - k0;
    asm volatile("s_waitcnt vmcnt(0)" ::: "memory");
    bf16x8 vfr[NDT];
#pragma unroll
    for (int dt = 0; dt < NDT; ++dt) vfr[dt] = *(const bf16x8*)(vb + dt * 512);
    f32x4 sa[NR][2];
    const LAS bf16x8* kr = (const LAS bf16x8*)ring + lane;
#pragma unroll
    for (int kt = 0; kt < 2; ++kt) {
#pragma unroll
        for (int r = 0; r < NR; ++r) { sa[r][kt] = (f32x4){0.f, 0.f, 0.f, 0.f};
#pragma unroll
            for (int dc = 0; dc < 4; ++dc) sa[r][kt] = MFMA16(kr[(kt * 4 + dc) * 64], qs[(r * 4 + dc) * 64], sa[r][kt]); }
    }
    asm volatile("s_waitcnt lgkmcnt(0)" ::: "memory");
    __builtin_amdgcn_sched_barrier(0);
    if (k0n >= 0) att_kdma(Kf, k0n, lane8, ring);
    __builtin_amdgcn_sched_barrier(0);
    bf16x8 Pb[NR];
    const float dqf = (float)dq;
#pragma unroll
    for (int r = 0; r < NR; ++r) {
        f32x4 s[2]; s[0] = sa[r][0]; s[1] = sa[r][1];
        float p[2][4];
        if (MODE == 2) {
#pragma unroll
            for (int kt = 0; kt < 2; ++kt)
#pragma unroll
                for (int j = 0; j < 4; ++j) { const bool valid = dq >= (16 * kt + j); p[kt][j] = valid ? s[kt][j] * SC * ex2(coef[r] * (dqf - (float)(16 * kt + j))) : 0.f; }
        } else {
            float mx = -INFINITY;
            const float base = -coef[r] * dqf;
            if (full) {
#pragma unroll
                for (int kt = 0; kt < 2; ++kt)
#pragma unroll
                    for (int j = 0; j < 4; ++j) { const float v = fmaf(coef[r], (float)(16 * kt + j), fmaf(s[kt][j], SC * LOG2E, base)); p[kt][j] = v; mx = fmaxf(mx, v); }
            } else {
#pragma unroll
                for (int kt = 0; kt < 2; ++kt)
#pragma unroll
                    for (int j = 0; j < 4; ++j) {
                        const bool valid = (MODE == 0) ? (vblk && dq >= (16 * kt + j)) : (dq >= (16 * kt + j) && dq < 512 + (16 * kt + j));
                        const float v = valid ? fmaf(coef[r], (float)(16 * kt + j), fmaf(s[kt][j], SC * LOG2E, base)) : -INFINITY;
                        p[kt][j] = v; mx = fmaxf(mx, v);
                    }
            }
            mx = rowred_max(mx);
            const float mnew = (mx - m[r] > 8.0f) ? mx : m[r], muse = (mnew == -INFINITY) ? 0.f : mnew;
            float ps = 0.f;
#pragma unroll
            for (int kt = 0; kt < 2; ++kt)
#pragma unroll
                for (int j = 0; j < 4; ++j) { p[kt][j] = ex2(p[kt][j] - muse); ps += p[kt][j]; }
#ifdef ALWAYS_RESCALE
            {
#else
            if (__ballot(mnew != m[r]) != 0ull) {
#endif
                const float alpha = ex2(m[r] - muse);
                l[r] *= alpha;
#pragma unroll
                for (int dt = 0; dt < NDT; ++dt) O[r][dt] *= alpha;
            }
            l[r] += ps; m[r] = mnew;
        }
        u32x4 pw; pw.x = cvt_pk_bf16(p[0][0], p[0][1]); pw.y = cvt_pk_bf16(p[0][2], p[0][3]); pw.z = cvt_pk_bf16(p[1][0], p[1][1]); pw.w = cvt_pk_bf16(p[1][2], p[1][3]);
        Pb[r] = __builtin_bit_cast(bf16x8, pw);
    }
#pragma unroll
    for (int dt = 0; dt < NDT; ++dt) {
#pragma unroll
        for (int r = 0; r < NR; ++r) O[r][dt] = MFMA16(vfr[dt], Pb[r], O[r][dt]);
        if ((dt & 3) == 3) __builtin_amdgcn_sched_barrier(0);
    }
}

template <int VSTEP = 4096>
__device__ __forceinline__ void att_vdma(const bf16_t* __restrict__ Vf, int k0, int lane8, LAS unsigned char* ring) {
    const bf16_t* vb = Vf + (size_t)(k0 >> 5) * VSTEP + lane8;
#pragma unroll
    for (int dt = 0; dt < 8; ++dt) __builtin_amdgcn_global_load_lds((const unsigned*)(vb + dt * 512), (LAS unsigned*)(ring + 8192 + dt * 1024), 16, 0, 0);
}
template <int MODE, int TSTEP = 0  , int VSTEP = 4096>
__device__ __forceinline__ void att_step2(const bf16_t* __restrict__ Kf, const bf16_t* __restrict__ Vf, int k0, int k0n  , int tq  , int lane8,
                                          const bf16x8 (&Qf)[2][4], LAS unsigned char* ring, int lane, f32x4 (&O)[2][8], float (&m)[2], float (&l)[2], const float (&coef)[2], bool vblk, bool full) {
    constexpr float SC = 0.08838834764831845f;
    constexpr int NR = 2, NDT = 8;
    const int dq = tq - k0;
    const LAS bf16x8* kr = (const LAS bf16x8*)ring + lane;
    const LAS bf16x8* vr = (const LAS bf16x8*)(ring + 8192) + lane;
    asm volatile("s_waitcnt vmcnt(8)" ::: "memory");
    f32x4 sa[NR][2];
#pragma unroll
    for (int kt = 0; kt < 2; ++kt) {
#pragma unroll
        for (int r = 0; r < NR; ++r) sa[r][kt] = (f32x4){0.f, 0.f, 0.f, 0.f};
#pragma unroll
        for (int dc = 0; dc < 4; ++dc) { const bf16x8 kf = kr[(kt * 4 + dc) * 64];
#pragma unroll
            for (int r = 0; r < NR; ++r) sa[r][kt] = MFMA16(kf, Qf[r][dc], sa[r][kt]); }
    }
    asm volatile("s_waitcnt lgkmcnt(0)" ::: "memory");
    __builtin_amdgcn_sched_barrier(0);
    if (k0n >= 0) att_kdma(Kf, k0n, lane8, ring);
    __builtin_amdgcn_sched_barrier(0);
    bf16x8 Pb[NR];
    const float dqf = (float)dq;
#pragma unroll
    for (int r = 0; r < NR; ++r) {
        float p[2][4];
        if (MODE == 2) {
            const int dqr = dq + r * TSTEP; const float dqrf = (float)dqr;
#pragma unroll
            for (int kt = 0; kt < 2; ++kt)
#pragma unroll
                for (int j = 0; j < 4; ++j) p[kt][j] = (dqr >= (16 * kt + j)) ? sa[r][kt][j] * SC * ex2(coef[r] * (dqrf - (float)(16 * kt + j))) : 0.f;
        } else {
        float mx = -INFINITY;
        const float base = -coef[r] * dqf;
        if (full) {
#pragma unroll
            for (int kt = 0; kt < 2; ++kt)
#pragma unroll
                for (int j = 0; j < 4; ++j) { const float v = fmaf(coef[r], (float)(16 * kt + j), fmaf(sa[r][kt][j], SC * LOG2E, base)); p[kt][j] = v; mx = fmaxf(mx, v); }
        } else {
#pragma unroll
            for (int kt = 0; kt < 2; ++kt)
#pragma unroll
                for (int j = 0; j < 4; ++j) {
                    const bool valid = (MODE == 0) ? (vblk && dq >= (16 * kt + j)) : (dq >= (16 * kt + j) && dq < 512 + (16 * kt + j));
                    const float v = valid ? fmaf(coef[r], (float)(16 * kt + j), fmaf(sa[r][kt][j], SC * LOG2E, base)) : -INFINITY;
                    p[kt][j] = v; mx = fmaxf(mx, v);
                }
        }
        mx = rowred_max(mx);
        const float mnew = (mx - m[r] > 8.0f) ? mx : m[r], muse = (mnew == -INFINITY) ? 0.f : mnew;
        float ps = 0.f;
#pragma unroll
        for (int kt = 0; kt < 2; ++kt)
#pragma unroll
            for (int j = 0; j < 4; ++j) { p[kt][j] = ex2(p[kt][j] - muse); ps += p[kt][j]; }
        if (__ballot(mnew != m[r]) != 0ull) {
            const float alpha = ex2(m[r] - muse);
            l[r] *= alpha;
#pragma unroll
            for (int dt = 0; dt < NDT; ++dt) O[r][dt] *= alpha;
        }
        l[r] += ps; m[r] = mnew;
        }
        u32x4 pw; pw.x = cvt_pk_bf16(p[0][0], p[0][1]); pw.y = cvt_pk_bf16(p[0][2], p[0][3]); pw.z = cvt_pk_bf16(p[1][0], p[1][1]); pw.w = cvt_pk_bf16(p[1][2], p[1][3]);
        Pb[r] = __builtin_bit_cast(bf16x8, pw);
    }
    __builtin_amdgcn_sched_barrier(0);
    if (k0n >= 0) asm volatile("s_waitcnt vmcnt(8)" ::: "memory"); else asm volatile("s_waitcnt vmcnt(0)" ::: "memory");
#pragma unroll
    for (int dt = 0; dt < NDT; ++dt) { const bf16x8 vf = vr[dt * 64];
#pragma unroll
        for (int r = 0; r < NR; ++r) O[r][dt] = MFMA16(vf, Pb[r], O[r][dt]); }
    asm volatile("s_waitcnt lgkmcnt(0)" ::: "memory");
    __builtin_amdgcn_sched_barrier(0);
    if (k0n >= 0) att_vdma<VSTEP>(Vf, k0n, lane8, ring);
    __builtin_amdgcn_sched_barrier(0);
}

struct MixPtrs { const bf16_t* Y; bf16_t* ONSA; bf16_t* ORET; const bf16_t* VTS; const bf16_t* VTW; const bf16_t* VTR; const bf16_t* KC; const bf16_t* VCT; const float* gn; const bf16_t* KS; const bf16_t* KW; const bf16_t* KR; };

__device__ __forceinline__ void cmp_unit(const MixPtrs& P, unsigned* __restrict__ SM, int bg, int grp, LAS unsigned char* lds, int tid) {
    const int lane = tid & 63, wave = __builtin_amdgcn_readfirstlane(tid >> 6), l15 = lane & 15, fq = lane >> 4;
    const int b = bg >> 2, g = bg & 3, t0 = (grp * 8 + wave) * 16, t = t0 + l15;
#pragma unroll
    for (int i = 0; i < 8; ++i) {
        const int blk = wave * 8 + i;
        const bf16_t* src = (blk < 32 ? P.KC + (size_t)bg * 16384 + blk * 512 : P.VCT + (size_t)bg * 16384 + (blk - 32) * 512) + lane * 8;
        __builtin_amdgcn_global_load_lds((const unsigned*)src, (LAS unsigned*)(lds + blk * 1024), 16, 0, 0);
    }
    const bf16_t* Yt = P.Y + (size_t)(b * 2048 + t) * LDY;
    bf16_t* orow = P.ONSA + (size_t)(b * 2048 + t) * D_;
    constexpr float SC2 = 0.08838834764831845f * LOG2E;
    const int tq64 = t - 64 * fq; const float tq64f = (float)tq64 - 15.5f;
    const LAS bf16x8* kl = (const LAS bf16x8*)lds + lane;
    const LAS bf16x8* vl = (const LAS bf16x8*)(lds + 32768) + lane;
    float pown[8], ptail[8];
#pragma unroll
    for (int kt = 0; kt < 8; ++kt) { pown[kt] = 0.f; ptail[kt] = 0.f; }
    asm volatile("s_waitcnt vmcnt(0)" ::: "memory");
    __syncthreads();
#pragma unroll 1
    for (int hd = 0; hd < 4; ++hd) {
        const int hh = 4 * g + hd;
        bf16x8 Qf[4];
#pragma unroll
        for (int dc = 0; dc < 4; ++dc) Qf[dc] = *(const bf16x8*)(Yt + OFF_Q + hh * 128 + 32 * dc + 8 * fq);
        const float gate = sigmoid_f(bf2f(Yt[OFF_GL + hh]));
        f32x4 s[8];
#pragma unroll
        for (int kt = 0; kt < 8; ++kt) { s[kt] = (f32x4){0.f, 0.f, 0.f, 0.f};
#pragma unroll
            for (int dc = 0; dc < 4; ++dc) s[kt] = MFMA16(kl[(kt * 4 + dc) * 64], Qf[dc], s[kt]); }
        const float slope2 = ex2(-0.5f * (float)(hh + 1)) * LOG2E;
        float mx = -INFINITY;
#pragma unroll
        for (int kt = 0; kt < 8; ++kt)
#pragma unroll
            for (int j = 0; j < 4; ++j) {
                const bool valid = (256 * kt + 16 * j + 31) <= tq64;
                const float v = valid ? s[kt][j] * SC2 - slope2 * (tq64f - (float)(256 * kt + 16 * j)) : -INFINITY;
                s[kt][j] = v; mx = fmaxf(mx, v);
            }
        mx = rowred_max(mx);
        const float muse = (mx == -INFINITY) ? 0.f : mx;
        float ls = 0.f;
#pragma unroll
        for (int kt = 0; kt < 8; ++kt)
#pragma unroll
            for (int j = 0; j < 4; ++j) { const float pv = ex2(s[kt][j] - muse); s[kt][j] = pv; ls += pv; }
        ls = rowred_sum(ls);
        const float inv = 1.0f / fmaxf(ls, 1.17549435e-38f);
#pragma unroll
        for (int kt = 0; kt < 8; ++kt)
#pragma unroll
            for (int j = 0; j < 4; ++j) s[kt][j] *= inv;
#pragma unroll
        for (int kt = 0; kt < 8; ++kt) { const float h3 = 0.5f * s[kt][3]; ptail[kt] += h3; pown[kt] += ((s[kt][0] + s[kt][1]) + s[kt][2]) + h3; }
        f32x4 O[8];
#pragma unroll
        for (int dt = 0; dt < 8; ++dt) O[dt] = (f32x4){0.f, 0.f, 0.f, 0.f};
#pragma unroll
        for (int ks = 0; ks < 4; ++ks) {
            u32x4 pw; pw.x = cvt_pk_bf16(s[2 * ks][0], s[2 * ks][1]); pw.y = cvt_pk_bf16(s[2 * ks][2], s[2 * ks][3]);
            pw.z = cvt_pk_bf16(s[2 * ks + 1][0], s[2 * ks + 1][1]); pw.w = cvt_pk_bf16(s[2 * ks + 1][2], s[2 * ks + 1][3]);
            const bf16x8 Pb = __builtin_bit_cast(bf16x8, pw);
#pragma unroll
            for (int dt = 0; dt < 8; ++dt) O[dt] = MFMA16(vl[(ks * 8 + dt) * 64], Pb, O[dt]);
        }
#pragma unroll
        for (int dt = 0; dt < 8; ++dt) {
            u32x2 w; w.x = cvt_pk_bf16(O[dt][0] * gate, O[dt][1] * gate); w.y = cvt_pk_bf16(O[dt][2] * gate, O[dt][3] * gate);
            *(u32x2*)(orow + hh * 128 + 16 * dt + 4 * fq) = w;
        }
    }
    {
        float val[8], sh[8];
        const int bq = (t >> 6) - fq;
#pragma unroll
        for (int kt = 0; kt < 8; ++kt) sh[kt] = __shfl(ptail[kt], (lane + 48) & 63);
#pragma unroll
        for (int kt = 0; kt < 8; ++kt) {
            const float prev = fq > 0 ? sh[kt] : (kt > 0 ? sh[kt > 0 ? kt - 1 : 0] : 0.f);
            const float imp = pown[kt] + prev;
            const bool forced = (kt == 0 && fq == 0) || (4 * kt == bq) || (4 * kt == bq - 1);
            val[kt] = forced ? 1e4f : (4 * kt <= bq ? imp : -1e4f);
        }
        int cnt[8];
#pragma unroll
        for (int kt = 0; kt < 8; ++kt) cnt[kt] = 0;
#pragma unroll 1
        for (int f2 = 0; f2 < 4; ++f2) {
            const int df = fq - f2;
#pragma unroll
            for (int k2 = 0; k2 < 8; ++k2) {
                const float o = __shfl(val[k2], l15 + 16 * f2);
#pragma unroll
                for (int kt = 0; kt < 8; ++kt) cnt[kt] += ((o > val[kt]) || (o == val[kt] && (4 * (k2 - kt)) < df)) ? 1 : 0;
            }
        }
        unsigned smq = 0;
#pragma unroll
        for (int kt = 0; kt < 8; ++kt) if (cnt[kt] < 16) smq |= 1u << (4 * kt);
        unsigned sm = smq << fq;
        sm |= __shfl_xor(sm, 16); sm |= __shfl_xor(sm, 32);
        if (fq == 0) SM[bg * 2048 + t] = sm;
    }
    __syncthreads();
}

__device__ __forceinline__ void nsa_unit(const MixPtrs& P, const unsigned* __restrict__ SM, int b, int g, int tile, int hp  , int lane, LAS bf16x8* qs  , LAS unsigned char* qbase  ) {
    const int l15 = lane & 15, fq = lane >> 4, t0 = tile * 16, t = t0 + l15, bg = b * 4 + g;
    const bf16_t* Yt = P.Y + (size_t)(b * 2048 + t) * LDY;
    bf16_t* orow = P.ONSA + (size_t)(b * 2048 + t) * D_;
    const int tq = t - 4 * fq, lane8 = lane * 8;
    const unsigned sm = SM[bg * 2048 + t];
    bf16x8 Qf[2][4];
#pragma unroll
    for (int r = 0; r < 2; ++r)
#pragma unroll
        for (int dc = 0; dc < 4; ++dc) Qf[r][dc] = *(const bf16x8*)(Yt + OFF_Q + (4 * g + 2 * hp + r) * 128 + 32 * dc + 8 * fq);
    {
        float coef[2], m[2], l[2]; f32x4 O[2][8];
        LAS unsigned char* ring = qbase;
#pragma unroll
        for (int r = 0; r < 2; ++r) coef[r] = ex2(-0.5f * (float)(4 * g + 2 * hp + r + 1)) * LOG2E;
#pragma unroll 1
        for (int br = 1; br < 3; ++br) {
#pragma unroll
            for (int r = 0; r < 2; ++r) { m[r] = -INFINITY; l[r] = 0.f;
#pragma unroll
                for (int dt = 0; dt < 8; ++dt) O[r][dt] = (f32x4){0.f, 0.f, 0.f, 0.f}; }
            asm volatile("s_waitcnt vmcnt(0) lgkmcnt(0)" ::: "memory");
            if (br == 1) {
                const bf16_t* Kp = P.KS + (size_t)bg * 262144; const bf16_t* Vt = P.VTS + (size_t)bg * 262144;
                const int blkmax = (t0 + 15) >> 6;
                unsigned U = 0;
#pragma unroll 1
                for (int jb = 0; jb <= blkmax; ++jb) if (__ballot((sm >> jb) & 1u) != 0ull) U |= 1u << jb;
                int jb = __builtin_ctz(U), k0 = 64 * jb;
                att_kdma(Kp, k0, lane8, ring); att_vdma(Vt, k0, lane8, ring);
#pragma unroll 1
                for (;;) {
                    int k0n, jbn = jb;
                    if ((k0 & 32) == 0) k0n = k0 + 32;
                    else { const unsigned rest = jb >= 31 ? 0u : (U >> (jb + 1)); if (rest == 0u) k0n = -1; else { jbn = jb + 1 + __builtin_ctz(rest); k0n = 64 * jbn; } }
                    const bool vb = (sm >> jb) & 1u;
                    const bool full = (k0 + 31 <= t0) && (__ballot(vb) == ~0ull);
                    att_step2<0>(Kp, Vt, k0, k0n, tq, lane8, Qf, ring, lane, O, m, l, coef, vb, full);
                    if (k0n < 0) break;
                    k0 = k0n; jb = jbn;
                }
            } else {
                const bf16_t* Kp = P.KW + (size_t)bg * 262144; const bf16_t* Vt = P.VTW + (size_t)bg * 262144;
                int kstart = t0 - 511; kstart = kstart < 0 ? 0 : (kstart & ~31);
                att_kdma(Kp, kstart, lane8, ring); att_vdma(Vt, kstart, lane8, ring);
#pragma unroll 1
                for (int k0 = kstart; k0 <= t0; k0 += 32) att_step2<1>(Kp, Vt, k0, (k0 + 32 <= t0) ? k0 + 32 : -1, tq, lane8, Qf, ring, lane, O, m, l, coef, true, (k0 + 31 <= t0) && (k0 >= t0 - 496));
            }
#pragma unroll
            for (int r = 0; r < 2; ++r) {
                const int hh = 4 * g + 2 * hp + r;
                const float lt = rowred_sum(l[r]);
                const float sc = sigmoid_f(bf2f(Yt[OFF_GL + br * 16 + hh])) / fmaxf(lt, 1.17549435e-38f);
#pragma unroll
                for (int dt = 0; dt < 8; ++dt) {
                    u32x2* op = (u32x2*)(orow + hh * 128 + 16 * dt + 4 * fq);
                    const u32x2 pw = *op;
                    u32x2 w; w.x = cvt_pk_bf16(bf_lo(pw.x) + O[r][dt][0] * sc, bf_hi(pw.x) + O[r][dt][1] * sc);
                    w.y = cvt_pk_bf16(bf_lo(pw.y) + O[r][dt][2] * sc, bf_hi(pw.y) + O[r][dt][3] * sc);
                    *op = w;
                }
            }
        }
    }
}

__device__ __forceinline__ void ret_unit(const MixPtrs& P, int b, int h, int tile, int lane, LAS bf16x8* qs, LAS unsigned char* qbase) {
    const int l15 = lane & 15, fq = lane >> 4, t0 = tile * 16, t = t0 + l15;
    const bf16_t* Yb = P.Y + (size_t)(b * 2048) * LDY;
    const bf16_t* Yt = Yb + (size_t)t * LDY;
    float coef[1], m[1], l[1]; f32x4 O[1][16];
    const LAS bf16x8* Qf = qs;
#pragma unroll
    for (int dc = 0; dc < 4; ++dc) qs[dc * 64] = *(const bf16x8*)(Yt + OFF_QR + h * 128 + 32 * dc + 8 * fq);
    coef[0] = log1pf(-exp2f(-5.0f - (float)h)) * LOG2E; m[0] = 0.f; l[0] = 0.f;
#pragma unroll
    for (int dt = 0; dt < 16; ++dt) O[0][dt] = (f32x4){0.f, 0.f, 0.f, 0.f};
    const bf16_t* Kp = P.KR + (size_t)(b * 8 + h) * 262144; const bf16_t* Vt = P.VTR + (size_t)(b * 8 + h) * 524288;
    LAS unsigned char* ring = qbase + 8192;
    asm volatile("s_waitcnt lgkmcnt(0)" ::: "memory");
    att_kdma(Kp, 0, lane * 8, ring);
#pragma unroll 1
    for (int k0 = 0; k0 <= t0; k0 += 32) att_step<1, 16, 2>(Kp, Vt, k0, (k0 + 32 <= t0) ? k0 + 32 : -1, t - 4 * fq, lane * 8, Qf, ring, lane, O, m, l, coef, true);
    float sum = 0.f;
#pragma unroll
    for (int dt = 0; dt < 16; ++dt) sum += (O[0][dt][0] + O[0][dt][1]) + (O[0][dt][2] + O[0][dt][3]);
    sum = rowred_sum(sum);
    const float mean = sum * (1.0f / 256.0f);
    float var = 0.f;
#pragma unroll
    for (int dt = 0; dt < 16; ++dt) { const f32x4 d = O[0][dt] - mean; var += (d[0] * d[0] + d[1] * d[1]) + (d[2] * d[2] + d[3] * d[3]); }
    var = rowred_sum(var);
    const float rstd = 1.0f / sqrtf(var * (1.0f / 256.0f) + EPS_);
    bf16_t* orow = P.ORET + (size_t)(b * 2048 + t) * D_ + h * 256;
#pragma unroll
    for (int dt = 0; dt < 16; ++dt) {
        const int e = 16 * dt + 4 * fq;
        const f32x4 gain = *(const f32x4*)(P.gn + h * 256 + e);
        const u32x2 gw = *(const u32x2*)(Yt + OFF_GR + h * 256 + e);
        const f32x4 y = (O[0][dt] - mean) * rstd * gain;
        u32x2 w; w.x = cvt_pk_bf16(silu_f(bf_lo(gw.x)) * y[0], silu_f(bf_hi(gw.x)) * y[1]); w.y = cvt_pk_bf16(silu_f(bf_lo(gw.y)) * y[2], silu_f(bf_hi(gw.y)) * y[3]);
        *(u32x2*)(orow + e) = w;
    }
}

__device__ __forceinline__ void ret_unit2(const MixPtrs& P, int b, int h, int tile32, int lane, LAS unsigned char* ring) {
    const int l15 = lane & 15, fq = lane >> 4, t0 = tile32 * 32, lane8 = lane * 8;
    const bf16_t* Yb = P.Y + (size_t)(b * 2048) * LDY;
    bf16x8 Qf[2][4]; float coef[2], m[2], l[2]; f32x4 O[2][8], Oa[2][8];
#pragma unroll
    for (int r = 0; r < 2; ++r)
#pragma unroll
        for (int dc = 0; dc < 4; ++dc) Qf[r][dc] = *(const bf16x8*)(Yb + (size_t)(t0 + 16 * r + l15) * LDY + OFF_QR + h * 128 + 32 * dc + 8 * fq);
    coef[0] = log1pf(-exp2f(-5.0f - (float)h)) * LOG2E; coef[1] = coef[0]; m[0] = m[1] = 0.f; l[0] = l[1] = 0.f;
    const bf16_t* Kp = P.KR + (size_t)(b * 8 + h) * 262144;
    const int tq = t0 + l15 - 4 * fq;
#pragma unroll
    for (int hf = 0; hf < 2; ++hf) {
        const bf16_t* Vt = P.VTR + (size_t)(b * 8 + h) * 524288 + hf * 4096;
#pragma unroll
        for (int r = 0; r < 2; ++r)
#pragma unroll
            for (int dt = 0; dt < 8; ++dt) O[r][dt] = (f32x4){0.f, 0.f, 0.f, 0.f};
        asm volatile("s_waitcnt vmcnt(0) lgkmcnt(0)" ::: "memory");
        att_kdma(Kp, 0, lane8, ring); att_vdma<8192>(Vt, 0, lane8, ring);
#pragma unroll 1
        for (int k0 = 0; k0 <= t0; k0 += 32) att_step2<2, 16, 8192>(Kp, Vt, k0, (k0 + 32 <= t0) ? k0 + 32 : -1, tq, lane8, Qf, ring, lane, O, m, l, coef, true, false);
        if (hf == 0) {
#pragma unroll
            for (int r = 0; r < 2; ++r)
#pragma unroll
                for (int dt = 0; dt < 8; ++dt) Oa[r][dt] = O[r][dt];
        }
    }
#pragma unroll
    for (int r = 0; r < 2; ++r) {
        float sum = 0.f;
#pragma unroll
        for (int dt = 0; dt < 8; ++dt) sum += ((Oa[r][dt][0] + Oa[r][dt][1]) + (Oa[r][dt][2] + Oa[r][dt][3])) + ((O[r][dt][0] + O[r][dt][1]) + (O[r][dt][2] + O[r][dt][3]));
        sum = rowred_sum(sum);
        const float mean = sum * (1.0f / 256.0f);
        float var = 0.f;
#pragma unroll
        for (int dt = 0; dt < 8; ++dt) { const f32x4 d0 = Oa[r][dt] - mean, d1 = O[r][dt] - mean;
            var += ((d0[0] * d0[0] + d0[1] * d0[1]) + (d0[2] * d0[2] + d0[3] * d0[3])) + ((d1[0] * d1[0] + d1[1] * d1[1]) + (d1[2] * d1[2] + d1[3] * d1[3])); }
        var = rowred_sum(var);
        const float rstd = 1.0f / sqrtf(var * (1.0f / 256.0f) + EPS_);
        const int t = t0 + 16 * r + l15;
        const bf16_t* Yt = Yb + (size_t)t * LDY;
        bf16_t* orow = P.ORET + (size_t)(b * 2048 + t) * D_ + h * 256;
#pragma unroll
        for (int hf = 0; hf < 2; ++hf)
#pragma unroll
            for (int dt = 0; dt < 8; ++dt) {
                const int e = 128 * hf + 16 * dt + 4 * fq;
                const f32x4 gain = *(const f32x4*)(P.gn + h * 256 + e);
                const u32x2 gw = *(const u32x2*)(Yt + OFF_GR + h * 256 + e);
                const f32x4 y = ((hf ? O[r][dt] : Oa[r][dt]) - mean) * rstd * gain;
                u32x2 w; w.x = cvt_pk_bf16(silu_f(bf_lo(gw.x)) * y[0], silu_f(bf_hi(gw.x)) * y[1]); w.y = cvt_pk_bf16(silu_f(bf_lo(gw.y)) * y[2], silu_f(bf_hi(gw.y)) * y[3]);
                *(u32x2*)(orow + e) = w;
            }
    }
}

__device__ __forceinline__ void ret_states(const bf16_t* __restrict__ KRT, const bf16_t* __restrict__ VTR, bf16_t* __restrict__ ST, int item, int lane) {
    const int bh = item >> 6, et = (item >> 2) & 15, dc = item & 3, h = bh & 7;
    const float g128 = ex2(log1pf(-exp2f(-5.0f - (float)h)) * LOG2E * 128.0f);
    const bf16_t* kb = KRT + (size_t)bh * 262144 + (size_t)(2 * dc) * 512 + lane * 8;
    const bf16_t* vb = VTR + (size_t)bh * 524288 + (size_t)et * 512 + lane * 8;
    bf16_t* sb = ST + ((size_t)(bh * 16) * 16 + et) * 2048 + dc * 512 + lane * 8;
    f32x4 S0 = (f32x4){0.f, 0.f, 0.f, 0.f}, S1 = S0;
#pragma unroll 1
    for (int j = 0; j < 15; ++j) {
        f32x4 a0 = (f32x4){0.f, 0.f, 0.f, 0.f}, a1 = a0;
#pragma unroll
        for (int ks = 0; ks < 4; ++ks) {
            const int st = 4 * j + ks;
            const bf16x8 vf = *(const bf16x8*)(vb + (size_t)st * 8192), k0f = *(const bf16x8*)(kb + (size_t)st * 4096), k1f = *(const bf16x8*)(kb + (size_t)st * 4096 + 512);
            a0 = MFMA16(k0f, vf, a0); a1 = MFMA16(k1f, vf, a1);
        }
        S0 = S0 * g128 + a0; S1 = S1 * g128 + a1;
        u32x4 w; w.x = cvt_pk_bf16(S0[0], S0[1]); w.y = cvt_pk_bf16(S0[2], S0[3]); w.z = cvt_pk_bf16(S1[0], S1[1]); w.w = cvt_pk_bf16(S1[2], S1[3]);
        *(u32x4*)(sb + (size_t)(j + 1) * 16 * 2048) = w;
    }
}

__device__ __forceinline__ void ret_unit3(const MixPtrs& P, const bf16_t* __restrict__ ST, int b, int h, int tile32, int lane, LAS unsigned char* ring) {
    const int l15 = lane & 15, fq = lane >> 4, t0 = tile32 * 32, lane8 = lane * 8, c = t0 >> 7, cs = c * 128, bh = b * 8 + h;
    const bf16_t* Yb = P.Y + (size_t)(b * 2048) * LDY;
    float coef[2], m[2], l[2]; f32x4 O[2][8]; u32x2 Oa[2][8];
    const float lg2g = log1pf(-exp2f(-5.0f - (float)h)) * LOG2E;
    coef[0] = lg2g; coef[1] = lg2g; m[0] = m[1] = 0.f; l[0] = l[1] = 0.f;
    const bf16_t* Kp = P.KR + (size_t)bh * 262144;
    const int tq = t0 + l15 - 4 * fq;
#pragma unroll
    for (int hf = 0; hf < 2; ++hf) {
        const bf16_t* Vt = P.VTR + (size_t)bh * 524288 + hf * 4096;
#pragma unroll
        for (int r = 0; r < 2; ++r)
#pragma unroll
            for (int dt = 0; dt < 8; ++dt) O[r][dt] = (f32x4){0.f, 0.f, 0.f, 0.f};
        asm volatile("s_waitcnt vmcnt(0) lgkmcnt(0)" ::: "memory");
        if (c > 0) {
            const bf16_t* sb = ST + ((size_t)(bh * 16 + c) * 16 + 8 * hf) * 2048 + lane8;
#pragma unroll
            for (int dc = 0; dc < 4; ++dc) {
                bf16x8 Qp[2];
#pragma unroll
                for (int r = 0; r < 2; ++r) { const bf16_t* qp = Yb + (size_t)(t0 + 16 * r + l15) * LDY + OFF_QR + h * 128 + 32 * dc + 4 * fq;
                    const s16x4 lo = *(const s16x4*)qp, hi = *(const s16x4*)(qp + 16); Qp[r] = __builtin_shufflevector(lo, hi, 0, 1, 2, 3, 4, 5, 6, 7); }
#pragma unroll
                for (int dt = 0; dt < 8; ++dt) { const bf16x8 sf = *(const bf16x8*)(sb + (size_t)dt * 2048 + dc * 512);
#pragma unroll
                    for (int r = 0; r < 2; ++r) O[r][dt] = MFMA16(sf, Qp[r], O[r][dt]); }
            }
#pragma unroll
            for (int r = 0; r < 2; ++r) { const float xi = ex2(lg2g * (float)(((t0 + 16 * r + l15) & 127) + 1));
#pragma unroll
                for (int dt = 0; dt < 8; ++dt) O[r][dt] *= xi; }
            asm volatile("s_waitcnt vmcnt(0) lgkmcnt(0)" ::: "memory");
        }
        bf16x8 Qf[2][4];
#pragma unroll
        for (int r = 0; r < 2; ++r)
#pragma unroll
            for (int dc = 0; dc < 4; ++dc) Qf[r][dc] = *(const bf16x8*)(Yb + (size_t)(t0 + 16 * r + l15) * LDY + OFF_QR + h * 128 + 32 * dc + 8 * fq);
        asm volatile("s_waitcnt vmcnt(0)" ::: "memory");
        att_kdma(Kp, cs, lane8, ring); att_vdma<8192>(Vt, cs, lane8, ring);
#pragma unroll 1
        for (int k0 = cs; k0 <= t0; k0 += 32) att_step2<2, 16, 8192>(Kp, Vt, k0, (k0 + 32 <= t0) ? k0 + 32 : -1, tq, lane8, Qf, ring, lane, O, m, l, coef, true, false);
        if (hf == 0) {
#pragma unroll
            for (int r = 0; r < 2; ++r)
#pragma unroll
                for (int dt = 0; dt < 8; ++dt) { Oa[r][dt].x = cvt_pk_bf16(O[r][dt][0], O[r][dt][1]); Oa[r][dt].y = cvt_pk_bf16(O[r][dt][2], O[r][dt][3]); }
        }
    }
#pragma unroll
    for (int r = 0; r < 2; ++r) {
        float sum = 0.f;
#pragma unroll
        for (int dt = 0; dt < 8; ++dt) sum += ((bf_lo(Oa[r][dt].x) + bf_hi(Oa[r][dt].x)) + (bf_lo(Oa[r][dt].y) + bf_hi(Oa[r][dt].y))) + ((O[r][dt][0] + O[r][dt][1]) + (O[r][dt][2] + O[r][dt][3]));
        sum = rowred_sum(sum);
        const float mean = sum * (1.0f / 256.0f);
        float var = 0.f;
#pragma unroll
        for (int dt = 0; dt < 8; ++dt) { const f32x4 d0 = (f32x4){bf_lo(Oa[r][dt].x), bf_hi(Oa[r][dt].x), bf_lo(Oa[r][dt].y), bf_hi(Oa[r][dt].y)} - mean, d1 = O[r][dt] - mean;
            var += ((d0[0] * d0[0] + d0[1] * d0[1]) + (d0[2] * d0[2] + d0[3] * d0[3])) + ((d1[0] * d1[0] + d1[1] * d1[1]) + (d1[2] * d1[2] + d1[3] * d1[3])); }
        var = rowred_sum(var);
        const float rstd = 1.0f / sqrtf(var * (1.0f / 256.0f) + EPS_);
        const int t = t0 + 16 * r + l15;
        const bf16_t* Yt = Yb + (size_t)t * LDY;
        bf16_t* orow = P.ORET + (size_t)(b * 2048 + t) * D_ + h * 256;
#pragma unroll
        for (int hf = 0; hf < 2; ++hf)
#pragma unroll
            for (int dt = 0; dt < 8; ++dt) {
                const int e = 128 * hf + 16 * dt + 4 * fq;
                const f32x4 gain = *(const f32x4*)(P.gn + h * 256 + e);
                const u32x2 gw = *(const u32x2*)(Yt + OFF_GR + h * 256 + e);
                const f32x4 yv = hf ? O[r][dt] : (f32x4){bf_lo(Oa[r][dt].x), bf_hi(Oa[r][dt].x), bf_lo(Oa[r][dt].y), bf_hi(Oa[r][dt].y)};
                const f32x4 y = (yv - mean) * rstd * gain;
                u32x2 w; w.x = cvt_pk_bf16(silu_f(bf_lo(gw.x)) * y[0], silu_f(bf_hi(gw.x)) * y[1]); w.y = cvt_pk_bf16(silu_f(bf_lo(gw.y)) * y[2], silu_f(bf_hi(gw.y)) * y[3]);
                *(u32x2*)(orow + e) = w;
            }
    }
}

__device__ __forceinline__ void compress_unit(int unit, const bf16_t* __restrict__ Y, const float* __restrict__ cmp_pos, const float* __restrict__ cmp_b1, const float* __restrict__ g_qk,
                                              const bf16_t* __restrict__ WC1, const bf16_t* __restrict__ WC2, bf16_t* __restrict__ KC, bf16_t* __restrict__ VCT, LAS unsigned char* lds, int tid) {
    const int lane = tid & 63, wave = tid >> 6, l15 = lane & 15, fq = lane >> 4;
    const int i = unit >> 7, bg = (unit >> 3) & 15, ct = unit & 7, b = bg >> 2, g = bg & 3;
    const int c = 16 * ct + l15; const bool cvalid = c < 127;
    const bf16_t* Yc = Y + (size_t)(b * 2048 + 16 * (cvalid ? c : 0)) * LDY + OFF_KV + i * 512 + g * 128;
    LAS float* red = (LAS float*)lds;
    LAS bf16_t* hid = (LAS bf16_t*)(lds + 65536);
    f32x4 acc[8];
#pragma unroll
    for (int nt = 0; nt < 8; ++nt) acc[nt] = (f32x4){0.f, 0.f, 0.f, 0.f};
#pragma unroll 1
    for (int ls = 0; ls < 4; ++ls) {
        const int l = 4 * wave + ls;
#pragma unroll
        for (int dc = 0; dc < 4; ++dc) {
            const int d = 32 * dc + 8 * fq;
            u32x4 aw = (u32x4){0u, 0u, 0u, 0u};
            if (cvalid) {
                const u32x4 zw = *(const u32x4*)(Yc + (size_t)l * LDY + d);
                const f32x4 p0 = *(const f32x4*)(cmp_pos + (size_t)(i * 32 + l) * 128 + d), p1 = *(const f32x4*)(cmp_pos + (size_t)(i * 32 + l) * 128 + d + 4);
                aw.x = cvt_pk_bf16(bf_lo(zw.x) + p0[0], bf_hi(zw.x) + p0[1]); aw.y = cvt_pk_bf16(bf_lo(zw.y) + p0[2], bf_hi(zw.y) + p0[3]);
                aw.z = cvt_pk_bf16(bf_lo(zw.z) + p1[0], bf_hi(zw.z) + p1[1]); aw.w = cvt_pk_bf16(bf_lo(zw.w) + p1[2], bf_hi(zw.w) + p1[3]);
            }
            const bf16x8 a = __builtin_bit_cast(bf16x8, aw);
            const int kidx = l * 128 + 32 * dc + 8 * fq;
#pragma unroll
            for (int nt = 0; nt < 8; ++nt) { const bf16x8 bf = *(const bf16x8*)(WC1 + (size_t)i * 524288 + (size_t)(((l * 4 + dc) * 8 + nt) * 64 + lane) * 8); acc[nt] = MFMA16(a, bf, acc[nt]); }
        }
    }
#pragma unroll
    for (int nt = 0; nt < 8; ++nt)
#pragma unroll
        for (int j = 0; j < 4; ++j) red[(wave * 16 + 4 * fq + j) * 128 + 16 * nt + l15] = acc[nt][j];
    __syncthreads();
    {
        const int e = tid * 4, cc = e >> 7, n = e & 127;
        f32x4 s = *(const f32x4*)(cmp_b1 + i * 128 + n);
#pragma unroll
        for (int w = 0; w < 8; ++w) s += *(const LAS f32x4*)(red + (w * 16 + cc) * 128 + n);
        float o[4];
#pragma unroll
        for (int j = 0; j < 4; ++j) { const float x = s[j]; o[j] = 0.5f * x * (1.0f + tanhf(0.7978845608028654f * (x + 0.044715f * x * x * x))); }
        u32x2 w; w.x = cvt_pk_bf16(o[0], o[1]); w.y = cvt_pk_bf16(o[2], o[3]);
        *(LAS u32x2*)(hid + cc * 136 + n) = w;
    }
    __syncthreads();
    f32x4 o2 = (f32x4){0.f, 0.f, 0.f, 0.f};
#pragma unroll
    for (int kc = 0; kc < 4; ++kc) {
        const bf16x8 a = *(const LAS bf16x8*)(hid + l15 * 136 + 32 * kc + 8 * fq);
        const bf16x8 bf = *(const bf16x8*)(WC2 + (size_t)(i * 128 + 16 * wave + l15) * 128 + 32 * kc + 8 * fq);
        o2 = MFMA16(a, bf, o2);
    }
    if (i == 1) {
        const int cbase = 16 * ct + 4 * fq;
        u32x2 w; w.x = cvt_pk_bf16(cbase + 0 < 127 ? o2[0] : 0.f, cbase + 1 < 127 ? o2[1] : 0.f); w.y = cvt_pk_bf16(cbase + 2 < 127 ? o2[2] : 0.f, cbase + 3 < 127 ? o2[3] : 0.f);
        *(u32x2*)(VCT + (size_t)bg * 16384 + (((ct >> 1) * 8 + wave) * 64 + lane) * 8 + 4 * (ct & 1)) = w;
    } else {
#pragma unroll
        for (int j = 0; j < 4; ++j) red[(4 * fq + j) * 128 + 16 * wave + l15] = o2[j];
        __syncthreads();
        const int cc = tid >> 5, part = tid & 31;
        const f32x4 v = *(const LAS f32x4*)(red + cc * 128 + 4 * part);
        float ss = (v[0] * v[0] + v[1] * v[1]) + (v[2] * v[2] + v[3] * v[3]);
#pragma unroll
        for (int o = 1; o < 32; o <<= 1) ss += __shfl_xor(ss, o);
        const float r = 1.0f / sqrtf(ss * (1.0f / 128.0f) + EPS_);
        const f32x4 gq = *(const f32x4*)(g_qk + 128 + 4 * part);
        f32x4 y = v * r * gq;
        if (16 * ct + cc >= 127) y = (f32x4){0.f, 0.f, 0.f, 0.f};
        u32x2 w; w.x = cvt_pk_bf16(y[0], y[1]); w.y = cvt_pk_bf16(y[2], y[3]);
        *(u32x2*)(KC + (size_t)bg * 16384 + (ct * 4 + (part >> 3)) * 512 + ((part >> 1) & 3) * 128 + cc * 8 + 4 * (part & 1)) = w;
    }
    __syncthreads();
}


#define XB_TMO      128
#define XB_XCNT(j)  (256  + 64 * (j))
#define XB_XSUB(j)  (1280 + 64 * (j))
#define XB_XGEN(j)  (2304 + 64 * (j))
#define XB_TOP      3328
#define XB_TOPGEN   3392
#define XCD_BAR_WORDS 3456
#define XB_SPIN_CAP (1u << 18)
__device__ __forceinline__ unsigned xb_ld(unsigned* p)              { return __hip_atomic_load(p, __ATOMIC_RELAXED, __HIP_MEMORY_SCOPE_AGENT); }
__device__ __forceinline__ unsigned xb_add(unsigned* p, unsigned v) { return __hip_atomic_fetch_add(p, v, __ATOMIC_RELAXED, __HIP_MEMORY_SCOPE_AGENT); }
__device__ __forceinline__ unsigned xb_xcc_id() { return (unsigned)__builtin_amdgcn_s_getreg((3 << 11) | 20) & 0xFu; }
#define XB_SPIN(cond, bar) do { unsigned _sp = 0; while (cond) { __builtin_amdgcn_s_sleep(1); \
    if ((++_sp & 255u) == 0u) { if (xb_ld(&(bar)[XB_TMO])) break; if (_sp > XB_SPIN_CAP) { atomicAdd(&(bar)[XB_TMO], 1u); break; } } } } while (0)
struct XcdBarrier { unsigned* bar; unsigned x; volatile LAS unsigned* st; };
__device__ __forceinline__ XcdBarrier xcd_barrier_post(unsigned* bar, volatile LAS unsigned* st) {
    XcdBarrier b; b.bar = bar; b.x = xb_xcc_id(); b.st = st;
    if (threadIdx.x == 0) (void)xb_add(&bar[XB_XCNT(b.x)], 1u);
    return b;
}
__device__ __forceinline__ void xcd_barrier_complete(unsigned* bar, unsigned x, unsigned& nloc, unsigned& nx) {
    const unsigned G = gridDim.x * gridDim.y * gridDim.z;
    unsigned sum, cnt, mine, sp = 0u;
    for (;;) {
        sum = 0u; cnt = 0u; mine = 0u;
#pragma unroll
        for (unsigned j = 0; j < 16; ++j) { const unsigned c = xb_ld(&bar[XB_XCNT(j)]); sum += c; cnt += (c > 0u) ? 1u : 0u; mine = (j == x) ? c : mine; }
        if (sum == G) break;
        __builtin_amdgcn_s_sleep(1);
        if ((++sp & 255u) == 0u) { if (xb_ld(&bar[XB_TMO])) break; if (sp > XB_SPIN_CAP) { atomicAdd(&bar[XB_TMO], 1u); break; } }
    }
    nloc = mine > 0u ? mine : 1u; nx = cnt > 0u ? cnt : 1u;
}
__device__ __forceinline__ void xcd_barrier(const XcdBarrier& b) {
    asm volatile("s_waitcnt vmcnt(0)" ::: "memory");
    __syncthreads();
    if (threadIdx.x == 0) {
        unsigned* bar = b.bar;
        __builtin_amdgcn_s_waitcnt(0);
        unsigned nloc = b.st[0], nx = b.st[1];
        if (nloc == 0u) { xcd_barrier_complete(bar, b.x, nloc, nx); b.st[0] = nloc; b.st[1] = nx; }
        const unsigned old = xb_add(&bar[XB_XSUB(b.x)], 1u);
        const unsigned gen = old / nloc;
        if (old + 1u == (gen + 1u) * nloc) {
            __builtin_amdgcn_fence(__ATOMIC_RELEASE, "agent");
            asm volatile("s_waitcnt vmcnt(0)" ::: "memory");
            const unsigned og = xb_add(&bar[XB_TOP], 1u);
            const unsigned tg = og / nx;
            if (og + 1u == (tg + 1u) * nx) xb_add(&bar[XB_TOPGEN], 1u);
            else XB_SPIN(xb_ld(&bar[XB_TOPGEN]) == tg, bar);
            __builtin_amdgcn_fence(__ATOMIC_ACQUIRE, "agent");
            xb_add(&bar[XB_XGEN(b.x)], 1u);
            asm volatile("s_waitcnt vmcnt(0)" ::: "memory");
        } else {
            XB_SPIN(xb_ld(&bar[XB_XGEN(b.x)]) == gen, bar);
            __builtin_amdgcn_fence(__ATOMIC_ACQUIRE, "agent");
            asm volatile("s_waitcnt vmcnt(0)" ::: "memory");
        }
    }
    __syncthreads();
}

struct Params {
    const float *x, *c, *w_ada, *b_ada, *g_norm, *w_gate, *w_up, *w_down, *w_in, *g_qk, *cmp_pos, *cmp_w1, *cmp_b1, *cmp_w2, *gn_gain, *w_pn, *w_pr, *w_out;
    float* out; unsigned char* ws; int mask; int pad;
};

struct ConvTile { const float* W; bf16_t* WT; int K, N, mode, k0, n0; };
__device__ __forceinline__ ConvTile conv_tile(const Params& p, int set, int idx) {
    ConvTile c; int r = idx, nbn;
    constexpr int T_GU = (D_ / 128) * (FF_ / 128), T_IN = (D_ / 128) * ((NIN_ + 127) / 128), T_P = (D_ / 128) * (D_ / 128), T_C1 = 4096 / 128;
    const int layer = set;
    if (set == 1 || r < 3 * T_GU) {
        bf16_t* gu = (bf16_t*)(p.ws + (layer ? WS_WGU2 : WS_WGU)); bf16_t* dn = (bf16_t*)(p.ws + (layer ? WS_WD2 : WS_WD));
        if (r < T_GU) { c.W = p.w_gate + (size_t)layer * D_ * FF_; c.WT = gu; c.K = D_; c.N = FF_; c.mode = 1; }
        else if (r < 2 * T_GU) { r -= T_GU; c.W = p.w_up + (size_t)layer * D_ * FF_; c.WT = gu; c.K = D_; c.N = FF_; c.mode = 2; }
        else { r -= 2 * T_GU; c.W = p.w_down + (size_t)layer * D_ * FF_; c.WT = dn; c.K = FF_; c.N = D_; c.mode = 0; }
    } else {
        r -= 3 * T_GU;
        if (r < T_IN) { c.W = p.w_in; c.WT = (bf16_t*)(p.ws + WS_WIN); c.K = D_; c.N = NIN_; c.mode = 3; }
        else if (r < T_IN + 3 * T_P) { r -= T_IN; const int w = r / T_P; r -= w * T_P; c.W = w == 0 ? p.w_pn : (w == 1 ? p.w_pr : p.w_out);
            c.WT = (bf16_t*)(p.ws + (w == 0 ? WS_WPN : (w == 1 ? WS_WPR : WS_WO))); c.K = D_; c.N = D_; c.mode = 0; }
        else if (r < T_IN + 3 * T_P + 2 * T_C1) { r -= T_IN + 3 * T_P; const int i = r / T_C1; r -= i * T_C1; c.W = p.cmp_w1 + (size_t)i * 4096 * 128; c.WT = (bf16_t*)(p.ws + WS_WC1) + (size_t)i * 128 * 4096; c.K = 4096; c.N = 128; c.mode = 4; }
        else { r -= T_IN + 3 * T_P + 2 * T_C1; c.W = p.cmp_w2 + (size_t)r * 128 * 128; c.WT = (bf16_t*)(p.ws + WS_WC2) + (size_t)r * 128 * 128; c.K = 128; c.N = 128; c.mode = 0; r = 0; }
    }
    nbn = (c.N + 127) >> 7;
    const int kb = r / nbn, nb = r - kb * nbn; c.k0 = kb * 128; c.n0 = nb * 128;
    return c;
}
__device__ __forceinline__ void conv_load(const ConvTile& c, int tid, f32x4 (&r)[8]) {
    const int c4 = (tid & 31) * 4, r0 = 2 * (tid >> 5);
    const bool ok = (c.n0 + c4) < c.N;
    const float* src = c.W + (size_t)(c.k0 + r0) * c.N + c.n0 + c4;
#pragma unroll
    for (int i = 0; i < 4; ++i)
#pragma unroll
        for (int e = 0; e < 2; ++e) r[2 * i + e] = ok ? *(const f32x4*)(src + (size_t)(32 * i + e) * c.N) : (f32x4){0.f, 0.f, 0.f, 0.f};
}
constexpr int C_FFN = 3 * ((D_ / 128) * (FF_ / 128)), C_IN = C_FFN + (D_ / 128) * ((NIN_ + 127) / 128), C_PR = C_IN + 3 * (D_ / 128) * (D_ / 128);
constexpr int CONV_SPLIT = 600;
constexpr int CONV_T0 = 3 * ((D_ / 128) * (FF_ / 128)) + (D_ / 128) * ((NIN_ + 127) / 128) + 3 * (D_ / 128) * (D_ / 128) + 2 * (4096 / 128) + 2, CONV_T1 = 3 * ((D_ / 128) * (FF_ / 128));
__device__ __forceinline__ void conv_phase(const Params& p, int set, LAS unsigned char* lds, int tid, int bid, int G, int first, int total) {
    f32x4 r[8];
    int idx = first + bid;
    if (idx < total) { const ConvTile c = conv_tile(p, set, idx); conv_load(c, tid, r); }
    for (int it = 0; idx < total; ++it, idx += G) {
        const ConvTile c = conv_tile(p, set, idx);
        LAS bf16_t* buf = (LAS bf16_t*)(lds + (it & 1) * 34816);
        {
            const int c4 = (tid & 31) * 4, r0 = 2 * (tid >> 5);
#pragma unroll
            for (int i = 0; i < 4; ++i)
#pragma unroll
                for (int j = 0; j < 4; ++j) *(LAS unsigned*)(buf + (c4 + j) * 136 + r0 + 32 * i) = cvt_pk_bf16(r[2 * i][j], r[2 * i + 1][j]);
        }
        if (idx + G < total) { const ConvTile n = conv_tile(p, set, idx + G); conv_load(n, tid, r); }
        __syncthreads();
#pragma unroll
        for (int i = 0; i < 4; ++i) {
            const int q = tid + 512 * i, n = q >> 4, kc = q & 15;
            const u32x4 w = *(const LAS u32x4*)(buf + n * 136 + 8 * kc);
            if (c.mode == 4) {
                const int k = c.k0 + 8 * kc;
                *(u32x4*)(c.WT + (size_t)((((k >> 5) * 8 + (n >> 4)) * 64 + ((k >> 3) & 3) * 16 + (n & 15)) * 8)) = w;
            } else if (c.n0 + n < c.N) *(u32x4*)(c.WT + (size_t)rowmap(c.mode, c.n0 + n) * c.K + c.k0 + 8 * kc) = w;
        }
    }
    __syncthreads();
}

__global__ void __launch_bounds__(512, 2) fwd_kernel(Params p) {
    extern __shared__ __attribute__((aligned(16))) unsigned char lds_raw[];
    cg::grid_group grid = cg::this_grid();
    LAS unsigned char* lds = (LAS unsigned char*)lds_raw;
    const int tid = threadIdx.x, lane = tid & 63, wave = __builtin_amdgcn_readfirstlane(tid >> 6);
    const int G = gridDim.x, gw = blockIdx.x * 8 + wave, NGW = G * 8;
#define ctl ((unsigned*)(p.ws + WS_CTL))
#define ada ((float*)(p.ws + WS_ADA))
#define WGU ((bf16_t*)(p.ws + WS_WGU))
#define WD ((bf16_t*)(p.ws + WS_WD))
#define WIN ((bf16_t*)(p.ws + WS_WIN))
#define WPN ((bf16_t*)(p.ws + WS_WPN))
#define WPR ((bf16_t*)(p.ws + WS_WPR))
#define WO ((bf16_t*)(p.ws + WS_WO))
#define WC1 ((bf16_t*)(p.ws + WS_WC1))
#define WC2 ((bf16_t*)(p.ws + WS_WC2))
#define H ((bf16_t*)(p.ws + WS_H))
#define ONSA ((bf16_t*)(p.ws + WS_H))
#define Y ((bf16_t*)(p.ws + WS_Y))
#define ACT ((bf16_t*)(p.ws + WS_Y))
#define MG ((bf16_t*)(p.ws + WS_MG))
#define ORET ((bf16_t*)(p.ws + WS_ORET))
#define VTS ((bf16_t*)(p.ws + WS_VTS))
#define VTW ((bf16_t*)(p.ws + WS_VTW))
#define VTR ((bf16_t*)(p.ws + WS_VTR))
#define KC ((bf16_t*)(p.ws + WS_KC))
#define VCT ((bf16_t*)(p.ws + WS_VCT))
#define KS ((bf16_t*)(p.ws + WS_KS))
#define KW ((bf16_t*)(p.ws + WS_KW))
#define KR ((bf16_t*)(p.ws + WS_KR))
    const int mask = p.mask;
    { LAS unsigned* xbw = (LAS unsigned*)(lds + 131072); if (tid < 4) xbw[tid] = 0u; }
    if (blockIdx.x == 0) { u32x4* z = (u32x4*)(p.ws + WS_CTL); for (int i = tid; i < 32768 / 16; i += 512) z[i] = (u32x4){0u, 0u, 0u, 0u}; }
    __syncthreads();
#ifdef USE_CG_SYNC
#define GSYNC() grid.sync()
#else
#define GSYNC() xcd_barrier(xbar)
#endif
#ifndef DBL_MASK
#define DBL_MASK 0
#endif
#ifdef PROBE_CMP_FIRST
#define CMP_ONLY_COND (rep == 0)
#else
#define CMP_ONLY_COND false
#endif
#define REPS(k) (1 + ((DBL_MASK >> (k)) & 1))
#ifdef CT_MASK
#define ON(k) ((CT_MASK >> (k)) & 1)
#else
#define ON(k) ((mask >> (k)) & 1)
#endif

    for (int rep = 0; rep < REPS(0); ++rep) { if (rep) grid.sync();
    if (ON(0)) {
        LAS float* cond = (LAS float*)lds;
        LAS float* red = (LAS float*)(lds + 32768);
        for (int i = tid; i < 4 * D_; i += 512) cond[i] = silu_f(p.c[i]);
        __syncthreads();
        for (int it = blockIdx.x; it < NADA / 72; it += G) {
            const int n = it * 72 + 2 * lane; const bool act = lane < 36;
            float a[4][2] = {{0.f, 0.f}, {0.f, 0.f}, {0.f, 0.f}, {0.f, 0.f}};
            const int kb = wave * 256;
            if (act) {
#pragma unroll 8
                for (int kk = 0; kk < 256; ++kk) { const int k = kb + kk; const float2 w = *(const float2*)(p.w_ada + (size_t)k * NADA + n);
#pragma unroll
                    for (int bb = 0; bb < 4; ++bb) { const float cv = cond[bb * D_ + k]; a[bb][0] += cv * w.x; a[bb][1] += cv * w.y; } }
#pragma unroll
                for (int bb = 0; bb < 4; ++bb) { red[(wave * 4 + bb) * 72 + 2 * lane] = a[bb][0]; red[(wave * 4 + bb) * 72 + 2 * lane + 1] = a[bb][1]; }
            }
            __syncthreads();
            if (tid < 288) { const int bb = tid / 72, l = tid - bb * 72; float sacc = p.b_ada[it * 72 + l];
#pragma unroll
                for (int w = 0; w < 8; ++w) sacc += red[(w * 4 + bb) * 72 + l];
                ada[(size_t)bb * NADA + it * 72 + l] = sacc; }
            __syncthreads();
        }
        __syncthreads();
        conv_phase(p, 0, lds, tid, (int)blockIdx.x, G, 0, C_FFN);
        { u32x4* z = (u32x4*)(WIN + (size_t)NIN_ * D_); const int nz = (LDY - NIN_) * D_ * 2 / 16;
          for (int i = blockIdx.x * 512 + tid; i < nz; i += G * 512) z[i] = (u32x4){0u, 0u, 0u, 0u}; }
    }
    }
    grid.sync();
    const XcdBarrier xbar = xcd_barrier_post((unsigned*)(p.ws + WS_BAR), (volatile LAS unsigned*)(lds + 131072));
    for (int rep = 0; rep < REPS(1); ++rep) { if (rep) GSYNC();
    if (ON(1)) norm_rows(p.x, p.g_norm, ada, 0, 1, H, gw, NGW, lane);
    }
    GSYNC();
    for (int rep = 0; rep < REPS(2); ++rep) { if (rep) GSYNC();
    if (ON(2)) {
        pg8::Gemm g{H, WGU, T_, 2 * FF_, D_}; pg8::StaticOrder S; S.init(T_, 2 * FF_, G, (int)blockIdx.x);
        EpiSwiglu E{ACT};
        pg8::gemm_phase<EpiSwiglu, pg8::StaticOrder, true, true>(lds, g, S, E);
        { const int rem = ((T_ / 256) * (2 * FF_ / 256)) % G;
          if (rep == 0 && rem && (int)blockIdx.x >= rem) { __syncthreads(); conv_phase(p, 0, lds, tid, (int)blockIdx.x - rem, G - rem, C_FFN, C_IN); conv_phase(p, 0, lds, tid, (int)blockIdx.x - rem, G - rem, C_PR, CONV_T0); } }
    }
    }
    GSYNC();
    if (ON(3)) {
        pg8::Gemm g{ACT, WD, T_, D_, FF_}; pg8::StaticOrder S; S.init(T_, D_, G, (int)blockIdx.x);
        EpiResid E{p.x, p.out, ada + 2 * D_, 0.5f};
        pg8::gemm_phase<EpiResid, pg8::StaticOrder, true, true>(lds, g, S, E);
    } else {
        for (size_t i = (size_t)blockIdx.x * 512 + tid; i < (size_t)T_ * D_ / 4; i += (size_t)G * 512) ((f32x4*)p.out)[i] = ((const f32x4*)p.x)[i];
    }
    GSYNC();
    for (int rep = 0; rep < REPS(4); ++rep) { if (rep) GSYNC();
    if (ON(4)) {
        norm_rows(p.out, p.g_norm + D_, ada, 3, 4, H, gw, NGW, lane);
        __syncthreads();
        { const int rem2 = ((T_ / 256) * (2 * FF_ / 256)) % G, rem5 = ((T_ / 256) * (LDY / 256)) % G;
          if (!rem2) { conv_phase(p, 0, lds, tid, (int)blockIdx.x, G, C_FFN, C_IN); conv_phase(p, 0, lds, tid, (int)blockIdx.x, G, C_PR, CONV_T0); }
          conv_phase(p, 1, lds, tid, (int)blockIdx.x, G, rem5 ? CONV_SPLIT : 0, CONV_T1);
          if (!rem5) conv_phase(p, 0, lds, tid, (int)blockIdx.x, G, C_IN, C_PR); }
    }
    }
    GSYNC();
    for (int rep = 0; rep < REPS(5); ++rep) { if (rep) GSYNC();
    if (ON(5)) {
        pg8::Gemm g{H, WIN, T_, LDY, D_}; pg8::StaticOrder S; S.init(T_, LDY, G, (int)blockIdx.x);
        EpiY E{Y};
        pg8::gemm_phase<EpiY, pg8::StaticOrder, true, true>(lds, g, S, E);
        { const int rem = ((T_ / 256) * (LDY / 256)) % G;
          if (rep == 0 && rem && (int)blockIdx.x >= rem) { __syncthreads(); conv_phase(p, 0, lds, tid, (int)blockIdx.x - rem, G - rem, C_IN, C_PR); conv_phase(p, 1, lds, tid, (int)blockIdx.x - rem, G - rem, 0, CONV_SPLIT); } }
    }
    }
    GSYNC();
    for (int rep = 0; rep < REPS(6); ++rep) { if (rep) GSYNC();
    if (ON(6)) {
#ifndef COMPRESS_REPS
#define COMPRESS_REPS 1
#endif
        for (int z = 0; z < COMPRESS_REPS; ++z) for (int unit = blockIdx.x; unit < 256; unit += G) compress_unit(unit, Y, p.cmp_pos, p.cmp_b1, p.g_qk, WC1, WC2, KC, VCT, lds, tid);
        __syncthreads();
        if (rep == 0) for (int tok = gw; tok < T_; tok += NGW) {
            bf16_t* row = Y + (size_t)tok * LDY;
            const int b = tok >> 11, sidx = tok & 2047, c16 = lane & 15, hsub = lane >> 4;
            const size_t fro = (size_t)((sidx >> 4) * 4 + (c16 >> 2)) * 512 + (c16 & 3) * 128 + (sidx & 15) * 8;
            u32x4 wseg[8];
#pragma unroll
            for (int seg = 0; seg < 8; ++seg) { const int cb = seg < 4 ? seg * 512 : (seg == 4 ? OFF_KV + 1024 : (seg == 5 ? OFF_KV + 2048 : OFF_KR + (seg - 6) * 512)); wseg[seg] = *(const u32x4*)(row + cb + lane * 8); }
#pragma unroll
            for (int seg = 0; seg < 8; ++seg) {
                const int colbase = seg < 4 ? seg * 512 : (seg == 4 ? OFF_KV + 1024 : (seg == 5 ? OFF_KV + 2048 : OFF_KR + (seg - 6) * 512)), gi = seg < 4 ? 0 : (seg == 4 ? 2 : 3);
                const u32x4 w = wseg[seg];
                u32x4 o = w;
                if (seg < 6) {
                    float f[8] = {bf_lo(w.x), bf_hi(w.x), bf_lo(w.y), bf_hi(w.y), bf_lo(w.z), bf_hi(w.z), bf_lo(w.w), bf_hi(w.w)};
                    float ss = 0.f;
#pragma unroll
                    for (int j = 0; j < 8; ++j) ss += f[j] * f[j];
                    ss += __shfl_xor(ss, 1); ss += __shfl_xor(ss, 2); ss += __shfl_xor(ss, 4); ss += __shfl_xor(ss, 8);
                    const float r = 1.0f / sqrtf(ss * (1.0f / 128.0f) + EPS_);
                    const float* gq = p.g_qk + gi * 128 + c16 * 8;
                    const f32x4 g0 = *(const f32x4*)gq, g1 = *(const f32x4*)(gq + 4);
                    o.x = cvt_pk_bf16(f[0] * r * g0[0], f[1] * r * g0[1]); o.y = cvt_pk_bf16(f[2] * r * g0[2], f[3] * r * g0[3]);
                    o.z = cvt_pk_bf16(f[4] * r * g1[0], f[5] * r * g1[1]); o.w = cvt_pk_bf16(f[6] * r * g1[2], f[7] * r * g1[3]);
                }
                bf16_t* dstp;
                if (seg < 4) dstp = row + colbase + lane * 8;
                else if (seg == 4) dstp = KS + (size_t)(b * 4 + hsub) * 262144 + fro;
                else if (seg == 5) dstp = KW + (size_t)(b * 4 + hsub) * 262144 + fro;
                else dstp = KR + (size_t)(b * 8 + (seg - 6) * 4 + hsub) * 262144 + fro;
                *(u32x4*)dstp = o;
            }
        }
        LAS bf16_t* tl = (LAS bf16_t*)(lds + wave * 16384);
#ifndef TRANSP_REPS
#define TRANSP_REPS 1
#endif
        for (int z = 0; z < TRANSP_REPS; ++z)
        for (int it = gw; it < 64 * 128; it += NGW) {
            const int tt = it / 64, ct = it - tt * 64;
            int srccol, cc, HD; bf16_t* dst;
            if (ct < 8) { srccol = OFF_KV + 3 * 512 + ct * 64; cc = ct * 64; dst = VTS; HD = 128; }
            else if (ct < 16) { srccol = OFF_KV + 5 * 512 + (ct - 8) * 64; cc = (ct - 8) * 64; dst = VTW; HD = 128; }
            else if (ct < 48) { srccol = OFF_VR + (ct - 16) * 64; cc = (ct - 16) * 64; dst = VTR; HD = 256; }
            else { srccol = OFF_KR + (ct - 48) * 64; cc = (ct - 48) * 64; dst = (bf16_t*)(p.ws + WS_KRT); HD = 128; }
            const bool kscale = ct >= 48;
            const float lg2g = kscale ? log1pf(-exp2f(-5.0f - (float)(cc >> 7))) * LOG2E : 0.f;
            const int b = tt >> 5, s0 = (tt & 31) * 64;
            const int head = cc / HD, dt0 = (cc - head * HD) >> 4, NDTh = HD >> 4, nheads = (HD == 128 && !kscale) ? 4 : 8;
#pragma unroll
            for (int i = 0; i < 8; ++i) {
                const int tok = 8 * i + (lane >> 3), ch = lane & 7;
                u32x4 w = *(const u32x4*)(Y + (size_t)(b * 2048 + s0 + tok) * LDY + srccol + ch * 8);
                if (kscale) {
                    const float zf = 0.08838834764831845f * ex2(lg2g * (float)(127 - ((s0 + tok) & 127)));
                    w.x = cvt_pk_bf16(bf_lo(w.x) * zf, bf_hi(w.x) * zf); w.y = cvt_pk_bf16(bf_lo(w.y) * zf, bf_hi(w.y) * zf);
                    w.z = cvt_pk_bf16(bf_lo(w.z) * zf, bf_hi(w.z) * zf); w.w = cvt_pk_bf16(bf_lo(w.w) * zf, bf_hi(w.w) * zf);
                }
                LAS bf16_t* d = tl + (ch * 8) * 72 + tok;
                d[0 * 72] = (bf16_t)(w.x & 0xffffu); d[1 * 72] = (bf16_t)(w.x >> 16); d[2 * 72] = (bf16_t)(w.y & 0xffffu); d[3 * 72] = (bf16_t)(w.y >> 16);
                d[4 * 72] = (bf16_t)(w.z & 0xffffu); d[5 * 72] = (bf16_t)(w.z >> 16); d[6 * 72] = (bf16_t)(w.w & 0xffffu); d[7 * 72] = (bf16_t)(w.w >> 16);
            }
            asm volatile("s_waitcnt lgkmcnt(0)" ::: "memory");
            bf16_t* hb = dst + (size_t)(b * nheads + head) * (2048 * HD) + lane * 8;
#pragma unroll
            for (int i = 0; i < 8; ++i) {
                const int ks = i >> 2, dt = i & 3, col = 16 * dt + (lane & 15), fq4 = 4 * (lane >> 4);
                const u32x2 lo = *(const LAS u32x2*)(tl + col * 72 + 32 * ks + fq4), hi = *(const LAS u32x2*)(tl + col * 72 + 32 * ks + 16 + fq4);
                u32x4 w; w.x = lo.x; w.y = lo.y; w.z = hi.x; w.w = hi.y;
                *(u32x4*)(hb + (size_t)(((s0 >> 5) + ks) * NDTh + dt0 + dt) * 512) = w;
            }
            asm volatile("s_waitcnt lgkmcnt(0)" ::: "memory");
        }
    }
    }
    GSYNC();
    for (int rep = 0; rep < REPS(7); ++rep) { if (rep) GSYNC();
    if (ON(7)) {
        MixPtrs MP{Y, ONSA, ORET, VTS, VTW, VTR, KC, VCT, p.gn_gain, KS, KW, KR};
        unsigned* SM = (unsigned*)(p.ws + WS_SM);
#ifndef CMP_REPS
#define CMP_REPS 1
#endif
        for (int z = 0; z < CMP_REPS; ++z) for (int u = blockIdx.x; u < 256; u += G) cmp_unit(MP, SM, u >> 4, u & 15, lds, tid);
        for (int item = gw; item < 2048; item += NGW) ret_states((const bf16_t*)(p.ws + WS_KRT), VTR, (bf16_t*)(p.ws + WS_ST), item, lane);
    }
    GSYNC();
    if (ON(7)) {
        MixPtrs MP{Y, ONSA, ORET, VTS, VTW, VTR, KC, VCT, p.gn_gain, KS, KW, KR};
        const unsigned* SM = (const unsigned*)(p.ws + WS_SM);
        LAS bf16x8* qs = (LAS bf16x8*)(lds + wave * 16384) + lane;
        if (G == 256) {
            const int x = blockIdx.x & 7, wl = (blockIdx.x >> 3) * 8 + wave;
#pragma unroll 1
            for (int k = 0; k < 2; ++k) {
                const int r = (k & 1) ? 255 - wl : wl, bg = x + 8 * k;
                nsa_unit(MP, SM, bg >> 2, bg & 3, 127 - (r >> 1), r & 1, lane, qs, lds + wave * 16384);
            }
#pragma unroll 1
            for (int qi = 0; qi < 8; ++qi) {
                const int xq = (x + qi) & 7;
                unsigned* qc = ctl + 512 * rep + 32 * xq;
                for (;;) {
                    unsigned id = 0;
                    if (lane == 0) id = atomicAdd(qc, 1u);
                    id = (unsigned)__builtin_amdgcn_readfirstlane((int)id);
                    if (id >= 256u) break;
                    const int bh = xq + 8 * (int)(id >> 6);
                    ret_unit3(MP, (const bf16_t*)(p.ws + WS_ST), bh >> 3, bh & 7, 63 - (int)(id & 63u), lane, lds + wave * 16384);
                }
            }
        } else {
            for (int id = gw; id < 4096 + 2048; id += NGW) {
                if (id < 4096) { const int bg = id >> 8, r = id & 255; nsa_unit(MP, SM, bg >> 2, bg & 3, 127 - (r >> 1), r & 1, lane, qs, lds + wave * 16384); }
                else { const int r = id - 4096, bh = r >> 6; ret_unit3(MP, (const bf16_t*)(p.ws + WS_ST), bh >> 3, bh & 7, 63 - (r & 63), lane, lds + wave * 16384); }
            }
        }
    }
    }
    GSYNC();
    for (int rep = 0; rep < REPS(8); ++rep) { if (rep) GSYNC();
    if (ON(8)) {
        { pg8::Gemm g{ONSA, WPN, T_, D_, D_}; pg8::StaticOrder S; S.init(T_, D_, G, (int)blockIdx.x);
          EpiMerge<false> E{MG, Y, OFF_GA};
          pg8::gemm_phase<EpiMerge<false>, pg8::StaticOrder, true, true>(lds, g, S, E); }
        __syncthreads();
        { pg8::Gemm g{ORET, WPR, T_, D_, D_}; pg8::StaticOrder S; S.init(T_, D_, G, (int)blockIdx.x);
          EpiMerge<true> E{MG, Y, OFF_GB};
          pg8::gemm_phase<EpiMerge<true>, pg8::StaticOrder, true, true>(lds, g, S, E); }
    }
    }
    GSYNC();
    if (ON(9)) {
        pg8::Gemm g{MG, WO, T_, D_, D_}; pg8::StaticOrder S; S.init(T_, D_, G, (int)blockIdx.x);
        EpiResid E{p.out, p.out, ada + 5 * D_, 1.0f};
        pg8::gemm_phase<EpiResid, pg8::StaticOrder, true, true>(lds, g, S, E);
    }
    GSYNC();
    for (int rep = 0; rep < REPS(10); ++rep) { if (rep) GSYNC();
    if (ON(10)) norm_rows(p.out, p.g_norm + 2 * D_, ada, 6, 7, H, gw, NGW, lane);
    }
    GSYNC();
    for (int rep = 0; rep < REPS(11); ++rep) { if (rep) GSYNC();
    if (ON(11)) {
        pg8::Gemm g{H, (const bf16_t*)(p.ws + WS_WGU2), T_, 2 * FF_, D_}; pg8::StaticOrder S; S.init(T_, 2 * FF_, G, (int)blockIdx.x);
        EpiSwiglu E{ACT};
        pg8::gemm_phase<EpiSwiglu, pg8::StaticOrder, true, true>(lds, g, S, E);
    }
    }
    GSYNC();
    if (ON(12)) {
        pg8::Gemm g{ACT, (const bf16_t*)(p.ws + WS_WD2), T_, D_, FF_}; pg8::StaticOrder S; S.init(T_, D_, G, (int)blockIdx.x);
        EpiResid E{p.out, p.out, ada + 8 * D_, 0.5f};
        pg8::gemm_phase<EpiResid, pg8::StaticOrder, true, true>(lds, g, S, E);
    }
#undef ON
#undef GSYNC
#undef ctl
#undef ada
#undef WGU
#undef WD
#undef WIN
#undef WPN
#undef WPR
#undef WO
#undef WC1
#undef WC2
#undef H
#undef ONSA
#undef Y
#undef ACT
#undef MG
#undef ORET
#undef VTS
#undef VTW
#undef VTR
#undef KC
#undef VCT
#undef KS
#undef KW
#undef KR
}

#ifndef PHASE_MASK
#define PHASE_MASK 0x1fff
#endif
extern "C" void kernel_launch(void* const* d_in, const int* in_sizes, int n_in, void* d_out, int out_size, void* d_ws, size_t ws_size, hipStream_t stream) {
    static int grid_blocks = 0;
    if (grid_blocks == 0) {
        if (n_in != 18 || ws_size < WS_END) { fprintf(stderr, "kernel_launch: unexpected n_in %d or workspace %zu < %zu\n", n_in, ws_size, (size_t)WS_END); grid_blocks = -1; return; }
        int dev = 0, cus = 0, per_cu = 0;
        hipGetDevice(&dev);
        hipDeviceGetAttribute(&cus, hipDeviceAttributeMultiprocessorCount, dev);
        if (hipFuncSetAttribute((const void*)fwd_kernel, hipFuncAttributeMaxDynamicSharedMemorySize, LDS_BYTES) != hipSuccess) { fprintf(stderr, "kernel_launch: hipFuncSetAttribute failed\n"); grid_blocks = -1; return; }
        if (hipOccupancyMaxActiveBlocksPerMultiprocessor(&per_cu, (const void*)fwd_kernel, 512, LDS_BYTES) != hipSuccess || per_cu < 1) { fprintf(stderr, "kernel_launch: occupancy query gave %d\n", per_cu); per_cu = 1; }
        (void)hipGetLastError();
        grid_blocks = cus * 1;
    }
    if (grid_blocks < 0) return;
    Params p{};
    p.x = (const float*)d_in[0]; p.c = (const float*)d_in[1]; p.w_ada = (const float*)d_in[2]; p.b_ada = (const float*)d_in[3]; p.g_norm = (const float*)d_in[4];
    p.w_gate = (const float*)d_in[5]; p.w_up = (const float*)d_in[6]; p.w_down = (const float*)d_in[7]; p.w_in = (const float*)d_in[8]; p.g_qk = (const float*)d_in[9];
    p.cmp_pos = (const float*)d_in[10]; p.cmp_w1 = (const float*)d_in[11]; p.cmp_b1 = (const float*)d_in[12]; p.cmp_w2 = (const float*)d_in[13]; p.gn_gain = (const float*)d_in[14];
    p.w_pn = (const float*)d_in[15]; p.w_pr = (const float*)d_in[16]; p.w_out = (const float*)d_in[17];
    p.out = (float*)d_out; p.ws = (unsigned char*)d_ws; p.mask = PHASE_MASK; p.pad = 0;
    void* args[] = {&p};
    hipError_t e = hipLaunchCooperativeKernel((const void*)fwd_kernel, dim3(grid_blocks), dim3(512), args, LDS_BYTES, stream);
    if (e != hipSuccess) fprintf(stderr, "kernel_launch: cooperative launch failed: %s (grid %d)\n", hipGetErrorString(e), grid_blocks);
}
```
